# Optimizing an MI355X kernel written in HIP

```python
import math
import jax, jax.numpy as jnp
from jax import lax
import numpy as np

D_MODEL = 1024
BATCH = 16
SEQ = 256
DEPTH = 2
DEC_BATCH = 4
DEC_SEQ = 1024
PAST_LEN = 256

GRID_W = 64
D_HYENA = 256
D_SCONV = 256
N_HEADS = 8
QK_NOPE = 64
QK_ROPE = 32
QK_DIM = QK_NOPE + QK_ROPE
V_DIM = 64
D_MLA = N_HEADS * V_DIM
D_MIX = D_HYENA + D_SCONV + D_MLA
Q_LORA = 256
KV_LORA = 128
ROPE_THETA = 10000.0
HY_EMB = 33
HY_BANDS = (HY_EMB - 1) // 2
HY_FF = 64
HY_FAST_DECAY = 0.3
HY_SLOW_DECAY = 1.5
HY_TARGET = 1e-2
HY_SHIFT = 0.05
D_FF = ((8 * D_MODEL) // 3 + 255) // 256 * 256
N_IN = 3 * D_HYENA + 3 * D_SCONV + Q_LORA + KV_LORA + QK_ROPE
EPS = 1e-6
Q_BLOCK = 128

kernel_name = 'hybrid_hyena_sconv_mla_diffusion_step'


def rmsnorm(x, g):
    xf = x.astype(jnp.float32)
    y = xf * lax.rsqrt(jnp.mean(xf * xf, axis=-1, keepdims=True) + EPS)
    return (y * g.astype(jnp.float32)).astype(x.dtype)


def conv3(x, w):
    xp = jnp.pad(x, ((0, 0), (1, 1), (0, 0)))
    return xp[:, :-2] * w[0] + xp[:, 1:-1] * w[1] + xp[:, 2:] * w[2]


def axial_rope_tables(L):
    rows = L // GRID_W
    row = jnp.repeat(jnp.arange(rows, dtype=jnp.float32), GRID_W)
    col = jnp.tile(jnp.arange(GRID_W, dtype=jnp.float32), rows)
    half = QK_ROPE // 2
    inv = 1.0 / (ROPE_THETA ** (jnp.arange(0, half, 2, dtype=jnp.float32) / half))
    ang = jnp.concatenate([row[:, None] * inv, col[:, None] * inv], axis=-1)
    return jnp.cos(ang), jnp.sin(ang)


def apply_rope(x, cos, sin):
    Bn, L, H, _ = x.shape
    q4 = QK_ROPE // 4
    xf = x.astype(jnp.float32)
    pe = xf[..., QK_NOPE:].reshape(Bn, L, H, 2, 2, q4)
    c = cos.reshape(L, 2, q4)[None, :, None]
    s = sin.reshape(L, 2, q4)[None, :, None]
    a, b = pe[..., 0, :], pe[..., 1, :]
    rot = jnp.stack([a * c - b * s, b * c + a * s], axis=-2).reshape(Bn, L, H, QK_ROPE)
    return jnp.concatenate([xf[..., :QK_NOPE], rot], axis=-1).astype(x.dtype)


def hyena_filter_fft(L, w1, b1, freq, w2, b2, w3):
    f32 = jnp.float32
    t = jnp.linspace(0.0, 1.0, L, dtype=f32)[:, None]
    w_ang = 2.0 * math.pi * jnp.arange(L, dtype=f32)[:, None] / L
    bands = jnp.linspace(1e-4, HY_BANDS - 1, HY_BANDS, dtype=f32)[None, :]
    z = jnp.concatenate([t, jnp.cos(bands * w_ang), -jnp.sin(bands * w_ang)], axis=-1)
    fr = freq.astype(f32)
    h = jnp.sin(fr * (z @ w1.astype(f32) + b1.astype(f32)))
    h = jnp.sin(fr * (h @ w2.astype(f32) + b2.astype(f32)))
    h = h @ w3.astype(f32)
    deltas = jnp.abs(jnp.linspace(math.log(HY_TARGET) / HY_FAST_DECAY,
                                  math.log(HY_TARGET) / HY_SLOW_DECAY, D_HYENA, dtype=f32))
    window = jnp.exp(-t * deltas[None, :]) + HY_SHIFT
    h_f = h[:, :D_HYENA] * window
    h_b = h[:, D_HYENA:] * window
    k = jnp.concatenate([h_f, jnp.zeros((1, D_HYENA), f32), h_b[:0:-1]], axis=0)
    return jnp.fft.rfft(k, axis=0)


def hyena_mixer(u, conv_w, w1, b1, freq, w2, b2, w3, bias):
    L = u.shape[1]
    u = conv3(u, conv_w)
    x0, x1, v = jnp.split(u, 3, axis=-1)
    kf = hyena_filter_fft(L, w1, b1, freq, w2, b2, w3)
    z = (x1 * v).astype(jnp.float32)
    Z = jnp.fft.rfft(z, n=2 * L, axis=1)
    y = jnp.fft.irfft(Z * kf[None], n=2 * L, axis=1)[:, :L]
    y = y + z * bias.astype(jnp.float32)
    return (x0.astype(jnp.float32) * y).astype(u.dtype)


def sconv_mixer(u, conv_w):
    bg, cg, hx = jnp.split(u, 3, axis=-1)
    return bg * conv3(cg * hx, conv_w)


def mla_q(c_q, g_q, w_uq, g_qh):
    Bn, L, _ = c_q.shape
    q = (rmsnorm(c_q, g_q) @ w_uq).reshape(Bn, L, N_HEADS, QK_DIM)
    return rmsnorm(q, g_qh)


def mla_kv(c_kv, k_pe, g_kv, w_ukv, g_kh):
    Bn, L, _ = c_kv.shape
    kv = (rmsnorm(c_kv, g_kv) @ w_ukv).reshape(Bn, L, N_HEADS, QK_NOPE + V_DIM)
    k_nope, v = kv[..., :QK_NOPE], kv[..., QK_NOPE:]
    k = jnp.concatenate([k_nope, jnp.broadcast_to(k_pe[:, :, None, :], (Bn, L, N_HEADS, QK_ROPE))], axis=-1)
    return rmsnorm(k, g_kh), v


def attention(q, k, v):
    Bn, Lq, H, Dq = q.shape
    nb = Lq // Q_BLOCK
    kf = k.astype(jnp.float32)
    vf = v.astype(jnp.float32)
    qb = q.astype(jnp.float32).reshape(Bn, nb, Q_BLOCK, H, Dq).swapaxes(0, 1)
    scale = QK_DIM ** -0.5

    def one_block(qi):
        s = jnp.einsum('bqhd,bkhd->bhqk', qi, kf) * scale
        p = jax.nn.softmax(s, axis=-1)
        return jnp.einsum('bhqk,bkhd->bqhd', p, vf)

    o = lax.map(one_block, qb).swapaxes(0, 1).reshape(Bn, Lq, H * V_DIM)
    return o.astype(v.dtype)


def trunk_layer(x, mod, P, l, ctx, rope):
    sh1, sc1, g1, sh2, sc2, g2 = jnp.split(mod, 6, axis=-1)
    h = rmsnorm(x, P['g_norm1'][l]) * (1 + sc1) + sh1
    proj = h @ P['w_in'][l]
    o0 = 3 * D_HYENA
    o1 = o0 + 3 * D_SCONV
    o2 = o1 + Q_LORA
    o3 = o2 + KV_LORA
    u_hy, u_sc = proj[..., :o0], proj[..., o0:o1]
    c_q, c_kv, k_pe = proj[..., o1:o2], proj[..., o2:o3], proj[..., o3:]

    y_hy = hyena_mixer(u_hy, P['hy_conv'][l], P['hy_w1'][l], P['hy_b1'][l], P['hy_freq'][l],
                       P['hy_w2'][l], P['hy_b2'][l], P['hy_w3'][l], P['hy_bias'][l])
    y_sc = sconv_mixer(u_sc, P['sc_conv'][l])

    q = mla_q(c_q, P['g_q'][l], P['w_uq'][l], P['g_qh'][l])
    k, v = mla_kv(c_kv, k_pe, P['g_kv'][l], P['w_ukv'][l], P['g_kh'][l])
    if rope is not None:
        q = apply_rope(q, rope[0], rope[1])
        k = apply_rope(k, rope[0], rope[1])
    if ctx is not None:
        ck, cv = mla_kv(ctx[0], ctx[1], P['g_kv'][l], P['w_ukv'][l], P['g_kh'][l])
        k = jnp.concatenate([k, ck], axis=1)
        v = jnp.concatenate([v, cv], axis=1)
    y_at = attention(q, k, v)

    gg = P['g_grp'][l]
    y = jnp.concatenate([rmsnorm(y_hy, gg[:D_HYENA]),
                         rmsnorm(y_sc, gg[D_HYENA:D_HYENA + D_SCONV]),
                         rmsnorm(y_at, gg[D_HYENA + D_SCONV:])], axis=-1)
    x = x + g1 * (y @ P['w_out'][l])

    h2 = rmsnorm(x, P['g_norm2'][l]) * (1 + sc2) + sh2
    ff = (jax.nn.silu(h2 @ P['w_ff_gate'][l]) * (h2 @ P['w_ff_up'][l])) @ P['w_ff_down'][l]
    x = x + g2 * ff
    return x, c_kv, k_pe


def setup_inputs(seed: int = 0) -> dict:
    key = jax.random.key(seed)
    ks = iter(jax.random.split(key, 40))
    f32 = jnp.float32

    def nrm(shape, scale):
        return jax.random.normal(next(ks), shape, f32) * scale

    def gain(shape):
        return 1.0 + nrm(shape, 0.01)

    return {
        'x_prompt': nrm((BATCH, SEQ, D_MODEL), 1.0),
        'x_sample': nrm((DEC_BATCH, DEC_SEQ, D_MODEL), 1.0),
        'cache_ckv': nrm((DEC_BATCH, DEPTH, PAST_LEN, KV_LORA), 1.0),
        'cache_kpe': nrm((DEC_BATCH, DEPTH, PAST_LEN, QK_ROPE), 1.0),
        'c': nrm((DEC_BATCH, D_MODEL), 1.0),
        'c_ctx': nrm((D_MODEL,), 1.0),
        'w_mod': nrm((DEPTH, D_MODEL, 6 * D_MODEL), 0.3 * D_MODEL ** -0.5),
        'b_mod': nrm((DEPTH, 6 * D_MODEL), 0.01),
        'g_norm1': gain((DEPTH, D_MODEL)),
        'w_in': nrm((DEPTH, D_MODEL, N_IN), D_MODEL ** -0.5),
        'hy_conv': nrm((DEPTH, 3, 3 * D_HYENA), 3 ** -0.5),
        'hy_w1': nrm((DEPTH, HY_EMB, HY_FF), HY_EMB ** -0.5),
        'hy_b1': nrm((DEPTH, HY_FF), 0.01),
        'hy_freq': 1.0 + nrm((DEPTH, HY_FF), 0.1),
        'hy_w2': nrm((DEPTH, HY_FF, HY_FF), HY_FF ** -0.5),
        'hy_b2': nrm((DEPTH, HY_FF), 0.01),
        'hy_w3': nrm((DEPTH, HY_FF, 2 * D_HYENA), HY_FF ** -0.5),
        'hy_bias': nrm((DEPTH, D_HYENA), 0.5),
        'sc_conv': nrm((DEPTH, 3, D_SCONV), 3 ** -0.5),
        'g_q': gain((DEPTH, Q_LORA)),
        'w_uq': nrm((DEPTH, Q_LORA, N_HEADS * QK_DIM), Q_LORA ** -0.5),
        'g_kv': gain((DEPTH, KV_LORA)),
        'w_ukv': nrm((DEPTH, KV_LORA, N_HEADS * (QK_NOPE + V_DIM)), KV_LORA ** -0.5),
        'g_qh': gain((DEPTH, QK_DIM)),
        'g_kh': gain((DEPTH, QK_DIM)),
        'g_grp': gain((DEPTH, D_MIX)),
        'w_out': nrm((DEPTH, D_MIX, D_MODEL), D_MIX ** -0.5),
        'g_norm2': gain((DEPTH, D_MODEL)),
        'w_ff_gate': nrm((DEPTH, D_MODEL, D_FF), D_MODEL ** -0.5),
        'w_ff_up': nrm((DEPTH, D_MODEL, D_FF), D_MODEL ** -0.5),
        'w_ff_down': nrm((DEPTH, D_FF, D_MODEL), D_FF ** -0.5),
    }


def reference(x_prompt, x_sample, cache_ckv, cache_kpe, c, c_ctx, w_mod, b_mod, g_norm1, w_in,
              hy_conv, hy_w1, hy_b1, hy_freq, hy_w2, hy_b2, hy_w3, hy_bias, sc_conv,
              g_q, w_uq, g_kv, w_ukv, g_qh, g_kh, g_grp, w_out, g_norm2,
              w_ff_gate, w_ff_up, w_ff_down):
    P = {'g_norm1': g_norm1, 'w_in': w_in, 'hy_conv': hy_conv, 'hy_w1': hy_w1, 'hy_b1': hy_b1,
         'hy_freq': hy_freq, 'hy_w2': hy_w2, 'hy_b2': hy_b2, 'hy_w3': hy_w3, 'hy_bias': hy_bias,
         'sc_conv': sc_conv, 'g_q': g_q, 'w_uq': w_uq, 'g_kv': g_kv, 'w_ukv': w_ukv,
         'g_qh': g_qh, 'g_kh': g_kh, 'g_grp': g_grp, 'w_out': w_out, 'g_norm2': g_norm2,
         'w_ff_gate': w_ff_gate, 'w_ff_up': w_ff_up, 'w_ff_down': w_ff_down}

    xp = x_prompt
    ckv_list = []
    kpe_list = []
    for l in range(DEPTH):
        mod = (jax.nn.silu(c_ctx) @ w_mod[l] + b_mod[l])[None, None, :]
        xp, ckv, kpe = trunk_layer(xp, mod, P, l, None, None)
        ckv_list.append(ckv)
        kpe_list.append(kpe)
    new_ckv = jnp.stack(ckv_list, axis=1)
    new_kpe = jnp.stack(kpe_list, axis=1)

    xs = x_sample
    rope = axial_rope_tables(x_sample.shape[1])
    for l in range(DEPTH):
        mod = (jax.nn.silu(c) @ w_mod[l] + b_mod[l])[:, None, :]
        xs, _, _ = trunk_layer(xs, mod, P, l, (cache_ckv[:, l], cache_kpe[:, l]), rope)

    return (xp, xs, new_ckv, new_kpe)
```

```cpp
#include <hip/hip_runtime.h>
#include <hip/hip_cooperative_groups.h>
#include <cstdio>
#include <cstdint>
namespace cg = cooperative_groups;

namespace pg8 {
#define PG8_LAS __attribute__((address_space(3)))
typedef unsigned short bf16_t;
typedef short bf16x8 __attribute__((ext_vector_type(8)));
typedef float f32x4 __attribute__((ext_vector_type(4)));
typedef unsigned u32x4 __attribute__((ext_vector_type(4)));
constexpr int BM = 256, BK = 64, HALF = 128, HTB = HALF * BK * 2  , STAGE_BYTES = 8 * HTB, NXCD = 8, WGM = 8;

__host__ __device__ __forceinline__ int lds_byte(int r, int c) { const int st = (r >> 4) * 2 + (c >> 5), rr = r & 15, cc = c & 31, ob = rr * 64 + cc * 2; return st * 1024 + (ob ^ (((ob >> 9) & 1) << 5)); }
__host__ __device__ __forceinline__ void stage_rc(int b, int& R, int& C) { const int st = b / 1024, sb = b % 1024, swz = sb ^ (((sb >> 9) & 1) << 5); R = (st >> 1) * 16 + swz / 64; C = (st & 1) * 32 + (swz % 64) / 2; }
__host__ __device__ __forceinline__ int perm32(int rho) { const int n = rho >> 4, i = rho & 15; return 8 * (i >> 2) + 4 * n + (i & 3); }

struct Unit { int pm, pn; };
struct Gemm { const bf16_t* A; const bf16_t* Bt; int M, N, K; };

struct StaticOrder {
    int nM, nN, nwg, G, c;
    __host__ __device__ void init(int M, int N, int G_, int c_) { nM = M / BM; nN = N / BM; nwg = nM * nN; G = G_; c = c_; }
    __host__ __device__ bool next(int i, Unit& u) const {
        const long L = (long)i * G + c; if (L >= nwg) return false;
        int wgid = (int)L; { const int q = nwg / NXCD, r = nwg % NXCD, xcd = wgid % NXCD, off = wgid / NXCD; wgid = (xcd < r ? xcd * (q + 1) : r * (q + 1) + (xcd - r) * q) + off; }
        const int nig = WGM * nN, gid = wgid / nig, fm = gid * WGM, gsz = (nM - fm) < WGM ? (nM - fm) : WGM;
        u.pm = fm + ((wgid % nig) % gsz); u.pn = (wgid % nig) / gsz; return true;
    }
};
__device__ __forceinline__ unsigned cvt_pk_bf16(float lo, float hi) { unsigned r; asm volatile("v_cvt_pk_bf16_f32 %0, %1, %2" : "=v"(r) : "v"(lo), "v"(hi)); return r; }

template <class Epi, class Sched, bool ALIGN_EPI = false, bool SP2 = false>
__device__ __forceinline__ void gemm_phase(PG8_LAS unsigned char* lds, const Gemm g, const Sched& S, const Epi& E) {
    const int tid = threadIdx.x, wid = __builtin_amdgcn_readfirstlane(tid >> 6), lane = tid & 63, wr = wid >> 2, wc = wid & 3, fr = lane & 15, fq = lane >> 4;
    const int K = g.K, nt = K / BK;
    unsigned voffA[2], voffB[2];
#pragma unroll
    for (int i = 0; i < 2; ++i) { int R, C; stage_rc(tid * 16 + i * 8192, R, C); const int Rb = Epi::PERM ? ((R & ~31) + perm32(R & 31)) : R;
        voffA[i] = (unsigned)(R * K + C) * 2u; voffB[i] = (unsigned)(Rb * K + C) * 2u; }
    const size_t kstep = (size_t)(BK * 2);
    const size_t hstep = (size_t)HALF * K * 2;
    const size_t tstep = 2 * hstep;
    const unsigned ldsw = (unsigned)wid * 1024u;
    const int aoff = lds_byte(wr * 64 + fr, fq * 8), boff = lds_byte(wc * 32 + fr, fq * 8);
#define PG8_SA(b, h) (((b) * 2 + (h)) * HTB)
#define PG8_SB(b, h) ((4 + (b) * 2 + (h)) * HTB)
#define PG8_STAGE(bufoff, gbase, voff) do { _Pragma("unroll") for (int _i = 0; _i < 2; ++_i) \
        __builtin_amdgcn_global_load_lds((const unsigned*)((const char*)(gbase) + (voff)[_i]), (PG8_LAS unsigned*)(lds + (bufoff) + ldsw + _i * 8192), 16, 0, 0); } while (0)
#define PG8_LDA(dst, b, h) do { _Pragma("unroll") for (int m = 0; m < 4; ++m) _Pragma("unroll") for (int k = 0; k < 2; ++k) dst[m][k] = *(const PG8_LAS bf16x8*)(lds + PG8_SA(b, h) + aoff + m * 2048 + k * 1024); } while (0)
#define PG8_LDB(dst, b, h) do { _Pragma("unroll") for (int n = 0; n < 2; ++n) _Pragma("unroll") for (int k = 0; k < 2; ++k) dst[n][k] = *(const PG8_LAS bf16x8*)(lds + PG8_SB(b, h) + boff + n * 2048 + k * 1024); } while (0)
#define PG8_MMA(ai, bj, At, Bt) do { __builtin_amdgcn_s_setprio(1); _Pragma("unroll") for (int m = 0; m < 4; ++m) _Pragma("unroll") for (int n = 0; n < 2; ++n) _Pragma("unroll") for (int k = 0; k < 2; ++k) \
        acc[ai][bj][m][n] = __builtin_amdgcn_mfma_f32_16x16x32_bf16(Bt[n][k], At[m][k], acc[ai][bj][m][n], 0, 0, 0); __builtin_amdgcn_s_setprio(0); } while (0)
#define PG8_WAIT_V(n) asm volatile("s_waitcnt vmcnt(" #n ")" ::: "memory")
#define PG8_WAIT_L(n) asm volatile("s_waitcnt lgkmcnt(" #n ")" ::: "memory")
#define PG8_BAR __builtin_amdgcn_s_barrier()
#define PG8_SCHED __builtin_amdgcn_sched_barrier(0)
    Unit cur, nxt; int ui = 0;
    if (!S.next(0, cur)) return;
    f32x4 acc[2][2][4][2];
#pragma unroll
    for (int a = 0; a < 2; ++a)
#pragma unroll
        for (int b = 0; b < 2; ++b)
#pragma unroll
            for (int m = 0; m < 4; ++m)
#pragma unroll
                for (int n = 0; n < 2; ++n) acc[a][b][m][n] = (f32x4){0.f, 0.f, 0.f, 0.f};
    bf16x8 At[4][2], B0[2][2], B1[2][2];
    const char* cA = (const char*)g.A + (size_t)cur.pm * tstep; const char* cB = (const char*)g.Bt + (size_t)cur.pn * tstep;
    E.prep(cur, 0);
    if constexpr (SP2) {
        PG8_STAGE(PG8_SB(0, 0), cB, voffB); PG8_STAGE(PG8_SB(0, 1), cB + hstep, voffB); PG8_STAGE(PG8_SA(0, 0), cA, voffA); PG8_STAGE(PG8_SA(0, 1), cA + hstep, voffA);
        if (wr == 1) PG8_BAR;
        PG8_WAIT_V(2); PG8_BAR;
        PG8_STAGE(PG8_SB(1, 0), cB + kstep, voffB); PG8_STAGE(PG8_SA(1, 0), cA + kstep, voffA); PG8_STAGE(PG8_SB(1, 1), cB + hstep + kstep, voffB);
        PG8_WAIT_V(6); PG8_BAR;
    } else {
        PG8_STAGE(PG8_SB(0, 0), cB, voffB); PG8_STAGE(PG8_SA(0, 0), cA, voffA); PG8_STAGE(PG8_SB(0, 1), cB + hstep, voffB); PG8_STAGE(PG8_SA(0, 1), cA + hstep, voffA);
        if (wr == 1) PG8_BAR;
        PG8_WAIT_V(4); PG8_BAR;
        PG8_STAGE(PG8_SB(1, 0), cB + kstep, voffB); PG8_STAGE(PG8_SA(1, 0), cA + kstep, voffA); PG8_STAGE(PG8_SB(1, 1), cB + hstep + kstep, voffB);
        PG8_WAIT_V(6); PG8_BAR;
    }
    for (;;) {
        const bool has_next = S.next(ui + 1, nxt);
        const char* nA = has_next ? (const char*)g.A + (size_t)nxt.pm * tstep : cA; const char* nB = has_next ? (const char*)g.Bt + (size_t)nxt.pn * tstep : cB;
        for (int t = 0; t < nt; t += 2) {
            const bool last = (t == nt - 2);
            const char* a1 = cA + (size_t)(t + 1) * kstep;
            const char* a2 = last ? nA : cA + (size_t)(t + 2) * kstep; const char* b2 = last ? nB : cB + (size_t)(t + 2) * kstep;
            const char* a3 = a2 + kstep; const char* b3 = b2 + kstep;
            if (last && has_next) E.prep(nxt, (ui + 1) & 1);
            if constexpr (Epi::KRESCALE) { if (t == 4) E.rescale(acc, 0, ui & 1, wr, fr); else if (t == 8) E.rescale(acc, 1, ui & 1, wr, fr); }
            if constexpr (SP2) {
            PG8_LDB(B0, 0, 0); PG8_LDB(B1, 0, 1); PG8_SCHED; PG8_LDA(At, 0, 0); PG8_STAGE(PG8_SA(1, 1), a1 + hstep, voffA);
            PG8_WAIT_V(8); PG8_WAIT_L(0); PG8_BAR; PG8_MMA(0, 0, At, B0); PG8_MMA(0, 1, At, B1); PG8_BAR; PG8_SCHED;
            PG8_LDA(At, 0, 1); PG8_STAGE(PG8_SB(0, 0), b2, voffB); PG8_STAGE(PG8_SB(0, 1), b2 + hstep, voffB); PG8_STAGE(PG8_SA(0, 0), a2, voffA);
            PG8_WAIT_V(8); PG8_WAIT_L(0); PG8_BAR; PG8_MMA(1, 0, At, B0); PG8_MMA(1, 1, At, B1); PG8_BAR; PG8_SCHED;
            PG8_LDB(B0, 1, 0); PG8_LDB(B1, 1, 1); PG8_SCHED; PG8_LDA(At, 1, 0); PG8_STAGE(PG8_SA(0, 1), a2 + hstep, voffA);
            PG8_WAIT_V(8); PG8_WAIT_L(0); PG8_BAR; PG8_MMA(0, 0, At, B0); PG8_MMA(0, 1, At, B1); PG8_BAR; PG8_SCHED;
            PG8_LDA(At, 1, 1); PG8_STAGE(PG8_SB(1, 0), b3, voffB); PG8_STAGE(PG8_SB(1, 1), b3 + hstep, voffB); PG8_STAGE(PG8_SA(1, 0), a3, voffA);
            PG8_WAIT_V(8); PG8_WAIT_L(0); PG8_BAR; PG8_MMA(1, 0, At, B0); PG8_MMA(1, 1, At, B1); PG8_BAR; PG8_SCHED;
            } else {
            PG8_LDB(B0, 0, 0); PG8_SCHED; PG8_LDA(At, 0, 0); PG8_STAGE(PG8_SA(1, 1), a1 + hstep, voffA);
            PG8_WAIT_L(8); PG8_BAR; PG8_WAIT_L(0); PG8_MMA(0, 0, At, B0); PG8_BAR; PG8_SCHED;
            PG8_LDB(B1, 0, 1); PG8_STAGE(PG8_SB(0, 0), b2, voffB);
            PG8_BAR; PG8_WAIT_L(0); PG8_MMA(0, 1, At, B1); PG8_BAR;
            PG8_LDA(At, 0, 1); PG8_STAGE(PG8_SA(0, 0), a2, voffA);
            PG8_BAR; PG8_WAIT_L(0); PG8_MMA(1, 0, At, B0); PG8_BAR; PG8_SCHED;
            PG8_STAGE(PG8_SB(0, 1), b2 + hstep, voffB);
            PG8_WAIT_V(6); PG8_BAR; PG8_MMA(1, 1, At, B1); PG8_BAR;
            PG8_LDB(B0, 1, 0); PG8_SCHED; PG8_LDA(At, 1, 0); PG8_STAGE(PG8_SA(0, 1), a2 + hstep, voffA);
            PG8_WAIT_L(8); PG8_BAR; PG8_WAIT_L(0); PG8_MMA(0, 0, At, B0); PG8_BAR; PG8_SCHED;
            PG8_LDB(B1, 1, 1); PG8_STAGE(PG8_SB(1, 0), b3, voffB);
            PG8_BAR; PG8_WAIT_L(0); PG8_MMA(0, 1, At, B1); PG8_BAR;
            PG8_LDA(At, 1, 1); PG8_STAGE(PG8_SA(1, 0), a3, voffA);
            PG8_BAR; PG8_WAIT_L(0); PG8_MMA(1, 0, At, B0); PG8_BAR; PG8_SCHED;
            PG8_STAGE(PG8_SB(1, 1), b3 + hstep, voffB);
            PG8_WAIT_V(6); PG8_BAR; PG8_MMA(1, 1, At, B1); PG8_BAR;
            }
        }
        if constexpr (ALIGN_EPI) { if (wr == 0) PG8_BAR; }
        E(acc, cur, wr, wc, fr, fq, ui & 1);
        if (!has_next) break;
#pragma unroll
        for (int a = 0; a < 2; ++a)
#pragma unroll
            for (int b = 0; b < 2; ++b)
#pragma unroll
                for (int m = 0; m < 4; ++m)
#pragma unroll
                    for (int n = 0; n < 2; ++n) acc[a][b][m][n] = (f32x4){0.f, 0.f, 0.f, 0.f};
        cur = nxt; cA = nA; cB = nB; ++ui;
        if constexpr (ALIGN_EPI) { if (wr == 1) PG8_BAR; }
    }
    PG8_WAIT_V(0);
    if constexpr (!ALIGN_EPI) { if (wr == 0) PG8_BAR; }
    PG8_BAR;
#undef PG8_SA
#undef PG8_SB
#undef PG8_STAGE
#undef PG8_LDA
#undef PG8_LDB
#undef PG8_MMA
#undef PG8_WAIT_V
#undef PG8_WAIT_L
#undef PG8_BAR
#undef PG8_SCHED
}
}

#define GAS __attribute__((address_space(1)))
#define LAS __attribute__((address_space(3)))
typedef unsigned short bf16;
typedef unsigned v4u __attribute__((ext_vector_type(4)));
typedef unsigned v2u __attribute__((ext_vector_type(2)));
typedef float f32x4 __attribute__((ext_vector_type(4)));
typedef float f32x2 __attribute__((ext_vector_type(2)));
typedef short bf16x8 __attribute__((ext_vector_type(8)));
typedef short bf16x4 __attribute__((ext_vector_type(4)));

constexpr int NWAVES = 8, NTHR = 512;
constexpr int M = 8192, MC = 4096, D = 1024, NIN = 1952, NINP = 2048, DFF = 2816, NGU = 5632;
constexpr int O_SC = 768, O_CQ = 1536, O_CKV = 1792, O_KPE = 1920;
constexpr int NH = 8, QKD = 96, VD = 64, QL = 256, KVL = 128, ROPE = 32;
constexpr float EPS = 1e-6f;
constexpr float QSCALE = 0.10206207261596575f * 1.4426950408889634f;
constexpr int XL0 = 2 * 256 + 32, XL1 = 2 * 1024 + 32;
constexpr int FILT_LAYER = 256 * (XL0 + XL1);
constexpr int OUT_CKV = M * D, OUT_KPE = OUT_CKV + 16 * 2 * 256 * 128;
constexpr int N_PHASES = 14;

constexpr size_t MiB = 1u << 20;
constexpr size_t WS_CTL = 0, CTL_ZERO_BYTES = 1 * MiB;
constexpr size_t CTL_SSQHY = 256 * 1024;
constexpr size_t WS_MOD = 1 * MiB;
constexpr size_t WS_GG = WS_MOD + 2 * 5 * 6144 * 4;
constexpr size_t WS_BIN = WS_GG + 2 * 2 * 5 * 1024 * 4;
constexpr size_t WS_BGU = WS_BIN + 2 * 5 * 2048 * 4;
constexpr size_t WS_SSQ1P = 2 * MiB;
constexpr size_t WS_SSQ2P = WS_SSQ1P + 16 * M * 4;
constexpr size_t WS_SSQSC = WS_SSQ2P + 16 * M * 4;
constexpr size_t WS_SSQAT = WS_SSQSC + M * 4;
constexpr size_t WS_ROPE = WS_SSQAT + 8 * M * 4;
constexpr size_t WS_FILT = 4 * MiB;
constexpr size_t WS_WIN = 8 * MiB;
constexpr size_t WS_WOUT = WS_WIN + 2ull * NINP * D * 2;
constexpr size_t WS_WGU = WS_WOUT + 2ull * D * D * 2;
constexpr size_t WS_WD = WS_WGU + 2ull * NGU * D * 2;
constexpr size_t WS_WUQ = WS_WD + 2ull * D * DFF * 2;
constexpr size_t WS_WUKV = WS_WUQ + 2ull * 768 * 256 * 2;
constexpr size_t WS_XG = 58 * MiB;
constexpr size_t WS_XR = WS_XG + (size_t)M * D * 2;
constexpr size_t WS_PROJ = WS_XR + (size_t)M * D * 4;
constexpr size_t WS_Q = WS_PROJ + (size_t)M * NINP * 2;
constexpr size_t WS_ACT = WS_PROJ;
constexpr size_t WS_KC = WS_Q + (size_t)M * 768 * 2;
constexpr size_t WS_VTC = WS_KC + 16ull * 256 * 768 * 2;
constexpr size_t WS_KL = WS_VTC + 16ull * 8 * 64 * 256 * 2;
constexpr size_t WS_VTL = WS_KL + 2ull * 4 * 1280 * 768 * 2;
constexpr size_t WS_YMIX = WS_VTL + 2ull * 4 * 8 * 64 * 1280 * 2;
constexpr size_t WS_Z = WS_YMIX + (size_t)M * D * 2;
constexpr size_t WS_END = WS_Z + (size_t)M * 256 * 4;
static_assert(WS_BGU + 2 * 5 * 5632 * 4 <= WS_SSQ1P && WS_ROPE + 1024 * 32 * 4 <= WS_FILT && WS_FILT + 2ull * FILT_LAYER * 2 <= WS_WIN && WS_WUKV + 2ull * 1024 * 128 * 2 <= WS_XG, "ws map");
static_assert((size_t)M * DFF * 2 == (size_t)M * NINP * 2 + (size_t)M * 768 * 2, "ACT overlays PROJ|Q exactly");
static_assert(WS_END <= 256 * MiB, "ws fits 256 MiB");
constexpr int CW_BAR = 4096;

constexpr int RING_BYTES = 131072;
constexpr int MISC_OFF = RING_BYTES;
constexpr int AUX_OFF = RING_BYTES + 1024;
constexpr int LDS_BYTES = 155648;
static_assert(AUX_OFF + 5 * 1024 * 4 <= LDS_BYTES, "LDS map");

#define LDS_WAIT() asm volatile("s_waitcnt lgkmcnt(0)" ::: "memory")
#define VM_WAIT() asm volatile("s_waitcnt vmcnt(0)" ::: "memory")
__device__ __forceinline__ unsigned f2bf(float f) { unsigned u = __builtin_bit_cast(unsigned, f); return (u + 0x7fffu + ((u >> 16) & 1u)) >> 16; }
__device__ __forceinline__ unsigned pk2(float lo, float hi) { return f2bf(lo) | (f2bf(hi) << 16); }
__device__ __forceinline__ float bf2f(unsigned short b) { return __builtin_bit_cast(float, (unsigned)b << 16); }
__device__ __forceinline__ float bflo(unsigned w) { return __builtin_bit_cast(float, w << 16); }
__device__ __forceinline__ float bfhi(unsigned w) { return __builtin_bit_cast(float, w & 0xffff0000u); }
__device__ __forceinline__ float wave_sum(float v) {
#pragma unroll
    for (int o = 1; o < 64; o <<= 1) v += __shfl_xor(v, o);
    return v;
}
__device__ __forceinline__ int modidx(int row) { return row < MC ? 0 : 1 + ((row - MC) >> 10); }

struct Args { const float* in[31]; float* out; unsigned char* ws; int ph_lo, ph_hi, use_bar, pad; };
enum { I_XP = 0, I_XS, I_CCKV, I_CKPE, I_C, I_CCTX, I_WMOD, I_BMOD, I_GN1, I_WIN, I_HYCONV, I_HYW1, I_HYB1, I_HYFREQ, I_HYW2, I_HYB2, I_HYW3, I_HYBIAS, I_SCCONV,
       I_GQ, I_WUQ, I_GKV, I_WUKV, I_GQH, I_GKH, I_GGRP, I_WOUT, I_GN2, I_WG, I_WU, I_WD };

struct Frame {
    LAS unsigned char* lds;
    int tid, lane, wave, G, bid;
    const Args* a;
    unsigned char* ws;
};
#define WSP(T, off) ((T*)(F.ws + (off)))

__device__ __forceinline__ void tr_item(const float* W, int N, int k0, int n0, bf16* WT, int ldk, int dst_row0, const float* kscale, LAS float* scr, int lane) {
#pragma unroll 8
    for (int i = 0; i < 32; ++i) { const int kk = 2 * i + (lane >> 5); float v = W[(size_t)(k0 + kk) * N + n0 + (lane & 31)]; if (kscale) v *= kscale[k0 + kk]; scr[kk * 33 + (lane & 31)] = v; }
    LDS_WAIT(); asm volatile("" ::: "memory");
    const int c = lane & 7;
#pragma unroll
    for (int j = 0; j < 4; ++j) { const int n = (lane >> 3) + 8 * j; const LAS float* s = scr + (8 * c) * 33 + n;
        v4u o; o.x = pk2(s[0 * 33], s[1 * 33]); o.y = pk2(s[2 * 33], s[3 * 33]); o.z = pk2(s[4 * 33], s[5 * 33]); o.w = pk2(s[6 * 33], s[7 * 33]);
        *(v4u*)(WT + (size_t)(dst_row0 + n) * ldk + k0 + 8 * c) = o; }
    LDS_WAIT(); asm volatile("" ::: "memory");
}
constexpr int T_IN = 16 * 61, T_OUT = 16 * 32, T_G = 16 * 88, T_D = 44 * 32, T_UQ = 4 * 24, T_UKV = 2 * 32;
constexpr int T_LAYER = T_IN + T_OUT + 2 * T_G + T_D + T_UQ + T_UKV;
constexpr int IT_MOD = 192, IT_FILT = 2 * 1280, IT_ROPE = 256;
constexpr int P0_ITEMS = IT_MOD + IT_FILT + IT_ROPE + 2 * T_LAYER;

__device__ __forceinline__ void p0_mod_item(Frame& F, int it, const LAS float* sv) {
    const int l = it / 96, n0 = (it % 96) * 64 + F.lane;
    const float* W = F.a->in[I_WMOD] + (size_t)l * D * 6144 + n0;
    float acc[5] = {0.f, 0.f, 0.f, 0.f, 0.f};
    for (int k = 0; k < D; k += 8) {
        float w[8];
#pragma unroll
        for (int u = 0; u < 8; ++u) w[u] = W[(size_t)(k + u) * 6144];
#pragma unroll
        for (int u = 0; u < 8; ++u)
#pragma unroll
            for (int j = 0; j < 5; ++j) acc[j] += sv[j * 1024 + k + u] * w[u];
    }
    const float b = F.a->in[I_BMOD][l * 6144 + n0];
    float* mod = WSP(float, WS_MOD) + (size_t)l * 5 * 6144 + n0;
#pragma unroll
    for (int j = 0; j < 5; ++j) mod[j * 6144] = acc[j] + b;
}
__device__ __forceinline__ void p0_filt_item(Frame& F, int it) {
    const int l = it / 1280, r = it % 1280, sel = r >= 256, m = sel ? r - 256 : r, L = sel ? 1024 : 256, lane = F.lane;
    const float* w1 = F.a->in[I_HYW1] + l * 33 * 64; const float* w2 = F.a->in[I_HYW2] + l * 64 * 64; const float* w3 = F.a->in[I_HYW3] + l * 64 * 512;
    const float zt = (float)m / (float)(L - 1), wang = 6.283185307179586f * (float)m / (float)L;
    float zv = 0.f;
    if (lane == 0) zv = zt;
    else if (lane <= 16) { const float band = 1e-4f + (float)(lane - 1) * ((15.0f - 1e-4f) / 15.0f); zv = cosf(band * wang); }
    else if (lane <= 32) { const float band = 1e-4f + (float)(lane - 17) * ((15.0f - 1e-4f) / 15.0f); zv = -sinf(band * wang); }
    const float fr = F.a->in[I_HYFREQ][l * 64 + lane];
    float s = F.a->in[I_HYB1][l * 64 + lane];
    for (int i = 0; i < 33; ++i) s += __shfl(zv, i) * w1[i * 64 + lane];
    const float h1 = sinf(fr * s);
    s = F.a->in[I_HYB2][l * 64 + lane];
    for (int i = 0; i < 64; ++i) s += __shfl(h1, i) * w2[i * 64 + lane];
    const float h2 = sinf(fr * s);
    float h3[8] = {0.f, 0.f, 0.f, 0.f, 0.f, 0.f, 0.f, 0.f};
    for (int i = 0; i < 64; ++i) { const float hv = __shfl(h2, i);
#pragma unroll
        for (int q = 0; q < 8; ++q) h3[q] += hv * w3[i * 512 + q * 64 + lane]; }
    const int XL = 2 * L + 32;
    bf16* R = WSP(bf16, WS_FILT) + (size_t)l * FILT_LAYER + (sel ? 256 * XL0 : 0);
    const float da = logf(0.01f) / 0.3f, db = logf(0.01f) / 1.5f;
#pragma unroll
    for (int q = 0; q < 4; ++q) { const int c = q * 64 + lane; const float delta = fabsf(da + (float)c * ((db - da) / 255.0f)); const float win = expf(-zt * delta) + 0.05f;
        R[(size_t)c * XL + (L + 32 - m)] = (bf16)f2bf(h3[q] * win);
        if (m >= 1) R[(size_t)c * XL + (L + 32 + m)] = (bf16)f2bf(h3[q + 4] * win);
        if (m == 0) for (int i = 0; i <= 32; ++i) R[(size_t)c * XL + i] = 0; }
}
__device__ __forceinline__ void p0_phase(Frame& F) {
    LAS float* sv = (LAS float*)(F.lds + AUX_OFF);
    for (int i = F.tid; i < 5 * 1024; i += NTHR) { const int j = i >> 10, k = i & 1023; const float c = (j == 0) ? F.a->in[I_CCTX][k] : F.a->in[I_C][(j - 1) * 1024 + k]; sv[i] = c / (1.f + expf(-c)); }
    __syncthreads();
    LAS float* scr = (LAS float*)(F.lds + F.wave * 16384);
    const int gw = F.wave * F.G + F.bid, NGW = F.G * NWAVES;
    for (int it = gw; it < P0_ITEMS; it += NGW) {
        int r = it;
        if (r < IT_MOD) { p0_mod_item(F, r, sv); continue; } r -= IT_MOD;
        if (r < IT_FILT) { p0_filt_item(F, r); continue; } r -= IT_FILT;
        if (r < IT_ROPE) { const int t = r * 4 + (F.lane >> 4), e16 = F.lane & 15; const float pos = (float)((e16 < 8) ? (t >> 6) : (t & 63));
            const float x = pos * exp2f(-(float)(e16 & 7) * (13.287712379549449f / 8.0f));
            const float k = rintf(x * 0.15915494309189535f); float rr = fmaf(-k, 6.2831854820251465f, x); rr = fmaf(-k, -1.7484555e-07f, rr);
            float* T = WSP(float, WS_ROPE) + (size_t)t * 32; T[e16] = cosf(rr); T[16 + e16] = sinf(rr); continue; } r -= IT_ROPE;
        const int l = r / T_LAYER; r -= l * T_LAYER;
        if (r < T_IN) { const int kb = r / 61, nb = r % 61; tr_item(F.a->in[I_WIN] + (size_t)l * D * NIN, NIN, kb * 64, nb * 32, WSP(bf16, WS_WIN) + (size_t)l * NINP * D, D, nb * 32, nullptr, scr, F.lane); continue; } r -= T_IN;
        if (r < T_OUT) { const int kb = r / 32, nb = r % 32; tr_item(F.a->in[I_WOUT] + (size_t)l * D * D, D, kb * 64, nb * 32, WSP(bf16, WS_WOUT) + (size_t)l * D * D, D, nb * 32, F.a->in[I_GGRP] + l * D, scr, F.lane); continue; } r -= T_OUT;
        if (r < 2 * T_G) { const int up = r >= T_G; if (up) r -= T_G; const int kb = r / 88, nb = r % 88, u0 = nb * 32;
            tr_item(F.a->in[up ? I_WU : I_WG] + (size_t)l * D * DFF, DFF, kb * 64, u0, WSP(bf16, WS_WGU) + (size_t)l * NGU * D, D, (u0 >> 7) * 256 + up * 128 + (u0 & 127), nullptr, scr, F.lane); continue; } r -= 2 * T_G;
        if (r < T_D) { const int kb = r / 32, nb = r % 32; tr_item(F.a->in[I_WD] + (size_t)l * DFF * D, D, kb * 64, nb * 32, WSP(bf16, WS_WD) + (size_t)l * D * DFF, DFF, nb * 32, nullptr, scr, F.lane); continue; } r -= T_D;
        if (r < T_UQ) { const int kb = r / 24, nb = r % 24; tr_item(F.a->in[I_WUQ] + (size_t)l * QL * 768, 768, kb * 64, nb * 32, WSP(bf16, WS_WUQ) + (size_t)l * 768 * QL, QL, nb * 32, nullptr, scr, F.lane); continue; } r -= T_UQ;
        { const int kb = r / 32, nb = r % 32; tr_item(F.a->in[I_WUKV] + (size_t)l * KVL * 1024, 1024, kb * 64, nb * 32, WSP(bf16, WS_WUKV) + (size_t)l * 1024 * KVL, KVL, nb * 32, nullptr, scr, F.lane); }
    }
}

constexpr int AQ_LD = 264, AKV_LD = 136;
constexpr int QK_AQ = 0, QK_AKV = QK_AQ + 64 * AQ_LD * 2, QK_KPE = QK_AKV + 64 * AKV_LD * 2, QK_KSS = QK_KPE + 64 * 32 * 4, QK_KRS = QK_KSS + 64 * 4, QK_END = QK_KRS + 8 * 64 * 4;
static_assert(QK_END <= RING_BYTES, "qkv LDS");

template <bool FROM_CACHE>
__device__ __forceinline__ void qkv_unit(Frame& F, int l, int u) {
    LAS bf16* Aq = (LAS bf16*)(F.lds + QK_AQ); LAS bf16* Akv = (LAS bf16*)(F.lds + QK_AKV);
    LAS float* kpe = (LAS float*)(F.lds + QK_KPE); LAS float* kss = (LAS float*)(F.lds + QK_KSS); LAS float* krs = (LAS float*)(F.lds + QK_KRS);
    const int tid = F.tid, lane = F.lane, h = F.wave, f = lane & 15, g = lane >> 4;
    const int row0 = FROM_CACHE ? 0 : u * 64;
    const bool latent = FROM_CACHE ? false : (row0 >= MC);
    int t0, Lk; bf16* Kseg; bf16* Vtseg;
    if (FROM_CACHE) { const int ridx = (u & 15) * 64, b = ridx >> 8; t0 = 1024 + (ridx & 255); Lk = 1280;
        Kseg = WSP(bf16, WS_KL) + ((size_t)(l * 4 + b) * 1280) * 768; Vtseg = WSP(bf16, WS_VTL) + (size_t)(l * 4 + b) * 8 * 64 * 1280; }
    else if (latent) { const int b = (row0 - MC) >> 10; t0 = (row0 - MC) & 1023; Lk = 1280;
        Kseg = WSP(bf16, WS_KL) + ((size_t)(l * 4 + b) * 1280) * 768; Vtseg = WSP(bf16, WS_VTL) + (size_t)(l * 4 + b) * 8 * 64 * 1280; }
    else { const int b = row0 >> 8; t0 = row0 & 255; Lk = 256; Kseg = WSP(bf16, WS_KC) + ((size_t)b * 256) * 768; Vtseg = WSP(bf16, WS_VTC) + (size_t)b * 8 * 64 * 256; }
    {
        const int r = tid >> 3, s = tid & 7;
        if (!FROM_CACHE) {
            const bf16* prow = WSP(bf16, WS_PROJ) + (size_t)(row0 + r) * NINP;
            float v[32]; float ss = 0.f;
#pragma unroll
            for (int i = 0; i < 4; ++i) { const v4u w = *(const v4u*)(prow + O_CQ + s * 32 + i * 8);
                v[i * 8 + 0] = bflo(w.x); v[i * 8 + 1] = bfhi(w.x); v[i * 8 + 2] = bflo(w.y); v[i * 8 + 3] = bfhi(w.y); v[i * 8 + 4] = bflo(w.z); v[i * 8 + 5] = bfhi(w.z); v[i * 8 + 6] = bflo(w.w); v[i * 8 + 7] = bfhi(w.w); }
#pragma unroll
            for (int i = 0; i < 32; ++i) ss += v[i] * v[i];
            ss += __shfl_xor(ss, 1); ss += __shfl_xor(ss, 2); ss += __shfl_xor(ss, 4);
            const float rstd = rsqrtf(ss * (1.0f / QL) + EPS);
            const float* gq = F.a->in[I_GQ] + l * QL + s * 32;
#pragma unroll
            for (int i = 0; i < 4; ++i) { v4u o; o.x = pk2(v[i * 8 + 0] * rstd * gq[i * 8 + 0], v[i * 8 + 1] * rstd * gq[i * 8 + 1]); o.y = pk2(v[i * 8 + 2] * rstd * gq[i * 8 + 2], v[i * 8 + 3] * rstd * gq[i * 8 + 3]);
                o.z = pk2(v[i * 8 + 4] * rstd * gq[i * 8 + 4], v[i * 8 + 5] * rstd * gq[i * 8 + 5]); o.w = pk2(v[i * 8 + 6] * rstd * gq[i * 8 + 6], v[i * 8 + 7] * rstd * gq[i * 8 + 7]);
                *(LAS v4u*)(Aq + r * AQ_LD + s * 32 + i * 8) = o; }
        }
        float c[16], p[4];
        if (FROM_CACHE) { const int ridx = (u & 15) * 64 + r, b = ridx >> 8, t = ridx & 255;
            const float* ck = F.a->in[I_CCKV] + ((size_t)((b * 2 + l) * 256 + t)) * 128 + s * 16; const float* kp = F.a->in[I_CKPE] + ((size_t)((b * 2 + l) * 256 + t)) * 32 + s * 4;
#pragma unroll
            for (int i = 0; i < 4; ++i) { const f32x4 w = *(const f32x4*)(ck + i * 4); c[i * 4] = w.x; c[i * 4 + 1] = w.y; c[i * 4 + 2] = w.z; c[i * 4 + 3] = w.w; }
            const f32x4 w = *(const f32x4*)kp; p[0] = w.x; p[1] = w.y; p[2] = w.z; p[3] = w.w;
        } else { const bf16* prow = WSP(bf16, WS_PROJ) + (size_t)(row0 + r) * NINP;
#pragma unroll
            for (int i = 0; i < 2; ++i) { const v4u w = *(const v4u*)(prow + O_CKV + s * 16 + i * 8);
                c[i * 8 + 0] = bflo(w.x); c[i * 8 + 1] = bfhi(w.x); c[i * 8 + 2] = bflo(w.y); c[i * 8 + 3] = bfhi(w.y); c[i * 8 + 4] = bflo(w.z); c[i * 8 + 5] = bfhi(w.z); c[i * 8 + 6] = bflo(w.w); c[i * 8 + 7] = bfhi(w.w); }
            const v2u w = *(const v2u*)(prow + O_KPE + s * 4); p[0] = bflo(w.x); p[1] = bfhi(w.x); p[2] = bflo(w.y); p[3] = bfhi(w.y);
        }
        float ss = 0.f;
#pragma unroll
        for (int i = 0; i < 16; ++i) ss += c[i] * c[i];
        ss += __shfl_xor(ss, 1); ss += __shfl_xor(ss, 2); ss += __shfl_xor(ss, 4);
        const float rstd = rsqrtf(ss * (1.0f / KVL) + EPS);
        const float* gkv = F.a->in[I_GKV] + l * KVL + s * 16;
#pragma unroll
        for (int i = 0; i < 2; ++i) { v4u o; o.x = pk2(c[i * 8 + 0] * rstd * gkv[i * 8 + 0], c[i * 8 + 1] * rstd * gkv[i * 8 + 1]); o.y = pk2(c[i * 8 + 2] * rstd * gkv[i * 8 + 2], c[i * 8 + 3] * rstd * gkv[i * 8 + 3]);
            o.z = pk2(c[i * 8 + 4] * rstd * gkv[i * 8 + 4], c[i * 8 + 5] * rstd * gkv[i * 8 + 5]); o.w = pk2(c[i * 8 + 6] * rstd * gkv[i * 8 + 6], c[i * 8 + 7] * rstd * gkv[i * 8 + 7]);
            *(LAS v4u*)(Akv + r * AKV_LD + s * 16 + i * 8) = o; }
        float ps = p[0] * p[0] + p[1] * p[1] + p[2] * p[2] + p[3] * p[3];
        ps += __shfl_xor(ps, 1); ps += __shfl_xor(ps, 2); ps += __shfl_xor(ps, 4);
        *(LAS f32x4*)(kpe + r * 32 + s * 4) = (f32x4){p[0], p[1], p[2], p[3]};
        if (s == 0) kss[r] = ps;
    }
    __syncthreads();
    if (!FROM_CACHE) {
        const bf16* Wt = WSP(bf16, WS_WUQ) + (size_t)l * 768 * QL + (size_t)(h * QKD) * QL;
        f32x4 acc[4][6];
#pragma unroll
        for (int rt = 0; rt < 4; ++rt)
#pragma unroll
            for (int ct = 0; ct < 6; ++ct) acc[rt][ct] = (f32x4){0.f, 0.f, 0.f, 0.f};
#pragma unroll 1
        for (int kk = 0; kk < 8; ++kk) {
            bf16x8 a[4], b[6];
#pragma unroll
            for (int rt = 0; rt < 4; ++rt) a[rt] = *(const LAS bf16x8*)(Aq + (rt * 16 + f) * AQ_LD + kk * 32 + g * 8);
#pragma unroll
            for (int ct = 0; ct < 6; ++ct) b[ct] = *(const bf16x8*)(Wt + (size_t)(ct * 16 + f) * QL + kk * 32 + g * 8);
#pragma unroll
            for (int rt = 0; rt < 4; ++rt)
#pragma unroll
                for (int ct = 0; ct < 6; ++ct) acc[rt][ct] = __builtin_amdgcn_mfma_f32_16x16x32_bf16(a[rt], b[ct], acc[rt][ct], 0, 0, 0);
        }
        const float* gqh = F.a->in[I_GQH] + l * QKD;
        float gq[6];
#pragma unroll
        for (int ct = 0; ct < 6; ++ct) gq[ct] = gqh[ct * 16 + f];
        const float* RT = WSP(float, WS_ROPE);
        bf16* Qo = WSP(bf16, WS_Q);
#pragma unroll
        for (int rt = 0; rt < 4; ++rt)
#pragma unroll
            for (int i = 0; i < 4; ++i) {
                float ss = 0.f;
#pragma unroll
                for (int ct = 0; ct < 6; ++ct) ss += acc[rt][ct][i] * acc[rt][ct][i];
                ss += __shfl_xor(ss, 1); ss += __shfl_xor(ss, 2); ss += __shfl_xor(ss, 4); ss += __shfl_xor(ss, 8);
                const float rstd = rsqrtf(ss * (1.0f / QKD) + EPS);
                const int tok = rt * 16 + 4 * g + i, t = t0 + tok;
                float v[6];
#pragma unroll
                for (int ct = 0; ct < 6; ++ct) v[ct] = acc[rt][ct][i] * rstd * gq[ct];
                if (latent) {
#pragma unroll
                    for (int ct = 4; ct < 6; ++ct) { const float partner = __shfl_xor(v[ct], 8); const float cs = RT[(size_t)t * 32 + (ct - 4) * 8 + (f & 7)], sn = RT[(size_t)t * 32 + 16 + (ct - 4) * 8 + (f & 7)];
                        v[ct] = v[ct] * cs + (f < 8 ? -partner : partner) * sn; }
                }
                bf16* qrow = Qo + (size_t)(row0 + tok) * 768 + h * QKD + f;
#pragma unroll
                for (int ct = 0; ct < 6; ++ct) qrow[ct * 16] = (bf16)f2bf(v[ct] * QSCALE);
            }
    }
    {
        const bf16* Wt = WSP(bf16, WS_WUKV) + (size_t)l * 1024 * KVL + (size_t)(h * 128) * KVL;
        f32x4 acc[4][8];
#pragma unroll
        for (int rt = 0; rt < 4; ++rt)
#pragma unroll
            for (int ct = 0; ct < 8; ++ct) acc[rt][ct] = (f32x4){0.f, 0.f, 0.f, 0.f};
#pragma unroll 1
        for (int kk = 0; kk < 4; ++kk) {
            bf16x8 a[4], b[8];
#pragma unroll
            for (int rt = 0; rt < 4; ++rt) a[rt] = *(const LAS bf16x8*)(Akv + (rt * 16 + f) * AKV_LD + kk * 32 + g * 8);
#pragma unroll
            for (int ct = 0; ct < 8; ++ct) b[ct] = *(const bf16x8*)(Wt + (size_t)(ct * 16 + f) * KVL + kk * 32 + g * 8);
#pragma unroll
            for (int rt = 0; rt < 4; ++rt)
#pragma unroll
                for (int ct = 0; ct < 8; ++ct) acc[rt][ct] = __builtin_amdgcn_mfma_f32_16x16x32_bf16(a[rt], b[ct], acc[rt][ct], 0, 0, 0);
        }
        const float* gkh = F.a->in[I_GKH] + l * QKD;
        float gk[4];
#pragma unroll
        for (int ct = 0; ct < 4; ++ct) gk[ct] = gkh[ct * 16 + f];
#pragma unroll
        for (int rt = 0; rt < 4; ++rt) {
#pragma unroll
            for (int i = 0; i < 4; ++i) {
                float ss = 0.f;
#pragma unroll
                for (int ct = 0; ct < 4; ++ct) ss += acc[rt][ct][i] * acc[rt][ct][i];
                ss += __shfl_xor(ss, 1); ss += __shfl_xor(ss, 2); ss += __shfl_xor(ss, 4); ss += __shfl_xor(ss, 8);
                const int tok = rt * 16 + 4 * g + i;
                const float rstd = rsqrtf((ss + kss[tok]) * (1.0f / QKD) + EPS);
                if (f == 0) krs[h * 64 + tok] = rstd;
                bf16* krow = Kseg + (size_t)(t0 + tok) * 768 + h * QKD + f;
#pragma unroll
                for (int ct = 0; ct < 4; ++ct) krow[ct * 16] = (bf16)f2bf(acc[rt][ct][i] * rstd * gk[ct]);
            }
#pragma unroll
            for (int ct = 4; ct < 8; ++ct) { const int d = (ct - 4) * 16 + f;
                v2u o; o.x = pk2(acc[rt][ct][0], acc[rt][ct][1]); o.y = pk2(acc[rt][ct][2], acc[rt][ct][3]);
                *(v2u*)(Vtseg + ((size_t)h * 64 + d) * Lk + t0 + rt * 16 + 4 * g) = o; }
        }
        LDS_WAIT(); asm volatile("" ::: "memory");
        {
            const int tok = lane, t = t0 + tok; const float rs = krs[h * 64 + tok];
            float v[32];
#pragma unroll
            for (int i = 0; i < 8; ++i) { const f32x4 w = *(const LAS f32x4*)(kpe + tok * 32 + i * 4); v[i * 4] = w.x; v[i * 4 + 1] = w.y; v[i * 4 + 2] = w.z; v[i * 4 + 3] = w.w; }
#pragma unroll
            for (int i = 0; i < 32; ++i) v[i] *= rs * gkh[64 + i];
            if (latent) {
#pragma unroll
                for (int ax = 0; ax < 2; ++ax) { const float* RT = WSP(float, WS_ROPE) + (size_t)t * 32 + ax * 8;
#pragma unroll
                    for (int e = 0; e < 8; ++e) { const float cs = RT[e], sn = RT[16 + e]; const float A = v[ax * 16 + e], B = v[ax * 16 + 8 + e]; v[ax * 16 + e] = A * cs - B * sn; v[ax * 16 + 8 + e] = B * cs + A * sn; } }
            }
            bf16* krow = Kseg + (size_t)t * 768 + h * QKD + 64;
#pragma unroll
            for (int i = 0; i < 4; ++i) { v4u o; o.x = pk2(v[i * 8], v[i * 8 + 1]); o.y = pk2(v[i * 8 + 2], v[i * 8 + 3]); o.z = pk2(v[i * 8 + 4], v[i * 8 + 5]); o.w = pk2(v[i * 8 + 6], v[i * 8 + 7]); *(v4u*)(krow + i * 8) = o; }
        }
    }
    __syncthreads();
}

constexpr int P1_XROWS = M, P1_GG = 20, P1_BIAS = 2 * (NIN / 8 + NGU / 8);
constexpr int P1_ITEMS = P1_XROWS + P1_GG + P1_BIAS;
__device__ __forceinline__ void p1_phase(Frame& F) {
    const int gw = F.wave * F.G + F.bid, NGW = F.G * NWAVES, lane = F.lane;
    const float* MOD = WSP(float, WS_MOD);
    for (int it = gw; it < P1_ITEMS; it += NGW) {
        int r = it;
        if (r < P1_XROWS) {
            const float* xr = (r < MC) ? F.a->in[I_XP] + (size_t)r * D : F.a->in[I_XS] + (size_t)(r - MC) * D;
            const int j = modidx(r); const float* sc1 = MOD + (size_t)j * 6144 + 1024; const float* gn = F.a->in[I_GN1];
            f32x4 v[4]; float s = 0.f;
#pragma unroll
            for (int q = 0; q < 4; ++q) { v[q] = *(const f32x4*)(xr + 256 * q + 4 * lane); s += (v[q].x * v[q].x + v[q].y * v[q].y) + (v[q].z * v[q].z + v[q].w * v[q].w); }
            s = wave_sum(s);
            bf16* o = WSP(bf16, WS_XG) + (size_t)r * D;
#pragma unroll
            for (int q = 0; q < 4; ++q) { const int c = 256 * q + 4 * lane; const f32x4 g = *(const f32x4*)(gn + c); const f32x4 sc = *(const f32x4*)(sc1 + c);
                v2u w; w.x = pk2(v[q].x * g.x * (1.f + sc.x), v[q].y * g.y * (1.f + sc.y)); w.y = pk2(v[q].z * g.z * (1.f + sc.z), v[q].w * g.w * (1.f + sc.w)); *(v2u*)(o + c) = w; }
            if (lane == 0) WSP(float, WS_SSQ1P)[r] = s;
            continue;
        }
        r -= P1_XROWS;
        if (r < P1_GG) { const int l = r / 10, kind = (r % 10) / 5, j = r % 5;
            const float* gn = F.a->in[kind ? I_GN2 : I_GN1] + l * D; const float* sc = MOD + ((size_t)l * 5 + j) * 6144 + (kind ? 4096 : 1024);
            float* o = WSP(float, WS_GG) + ((size_t)(l * 2 + kind) * 5 + j) * D;
#pragma unroll
            for (int q = 0; q < 4; ++q) { const int c = 256 * q + 4 * lane; const f32x4 g = *(const f32x4*)(gn + c); const f32x4 s4 = *(const f32x4*)(sc + c); *(f32x4*)(o + c) = (f32x4){g.x * (1.f + s4.x), g.y * (1.f + s4.y), g.z * (1.f + s4.z), g.w * (1.f + s4.w)}; }
            continue;
        }
        r -= P1_GG;
        {
            const int per = NIN / 8 + NGU / 8, l = r / per; int q = r % per; const bool gu = q >= NIN / 8; if (gu) q -= NIN / 8;
            const bf16* Wt = gu ? WSP(bf16, WS_WGU) + (size_t)l * NGU * D : WSP(bf16, WS_WIN) + (size_t)l * NINP * D;
            float* bo = gu ? WSP(float, WS_BGU) + (size_t)l * 5 * NGU : WSP(float, WS_BIN) + (size_t)l * 5 * NINP; const int ldb = gu ? NGU : NINP;
            const float* shb = MOD + (size_t)l * 5 * 6144 + (gu ? 3072 : 0);
            float sh[5][16];
#pragma unroll
            for (int j = 0; j < 5; ++j)
#pragma unroll
                for (int hh = 0; hh < 2; ++hh)
#pragma unroll
                    for (int e = 0; e < 2; ++e) { const f32x4 w = *(const f32x4*)(shb + (size_t)j * 6144 + hh * 512 + lane * 8 + e * 4); sh[j][hh * 8 + e * 4] = w.x; sh[j][hh * 8 + e * 4 + 1] = w.y; sh[j][hh * 8 + e * 4 + 2] = w.z; sh[j][hh * 8 + e * 4 + 3] = w.w; }
            for (int n8 = 0; n8 < 8; ++n8) { const int n = q * 8 + n8; const bf16* wr = Wt + (size_t)n * D;
                float w[16];
#pragma unroll
                for (int hh = 0; hh < 2; ++hh) { const v4u x = *(const v4u*)(wr + hh * 512 + lane * 8); w[hh * 8] = bflo(x.x); w[hh * 8 + 1] = bfhi(x.x); w[hh * 8 + 2] = bflo(x.y); w[hh * 8 + 3] = bfhi(x.y); w[hh * 8 + 4] = bflo(x.z); w[hh * 8 + 5] = bfhi(x.z); w[hh * 8 + 6] = bflo(x.w); w[hh * 8 + 7] = bfhi(x.w); }
#pragma unroll
                for (int j = 0; j < 5; ++j) { float s = 0.f;
#pragma unroll
                    for (int e = 0; e < 16; ++e) s += w[e] * sh[j][e];
                    s = wave_sum(s); if (lane == 0) bo[(size_t)j * ldb + n] = s; }
            }
        }
    }
    for (int u = F.bid; u < 32; u += F.G) qkv_unit<true>(F, u >> 4, u);
}

__device__ __forceinline__ void prep_phase(Frame& F, int l) {
    for (int u = F.bid; u < M / 64; u += F.G) qkv_unit<false>(F, l, u);
    const bf16* P = WSP(bf16, WS_PROJ); float* Z = WSP(float, WS_Z); const float* cw = F.a->in[I_HYCONV] + l * 3 * 768;
    const int c = F.tid & 255;
    const float a0 = cw[256 + c], a1 = cw[768 + 256 + c], a2 = cw[1536 + 256 + c], b0 = cw[512 + c], b1 = cw[768 + 512 + c], b2 = cw[1536 + 512 + c];
    for (int u = F.bid; u < M / 2; u += F.G) {
        const int row = u * 2 + (F.tid >> 8); const int L = row < MC ? 256 : 1024, t = row < MC ? (row & 255) : ((row - MC) & 1023);
        const bf16* pr = P + (size_t)row * NINP;
        float x1 = a1 * bf2f(pr[256 + c]), v = b1 * bf2f(pr[512 + c]);
        if (t > 0) { x1 += a0 * bf2f(pr[256 + c - NINP]); v += b0 * bf2f(pr[512 + c - NINP]); }
        if (t < L - 1) { x1 += a2 * bf2f(pr[256 + c + NINP]); v += b2 * bf2f(pr[512 + c + NINP]); }
        Z[(size_t)row * 256 + c] = x1 * v;
    }
}

__device__ __forceinline__ void attn_unit(Frame& F, int l, bool latent, int seg, int h, int qb) {
    const int lane = F.lane, f = lane & 15, g = lane >> 4;
    const int Lk = latent ? 1280 : 256;
    const int qrow0 = (latent ? MC + seg * 1024 : seg * 256) + qb * 128 + F.wave * 16;
    const bf16* Kb = latent ? WSP(bf16, WS_KL) + ((size_t)(l * 4 + seg) * 1280) * 768 + h * QKD : WSP(bf16, WS_KC) + ((size_t)seg * 256) * 768 + h * QKD;
    const bf16* Vt = latent ? WSP(bf16, WS_VTL) + ((size_t)(l * 4 + seg) * 8 + h) * 64 * 1280 : WSP(bf16, WS_VTC) + ((size_t)seg * 8 + h) * 64 * 256;
    const bf16* Qp = WSP(bf16, WS_Q) + (size_t)(qrow0 + f) * 768 + h * QKD + g * 8;
    bf16x8 qB[3];
#pragma unroll
    for (int kk = 0; kk < 3; ++kk) qB[kk] = *(const bf16x8*)(Qp + kk * 32);
    float mrun = -1e30f, lsum = 0.f;
    f32x4 o[4];
#pragma unroll
    for (int dt = 0; dt < 4; ++dt) o[dt] = (f32x4){0.f, 0.f, 0.f, 0.f};
    for (int kb = 0; kb < Lk; kb += 32) {
        f32x4 s0 = (f32x4){0.f, 0.f, 0.f, 0.f}, s1 = s0;
        const bf16* kp = Kb + (size_t)(kb + f) * 768 + g * 8;
#pragma unroll
        for (int kk = 0; kk < 3; ++kk) { const bf16x8 k0 = *(const bf16x8*)(kp + kk * 32), k1 = *(const bf16x8*)(kp + 16 * 768 + kk * 32);
            s0 = __builtin_amdgcn_mfma_f32_16x16x32_bf16(k0, qB[kk], s0, 0, 0, 0); s1 = __builtin_amdgcn_mfma_f32_16x16x32_bf16(k1, qB[kk], s1, 0, 0, 0); }
        float mx = fmaxf(fmaxf(fmaxf(s0[0], s0[1]), fmaxf(s0[2], s0[3])), fmaxf(fmaxf(s1[0], s1[1]), fmaxf(s1[2], s1[3])));
        mx = fmaxf(mx, __shfl_xor(mx, 16)); mx = fmaxf(mx, __shfl_xor(mx, 32));
        const float mnew = fmaxf(mrun, mx), alpha = exp2f(mrun - mnew); mrun = mnew;
        float p0[4], p1[4]; float ps = 0.f;
#pragma unroll
        for (int i = 0; i < 4; ++i) { p0[i] = exp2f(s0[i] - mnew); p1[i] = exp2f(s1[i] - mnew); ps += p0[i] + p1[i]; }
        lsum = lsum * alpha + ps;
        v4u pw; pw.x = pk2(p0[0], p0[1]); pw.y = pk2(p0[2], p0[3]); pw.z = pk2(p1[0], p1[1]); pw.w = pk2(p1[2], p1[3]);
        const bf16x8 pB = __builtin_bit_cast(bf16x8, pw);
#pragma unroll
        for (int dt = 0; dt < 4; ++dt) { const bf16* vp = Vt + (size_t)(dt * 16 + f) * Lk + kb + 4 * g;
            const v2u lo = *(const v2u*)vp, hi = *(const v2u*)(vp + 16); v4u vw; vw.x = lo.x; vw.y = lo.y; vw.z = hi.x; vw.w = hi.y;
            o[dt] = o[dt] * alpha; o[dt] = __builtin_amdgcn_mfma_f32_16x16x32_bf16(__builtin_bit_cast(bf16x8, vw), pB, o[dt], 0, 0, 0); }
    }
    lsum += __shfl_xor(lsum, 16); lsum += __shfl_xor(lsum, 32);
    const float inv = 1.0f / lsum; float ss = 0.f;
    bf16* yo = WSP(bf16, WS_YMIX) + (size_t)(qrow0 + f) * D + 512 + h * 64 + 4 * g;
#pragma unroll
    for (int dt = 0; dt < 4; ++dt) { const f32x4 v = o[dt] * inv; v2u w; w.x = pk2(v[0], v[1]); w.y = pk2(v[2], v[3]); *(v2u*)(yo + dt * 16) = w;
        const float r0 = bflo(w.x), r1 = bfhi(w.x), r2 = bflo(w.y), r3 = bfhi(w.y); ss += (r0 * r0 + r1 * r1) + (r2 * r2 + r3 * r3); }
    ss += __shfl_xor(ss, 16); ss += __shfl_xor(ss, 32);
    if (g == 0) WSP(float, WS_SSQAT)[(size_t)h * M + qrow0 + f] = ss;
}
__device__ __forceinline__ void hyena_unit_v1(Frame& F, int l, int u) {
    const int c = F.tid & 255, tr = F.tid >> 8;
    const int row0 = u * 16; const bool latent = row0 >= MC; const int L = latent ? 1024 : 256, XL = 2 * L + 32;
    const int seg0 = latent ? MC + ((row0 - MC) & ~1023) : (row0 & ~255); const int t0 = row0 - seg0 + tr * 8;
    const bf16* R = WSP(bf16, WS_FILT) + (size_t)l * FILT_LAYER + (latent ? 256 * XL0 : 0) + (size_t)c * XL;
    const float* Z = WSP(float, WS_Z) + (size_t)seg0 * 256 + c;
    const int idx0 = L + 32 - t0;
    float acc[8], w[16];
#pragma unroll
    for (int i = 0; i < 8; ++i) acc[i] = 0.f;
    { const v4u x = *(const v4u*)(R + idx0 - 8); w[8] = bflo(x.x); w[9] = bfhi(x.x); w[10] = bflo(x.y); w[11] = bfhi(x.y); w[12] = bflo(x.z); w[13] = bfhi(x.z); w[14] = bflo(x.w); w[15] = bfhi(x.w); }
    for (int s = 0; s < L; s += 8) {
#pragma unroll
        for (int k = 0; k < 8; ++k) w[k] = w[k + 8];
        const v4u x = *(const v4u*)(R + idx0 + s); w[8] = bflo(x.x); w[9] = bfhi(x.x); w[10] = bflo(x.y); w[11] = bfhi(x.y); w[12] = bflo(x.z); w[13] = bfhi(x.z); w[14] = bflo(x.w); w[15] = bfhi(x.w);
#pragma unroll
        for (int e = 0; e < 8; ++e) { const float zv = Z[(size_t)(s + e) * 256];
#pragma unroll
            for (int i = 0; i < 8; ++i) acc[i] += zv * w[8 + e - i]; }
    }
    const float bias = F.a->in[I_HYBIAS][l * 256 + c];
    const float* cw = F.a->in[I_HYCONV] + l * 3 * 768; const float w0 = cw[c], w1 = cw[768 + c], w2 = cw[1536 + c];
    const bf16* P = WSP(bf16, WS_PROJ); bf16* Y = WSP(bf16, WS_YMIX); float* ssq = (float*)(F.ws + WS_CTL + CTL_SSQHY) + (size_t)l * M;
#pragma unroll
    for (int i = 0; i < 8; ++i) { const int t = t0 + i, row = seg0 + t; const bf16* pr = P + (size_t)row * NINP + c;
        float x0 = w1 * bf2f(pr[0]); if (t > 0) x0 += w0 * bf2f(pr[-NINP]); if (t < L - 1) x0 += w2 * bf2f(pr[NINP]);
        const float y = acc[i] + Z[(size_t)t * 256] * bias; const unsigned short ob = (unsigned short)f2bf(x0 * y); Y[(size_t)row * D + c] = ob;
        const float of = bf2f(ob); const float s = wave_sum(of * of); if (F.lane == 0) atomicAdd(ssq + row, s); }
}
__device__ __forceinline__ void sconv_rows(Frame& F, int l, int u) {
    const int row = u * 8 + F.wave, c4 = F.lane * 4; const bool latent = row >= MC; const int L = latent ? 1024 : 256, t = latent ? ((row - MC) & 1023) : (row & 255);
    const bf16* pr = WSP(bf16, WS_PROJ) + (size_t)row * NINP + O_SC + c4; const float* cw = F.a->in[I_SCCONV] + l * 3 * 256 + c4;
    float conv[4] = {0.f, 0.f, 0.f, 0.f};
#pragma unroll
    for (int dr = -1; dr <= 1; ++dr) { if (t + dr < 0 || t + dr >= L) continue;
        const v2u cg_ = *(const v2u*)(pr + dr * NINP + 256), hx = *(const v2u*)(pr + dr * NINP + 512); const f32x4 w = *(const f32x4*)(cw + (dr + 1) * 256);
        conv[0] += w.x * bflo(cg_.x) * bflo(hx.x); conv[1] += w.y * bfhi(cg_.x) * bfhi(hx.x); conv[2] += w.z * bflo(cg_.y) * bflo(hx.y); conv[3] += w.w * bfhi(cg_.y) * bfhi(hx.y); }
    const v2u bg = *(const v2u*)pr;
    v2u o; o.x = pk2(bflo(bg.x) * conv[0], bfhi(bg.x) * conv[1]); o.y = pk2(bflo(bg.y) * conv[2], bfhi(bg.y) * conv[3]);
    *(v2u*)(WSP(bf16, WS_YMIX) + (size_t)row * D + 256 + c4) = o;
    const float r0 = bflo(o.x), r1 = bfhi(o.x), r2 = bflo(o.y), r3 = bfhi(o.y);
    const float s = wave_sum((r0 * r0 + r1 * r1) + (r2 * r2 + r3 * r3)); if (F.lane == 0) WSP(float, WS_SSQSC)[row] = s;
}
constexpr int MX_ATL = 256, MX_ATC = 256, MX_HY = M / 16, MX_SC = M / 8, MX_UNITS = MX_ATL + MX_ATC + MX_HY + MX_SC;
__device__ __forceinline__ void mix_phase(Frame& F, int l) {
    for (int u = F.bid; u < MX_UNITS; u += F.G) {
        int r = u;
        if (r < MX_ATL) { attn_unit(F, l, true, r >> 6, (r >> 3) & 7, r & 7); continue; } r -= MX_ATL;
        if (r < MX_ATC) { attn_unit(F, l, false, r >> 4, (r >> 1) & 7, r & 1); continue; } r -= MX_ATC;
        if (r < MX_HY) { hyena_unit_v1(F, l, r); continue; } r -= MX_HY;
        sconv_rows(F, l, r);
    }
}

#define AUXT(par, k) (aux + ((par) * 3 + (k)) * 256)
struct EpiBase {
    LAS float* aux; int tid;
    __device__ __forceinline__ void rescale(pg8::f32x4 (&acc)[2][2][4][2], int which, int par, int wr, int fr) const {
        const LAS float* T = AUXT(par, 1 + which);
#pragma unroll
        for (int ai = 0; ai < 2; ++ai)
#pragma unroll
            for (int m = 0; m < 4; ++m) { const float s = T[ai * 128 + wr * 64 + m * 16 + fr];
#pragma unroll
                for (int bj = 0; bj < 2; ++bj)
#pragma unroll
                    for (int n = 0; n < 2; ++n) acc[ai][bj][m][n] = acc[ai][bj][m][n] * s; }
    }
};
struct EpiIn : EpiBase {
    static constexpr bool PERM = true, KRESCALE = false;
    const float* ssqp; int np; const float* bias; bf16* proj; float* out; int l;
    __device__ __forceinline__ void prep(const pg8::Unit& u, int par) const {
        if (tid < 256) { const int row = u.pm * 256 + tid; float s = 0.f;
#pragma unroll 1
            for (int p = 0; p < np; ++p) s += ssqp[(size_t)p * M + row]; AUXT(par, 0)[tid] = rsqrtf(s * (1.0f / D) + EPS); }
    }
    __device__ __forceinline__ void operator()(const pg8::f32x4 (&acc)[2][2][4][2], const pg8::Unit& u, int wr, int wc, int fr, int fq, int par) const {
        const int row0 = u.pm * 256 + wr * 64 + fr, j = modidx(u.pm * 256); const LAS float* T = AUXT(par, 0);
        const float* bp = bias + (size_t)j * NINP + u.pn * 256 + wc * 32 + 8 * fq;
        f32x4 bv[2][2];
#pragma unroll
        for (int bj = 0; bj < 2; ++bj)
#pragma unroll
            for (int n = 0; n < 2; ++n) bv[bj][n] = *(const f32x4*)(bp + bj * 128 + 4 * n);
#pragma unroll
        for (int ai = 0; ai < 2; ++ai)
#pragma unroll
            for (int m = 0; m < 4; ++m) { const int row = row0 + ai * 128 + m * 16; const float rs = T[ai * 128 + wr * 64 + m * 16 + fr];
#pragma unroll
                for (int bj = 0; bj < 2; ++bj) { const f32x4 v0 = acc[ai][bj][m][0] * rs + bv[bj][0], v1 = acc[ai][bj][m][1] * rs + bv[bj][1];
                    const int col = u.pn * 256 + bj * 128 + wc * 32 + 8 * fq;
                    v4u w; w.x = pk2(v0[0], v0[1]); w.y = pk2(v0[2], v0[3]); w.z = pk2(v1[0], v1[1]); w.w = pk2(v1[2], v1[3]);
                    *(v4u*)(proj + (size_t)row * NINP + col) = w;
                    if (u.pn == 7 && row < MC && col < NIN) { const int b = row >> 8, t = row & 255;
                        float* o = (col < O_KPE) ? out + OUT_CKV + ((size_t)((b * 2 + l) * 256 + t)) * 128 + (col - O_CKV) : out + OUT_KPE + ((size_t)((b * 2 + l) * 256 + t)) * 32 + (col - O_KPE);
                        *(f32x4*)o = v0; *(f32x4*)(o + 4) = v1; } } }
    }
};
struct EpiOut : EpiBase {
    static constexpr bool PERM = true, KRESCALE = true;
    const float* ssq_hy; const float* ssq_sc; const float* ssq_at; const float* xa; const float* xb; float* xr; bf16* xg; const float* g1; const float* gg2; float* ssqp;
    __device__ __forceinline__ void prep(const pg8::Unit& u, int par) const {
        if (tid < 256) { const int row = u.pm * 256 + tid; float sa = 0.f;
#pragma unroll 1
            for (int h = 0; h < 8; ++h) sa += ssq_at[(size_t)h * M + row];
            const float rh = rsqrtf(ssq_hy[row] * (1.0f / 256) + EPS), rs = rsqrtf(ssq_sc[row] * (1.0f / 256) + EPS), ra = rsqrtf(sa * (1.0f / 512) + EPS);
            AUXT(par, 0)[tid] = ra; AUXT(par, 1)[tid] = rh / rs; AUXT(par, 2)[tid] = rs / ra; }
    }
    __device__ __forceinline__ void operator()(const pg8::f32x4 (&acc)[2][2][4][2], const pg8::Unit& u, int wr, int wc, int fr, int fq, int par) const {
        const int row0 = u.pm * 256 + wr * 64 + fr, j = modidx(u.pm * 256); const LAS float* T = AUXT(par, 0);
        const float* xin = (u.pm * 256 < MC) ? xa : xb;
        const int cb = u.pn * 256 + wc * 32 + 8 * fq;
#pragma unroll
        for (int ai = 0; ai < 2; ++ai)
#pragma unroll
            for (int m = 0; m < 4; ++m) { const int row = row0 + ai * 128 + m * 16; const float rs = T[ai * 128 + wr * 64 + m * 16 + fr]; float ss = 0.f;
#pragma unroll
                for (int bj = 0; bj < 2; ++bj) { const int col = cb + bj * 128; v4u w;
#pragma unroll
                    for (int n = 0; n < 2; ++n) { const f32x4 gv = *(const f32x4*)(g1 + (size_t)j * 6144 + col + 4 * n), gg = *(const f32x4*)(gg2 + (size_t)j * D + col + 4 * n);
                        const f32x4 xv = *(const f32x4*)(xin + (size_t)row * D + col + 4 * n); const f32x4 x1 = xv + gv * (acc[ai][bj][m][n] * rs);
                        *(f32x4*)(xr + (size_t)row * D + col + 4 * n) = x1; ss += (x1[0] * x1[0] + x1[1] * x1[1]) + (x1[2] * x1[2] + x1[3] * x1[3]);
                        const f32x4 y = x1 * gg; if (n == 0) { w.x = pk2(y[0], y[1]); w.y = pk2(y[2], y[3]); } else { w.z = pk2(y[0], y[1]); w.w = pk2(y[2], y[3]); } }
                    *(v4u*)(xg + (size_t)row * D + col) = w; }
                ss += __shfl_xor(ss, 16); ss += __shfl_xor(ss, 32);
                if (fq == 0) ssqp[(size_t)(u.pn * 4 + wc) * M + row] = ss; }
    }
};
struct EpiUp : EpiBase {
    static constexpr bool PERM = true, KRESCALE = false;
    const float* ssqp; const float* bias; bf16* act;
    __device__ __forceinline__ void prep(const pg8::Unit& u, int par) const {
        if (tid < 256) { const int row = u.pm * 256 + tid; float s = 0.f;
#pragma unroll 1
            for (int p = 0; p < 16; ++p) s += ssqp[(size_t)p * M + row];
            AUXT(par, 0)[tid] = rsqrtf(s * (1.0f / D) + EPS); }
    }
    __device__ __forceinline__ void operator()(const pg8::f32x4 (&acc)[2][2][4][2], const pg8::Unit& u, int wr, int wc, int fr, int fq, int par) const {
        const int row0 = u.pm * 256 + wr * 64 + fr, j = modidx(u.pm * 256); const LAS float* T = AUXT(par, 0);
        const float* bp = bias + (size_t)j * NGU + u.pn * 256 + wc * 32 + 8 * fq;
        f32x4 bv[2][2];
#pragma unroll
        for (int bj = 0; bj < 2; ++bj)
#pragma unroll
            for (int n = 0; n < 2; ++n) bv[bj][n] = *(const f32x4*)(bp + bj * 128 + 4 * n);
#pragma unroll
        for (int ai = 0; ai < 2; ++ai)
#pragma unroll
            for (int m = 0; m < 4; ++m) { const int row = row0 + ai * 128 + m * 16; const float rs = T[ai * 128 + wr * 64 + m * 16 + fr]; float a[8];
#pragma unroll
                for (int n = 0; n < 2; ++n) { const f32x4 gt = acc[ai][0][m][n] * rs + bv[0][n], up = acc[ai][1][m][n] * rs + bv[1][n];
#pragma unroll
                    for (int e = 0; e < 4; ++e) a[n * 4 + e] = gt[e] / (1.0f + __expf(-gt[e])) * up[e]; }
                v4u w; w.x = pk2(a[0], a[1]); w.y = pk2(a[2], a[3]); w.z = pk2(a[4], a[5]); w.w = pk2(a[6], a[7]);
                *(v4u*)(act + (size_t)row * DFF + u.pn * 128 + wc * 32 + 8 * fq) = w; }
    }
};
struct EpiDown : EpiBase {
    static constexpr bool PERM = true, KRESCALE = false;
    const float* xr; float* xo; bf16* xg; const float* g2; const float* gg1n; float* ssqp; int last;
    __device__ __forceinline__ void prep(const pg8::Unit&, int) const {}
    __device__ __forceinline__ void operator()(const pg8::f32x4 (&acc)[2][2][4][2], const pg8::Unit& u, int wr, int wc, int fr, int fq, int) const {
        const int row0 = u.pm * 256 + wr * 64 + fr, j = modidx(u.pm * 256);
        const int cb = u.pn * 256 + wc * 32 + 8 * fq;
#pragma unroll
        for (int ai = 0; ai < 2; ++ai)
#pragma unroll
            for (int m = 0; m < 4; ++m) { const int row = row0 + ai * 128 + m * 16; float ss = 0.f;
#pragma unroll
                for (int bj = 0; bj < 2; ++bj) { const int col = cb + bj * 128; v4u w;
#pragma unroll
                    for (int n = 0; n < 2; ++n) { const f32x4 gv = *(const f32x4*)(g2 + (size_t)j * 6144 + col + 4 * n);
                        const f32x4 xv = *(const f32x4*)(xr + (size_t)row * D + col + 4 * n); const f32x4 x2 = xv + gv * acc[ai][bj][m][n];
                        *(f32x4*)(xo + (size_t)row * D + col + 4 * n) = x2;
                        if (!last) { const f32x4 gg = *(const f32x4*)(gg1n + (size_t)j * D + col + 4 * n); ss += (x2[0] * x2[0] + x2[1] * x2[1]) + (x2[2] * x2[2] + x2[3] * x2[3]);
                            const f32x4 y = x2 * gg; if (n == 0) { w.x = pk2(y[0], y[1]); w.y = pk2(y[2], y[3]); } else { w.z = pk2(y[0], y[1]); w.w = pk2(y[2], y[3]); } } }
                    if (!last) *(v4u*)(xg + (size_t)row * D + col) = w; }
                if (!last) { ss += __shfl_xor(ss, 16); ss += __shfl_xor(ss, 32); if (fq == 0) ssqp[(size_t)(u.pn * 4 + wc) * M + row] = ss; } }
    }
};

template <int KM> __global__ void __launch_bounds__(NTHR, 2) mk_fwd(Args args) {
    extern __shared__ __attribute__((aligned(16))) unsigned char lds[];
    Frame F;
    F.lds = (LAS unsigned char*)lds; F.tid = threadIdx.x; F.lane = F.tid & 63; F.wave = __builtin_amdgcn_readfirstlane(F.tid >> 6);
    F.G = gridDim.x; F.bid = blockIdx.x; F.a = &args; F.ws = args.ws;
    LAS float* aux = (LAS float*)(F.lds + AUX_OFF);
    float* MOD = WSP(float, WS_MOD); float* GG = WSP(float, WS_GG);
    for (int ph = args.ph_lo; ph < args.ph_hi; ++ph) {
        if (ph == 0) { if constexpr (KM & 1) p0_phase(F); }
        else if (ph == 1) { if constexpr (KM & 2) p1_phase(F); }
        else {
            const int l = (ph - 2) / 6, k = (ph - 2) % 6;
            if (k == 0) { if constexpr (KM & 4) {
                pg8::Gemm g{WSP(bf16, WS_XG), WSP(bf16, WS_WIN) + (size_t)l * NINP * D, M, NINP, D}; pg8::StaticOrder S; S.init(M, NINP, F.G, F.bid);
                EpiIn E; E.aux = aux; E.tid = F.tid; E.ssqp = WSP(float, WS_SSQ1P); E.np = l == 0 ? 1 : 16; E.bias = WSP(float, WS_BIN) + (size_t)l * 5 * NINP; E.proj = WSP(bf16, WS_PROJ); E.out = args.out; E.l = l;
                pg8::gemm_phase<EpiIn, pg8::StaticOrder, true, true>(F.lds, g, S, E);
            } } else if (k == 1) { if constexpr (KM & 8) prep_phase(F, l); }
            else if (k == 2) { if constexpr (KM & 16) mix_phase(F, l); }
            else if (k == 3) { if constexpr (KM & 32) {
                pg8::Gemm g{WSP(bf16, WS_YMIX), WSP(bf16, WS_WOUT) + (size_t)l * D * D, M, D, D}; pg8::StaticOrder S; S.init(M, D, F.G, F.bid);
                EpiOut E; E.aux = aux; E.tid = F.tid; E.ssq_hy = (const float*)(F.ws + WS_CTL + CTL_SSQHY) + (size_t)l * M; E.ssq_sc = WSP(float, WS_SSQSC); E.ssq_at = WSP(float, WS_SSQAT);
                E.xa = l == 0 ? args.in[I_XP] : WSP(float, WS_XR); E.xb = l == 0 ? args.in[I_XS] - (size_t)MC * D : WSP(float, WS_XR); E.xr = WSP(float, WS_XR); E.xg = WSP(bf16, WS_XG);
                E.g1 = MOD + (size_t)l * 5 * 6144 + 2048; E.gg2 = GG + (size_t)((l * 2 + 1) * 5) * D; E.ssqp = WSP(float, WS_SSQ2P);
                pg8::gemm_phase<EpiOut, pg8::StaticOrder, true, true>(F.lds, g, S, E);
            } } else if (k == 4) { if constexpr (KM & 64) {
                pg8::Gemm g{WSP(bf16, WS_XG), WSP(bf16, WS_WGU) + (size_t)l * NGU * D, M, NGU, D}; pg8::StaticOrder S; S.init(M, NGU, F.G, F.bid);
                EpiUp E; E.aux = aux; E.tid = F.tid; E.ssqp = WSP(float, WS_SSQ2P); E.bias = WSP(float, WS_BGU) + (size_t)l * 5 * NGU; E.act = WSP(bf16, WS_ACT);
                pg8::gemm_phase<EpiUp, pg8::StaticOrder, true, true>(F.lds, g, S, E);
            } } else { if constexpr (KM & 128) {
                pg8::Gemm g{WSP(bf16, WS_ACT), WSP(bf16, WS_WD) + (size_t)l * D * DFF, M, D, DFF}; pg8::StaticOrder S; S.init(M, D, F.G, F.bid);
                EpiDown E; E.aux = aux; E.tid = F.tid; E.xr = WSP(float, WS_XR); E.xo = l == 1 ? args.out : WSP(float, WS_XR); E.xg = WSP(bf16, WS_XG);
                E.g2 = MOD + (size_t)l * 5 * 6144 + 5120; E.gg1n = GG + (size_t)((l == 1 ? 0 : (l + 1) * 2) * 5) * D; E.ssqp = WSP(float, WS_SSQ1P); E.last = (l == 1);
                pg8::gemm_phase<EpiDown, pg8::StaticOrder, true, true>(F.lds, g, S, E);
            } }
        }
        if (args.use_bar && ph + 1 < args.ph_hi) { __threadfence(); cg::this_grid().sync(); }
    }
}

extern "C" void kernel_launch(void* const* d_in, const int* in_sizes, int n_in, void* d_out, int out_size, void* d_ws, size_t ws_size, hipStream_t stream) {
    static int grid = 0;
    if (grid == 0) {
        if (n_in != 31 || ws_size < WS_END) { fprintf(stderr, "kernel_launch: expected 31 inputs and >= %zu bytes of workspace; got %d, %zu\n", (size_t)WS_END, n_in, ws_size); grid = -1; return; }
        int dev = 0, cus = 0;
        if (hipGetDevice(&dev) != hipSuccess || hipDeviceGetAttribute(&cus, hipDeviceAttributeMultiprocessorCount, dev) != hipSuccess) { grid = -1; return; }
        const void* ks[8] = {(const void*)mk_fwd<1>, (const void*)mk_fwd<2>, (const void*)mk_fwd<4>, (const void*)mk_fwd<8>, (const void*)mk_fwd<16>, (const void*)mk_fwd<32>, (const void*)mk_fwd<64>, (const void*)mk_fwd<128>};
        for (int i = 0; i < 8; ++i) if (hipFuncSetAttribute(ks[i], hipFuncAttributeMaxDynamicSharedMemorySize, LDS_BYTES) != hipSuccess) { fprintf(stderr, "kernel_launch: hipFuncSetAttribute failed\n"); grid = -1; return; }
        grid = cus > 0 ? cus : 256;
    }
    if (grid < 0) return;
    (void)hipMemsetAsync((char*)d_ws + WS_CTL, 0, CTL_ZERO_BYTES, stream);
    Args a{};
    for (int i = 0; i < 31; ++i) a.in[i] = (const float*)d_in[i];
    a.out = (float*)d_out; a.ws = (unsigned char*)d_ws;
    for (int ph = 0; ph < N_PHASES; ++ph) {
        a.ph_lo = ph; a.ph_hi = ph + 1; a.use_bar = 0; a.pad = 0;
        const int kind = ph < 2 ? ph : 2 + (ph - 2) % 6;
        switch (kind) {
            case 0: hipLaunchKernelGGL(mk_fwd<1>, dim3(grid), dim3(NTHR), LDS_BYTES, stream, a); break;
            case 1: hipLaunchKernelGGL(mk_fwd<2>, dim3(grid), dim3(NTHR), LDS_BYTES, stream, a); break;
            case 2: hipLaunchKernelGGL(mk_fwd<4>, dim3(grid), dim3(NTHR), LDS_BYTES, stream, a); break;
            case 3: hipLaunchKernelGGL(mk_fwd<8>, dim3(grid), dim3(NTHR), LDS_BYTES, stream, a); break;
            case 4: hipLaunchKernelGGL(mk_fwd<16>, dim3(grid), dim3(NTHR), LDS_BYTES, stream, a); break;
            case 5: hipLaunchKernelGGL(mk_fwd<32>, dim3(grid), dim3(NTHR), LDS_BYTES, stream, a); break;
            case 6: hipLaunchKernelGGL(mk_fwd<64>, dim3(grid), dim3(NTHR), LDS_BYTES, stream, a); break;
            default: hipLaunchKernelGGL(mk_fwd<128>, dim3(grid), dim3(NTHR), LDS_BYTES, stream, a); break;
        }
    }
}
```

```cpp
#include <hip/hip_runtime.h>
#include <hip/hip_cooperative_groups.h>
#include <cstdio>
#include <cstdint>
namespace cg = cooperative_groups;

namespace pg8 {
#define PG8_LAS __attribute__((address_space(3)))
typedef unsigned short bf16_t;
typedef short bf16x8 __attribute__((ext_vector_type(8)));
typedef float f32x4 __attribute__((ext_vector_type(4)));
typedef unsigned u32x4 __attribute__((ext_vector_type(4)));
constexpr int BM = 256, BK = 64, HALF = 128, HTB = HALF * BK * 2  , STAGE_BYTES = 8 * HTB, NXCD = 8, WGM = 8;

__host__ __device__ __forceinline__ int lds_byte(int r, int c) { const int st = (r >> 4) * 2 + (c >> 5), rr = r & 15, cc = c & 31, ob = rr * 64 + cc * 2; return st * 1024 + (ob ^ (((ob >> 9) & 1) << 5)); }
__host__ __device__ __forceinline__ void stage_rc(int b, int& R, int& C) { const int st = b / 1024, sb = b % 1024, swz = sb ^ (((sb >> 9) & 1) << 5); R = (st >> 1) * 16 + swz / 64; C = (st & 1) * 32 + (swz % 64) / 2; }
__host__ __device__ __forceinline__ int perm32(int rho) { const int n = rho >> 4, i = rho & 15; return 8 * (i >> 2) + 4 * n + (i & 3); }

struct Unit { int pm, pn; };
struct Gemm { const bf16_t* A; const bf16_t* Bt; int M, N, K; };

struct StaticOrder {
    int nM, nN, nwg, G, c;
    __host__ __device__ void init(int M, int N, int G_, int c_) { nM = M / BM; nN = N / BM; nwg = nM * nN; G = G_; c = c_; }
    __host__ __device__ bool next(int i, Unit& u) const {
        const long L = (long)i * G + c; if (L >= nwg) return false;
        int wgid = (int)L; { const int q = nwg / NXCD, r = nwg % NXCD, xcd = wgid % NXCD, off = wgid / NXCD; wgid = (xcd < r ? xcd * (q + 1) : r * (q + 1) + (xcd - r) * q) + off; }
        const int nig = WGM * nN, gid = wgid / nig, fm = gid * WGM, gsz = (nM - fm) < WGM ? (nM - fm) : WGM;
        u.pm = fm + ((wgid % nig) % gsz); u.pn = (wgid % nig) / gsz; return true;
    }
};
__device__ __forceinline__ unsigned cvt_pk_bf16(float lo, float hi) { unsigned r; asm volatile("v_cvt_pk_bf16_f32 %0, %1, %2" : "=v"(r) : "v"(lo), "v"(hi)); return r; }

template <class Epi, class Sched, bool ALIGN_EPI = false, bool SP2 = false>
__device__ __forceinline__ void gemm_phase(PG8_LAS unsigned char* lds, const Gemm g, const Sched& S, const Epi& E, int tid_in) {
    int tid_ = tid_in; asm volatile("" : "+v"(tid_));
    const int tid = tid_, wid = __builtin_amdgcn_readfirstlane(tid >> 6), lane = tid & 63, wr = wid >> 2, wc = wid & 3, fr = lane & 15, fq = lane >> 4;
    const int K = g.K, nt = K / BK;
    unsigned voffA[2], voffB[2];
#pragma unroll
    for (int i = 0; i < 2; ++i) { int R, C; stage_rc(tid * 16 + i * 8192, R, C); const int Rb = Epi::PERM ? ((R & ~31) + perm32(R & 31)) : R;
        voffA[i] = (unsigned)(R * K + C) * 2u; voffB[i] = (unsigned)(Rb * K + C) * 2u; }
    const size_t kstep = (size_t)(BK * 2);
    const size_t hstep = (size_t)HALF * K * 2;
    const size_t tstep = 2 * hstep;
    const unsigned ldsw = (unsigned)wid * 1024u;
    const int aoff = lds_byte(wr * 64 + fr, fq * 8), boff = lds_byte(wc * 32 + fr, fq * 8);
#define PG8_SA(b, h) (((b) * 2 + (h)) * HTB)
#define PG8_SB(b, h) ((4 + (b) * 2 + (h)) * HTB)
#define PG8_STAGE(bufoff, gbase, voff) do { _Pragma("unroll") for (int _i = 0; _i < 2; ++_i) \
        __builtin_amdgcn_global_load_lds((const unsigned*)((const char*)(gbase) + (voff)[_i]), (PG8_LAS unsigned*)(lds + (bufoff) + ldsw + _i * 8192), 16, 0, 0); } while (0)
#define PG8_LDA(dst, b, h) do { _Pragma("unroll") for (int m = 0; m < 4; ++m) _Pragma("unroll") for (int k = 0; k < 2; ++k) dst[m][k] = *(const PG8_LAS bf16x8*)(lds + PG8_SA(b, h) + aoff + m * 2048 + k * 1024); } while (0)
#define PG8_LDB(dst, b, h) do { _Pragma("unroll") for (int n = 0; n < 2; ++n) _Pragma("unroll") for (int k = 0; k < 2; ++k) dst[n][k] = *(const PG8_LAS bf16x8*)(lds + PG8_SB(b, h) + boff + n * 2048 + k * 1024); } while (0)
#define PG8_MMA(ai, bj, At, Bt) do { __builtin_amdgcn_s_setprio(1); _Pragma("unroll") for (int m = 0; m < 4; ++m) _Pragma("unroll") for (int n = 0; n < 2; ++n) _Pragma("unroll") for (int k = 0; k < 2; ++k) \
        acc[ai][bj][m][n] = __builtin_amdgcn_mfma_f32_16x16x32_bf16(Bt[n][k], At[m][k], acc[ai][bj][m][n], 0, 0, 0); __builtin_amdgcn_s_setprio(0); } while (0)
#define PG8_WAIT_V(n) asm volatile("s_waitcnt vmcnt(" #n ")" ::: "memory")
#define PG8_WAIT_L(n) asm volatile("s_waitcnt lgkmcnt(" #n ")" ::: "memory")
#define PG8_BAR __builtin_amdgcn_s_barrier()
#define PG8_SCHED __builtin_amdgcn_sched_barrier(0)
    Unit cur, nxt; int ui = 0;
    if (!S.next(0, cur)) return;
    f32x4 acc[2][2][4][2];
#pragma unroll
    for (int a = 0; a < 2; ++a)
#pragma unroll
        for (int b = 0; b < 2; ++b)
#pragma unroll
            for (int m = 0; m < 4; ++m)
#pragma unroll
                for (int n = 0; n < 2; ++n) acc[a][b][m][n] = (f32x4){0.f, 0.f, 0.f, 0.f};
    bf16x8 At[4][2], B0[2][2], B1[2][2];
    const char* cA = (const char*)g.A + (size_t)cur.pm * tstep; const char* cB = (const char*)g.Bt + (size_t)cur.pn * tstep;
    E.prep(cur, 0);
    if constexpr (SP2) {
        PG8_STAGE(PG8_SB(0, 0), cB, voffB); PG8_STAGE(PG8_SB(0, 1), cB + hstep, voffB); PG8_STAGE(PG8_SA(0, 0), cA, voffA); PG8_STAGE(PG8_SA(0, 1), cA + hstep, voffA);
        if (wr == 1) PG8_BAR;
        PG8_WAIT_V(2); PG8_BAR;
        PG8_STAGE(PG8_SB(1, 0), cB + kstep, voffB); PG8_STAGE(PG8_SA(1, 0), cA + kstep, voffA); PG8_STAGE(PG8_SB(1, 1), cB + hstep + kstep, voffB);
        PG8_WAIT_V(6); PG8_BAR;
    } else {
        PG8_STAGE(PG8_SB(0, 0), cB, voffB); PG8_STAGE(PG8_SA(0, 0), cA, voffA); PG8_STAGE(PG8_SB(0, 1), cB + hstep, voffB); PG8_STAGE(PG8_SA(0, 1), cA + hstep, voffA);
        if (wr == 1) PG8_BAR;
        PG8_WAIT_V(4); PG8_BAR;
        PG8_STAGE(PG8_SB(1, 0), cB + kstep, voffB); PG8_STAGE(PG8_SA(1, 0), cA + kstep, voffA); PG8_STAGE(PG8_SB(1, 1), cB + hstep + kstep, voffB);
        PG8_WAIT_V(6); PG8_BAR;
    }
    for (;;) {
        const bool has_next = S.next(ui + 1, nxt);
        const char* nA = has_next ? (const char*)g.A + (size_t)nxt.pm * tstep : cA; const char* nB = has_next ? (const char*)g.Bt + (size_t)nxt.pn * tstep : cB;
        for (int t = 0; t < nt; t += 2) {
            const bool last = (t == nt - 2);
            const char* a1 = cA + (size_t)(t + 1) * kstep;
            const char* a2 = last ? nA : cA + (size_t)(t + 2) * kstep; const char* b2 = last ? nB : cB + (size_t)(t + 2) * kstep;
            const char* a3 = a2 + kstep; const char* b3 = b2 + kstep;
            if (last && has_next) E.prep(nxt, (ui + 1) & 1);
            if constexpr (Epi::KRESCALE) { if (t == 4) E.rescale(acc, 0, ui & 1, wr, fr); else if (t == 8) E.rescale(acc, 1, ui & 1, wr, fr); }
            if constexpr (SP2) {
            PG8_LDB(B0, 0, 0); PG8_LDB(B1, 0, 1); PG8_SCHED; PG8_LDA(At, 0, 0); PG8_STAGE(PG8_SA(1, 1), a1 + hstep, voffA);
            PG8_WAIT_V(8); PG8_WAIT_L(0); PG8_BAR; PG8_MMA(0, 0, At, B0); PG8_MMA(0, 1, At, B1); PG8_BAR; PG8_SCHED;
            PG8_LDA(At, 0, 1); PG8_STAGE(PG8_SB(0, 0), b2, voffB); PG8_STAGE(PG8_SB(0, 1), b2 + hstep, voffB); PG8_STAGE(PG8_SA(0, 0), a2, voffA);
            PG8_WAIT_V(8); PG8_WAIT_L(0); PG8_BAR; PG8_MMA(1, 0, At, B0); PG8_MMA(1, 1, At, B1); PG8_BAR; PG8_SCHED;
            PG8_LDB(B0, 1, 0); PG8_LDB(B1, 1, 1); PG8_SCHED; PG8_LDA(At, 1, 0); PG8_STAGE(PG8_SA(0, 1), a2 + hstep, voffA);
            PG8_WAIT_V(8); PG8_WAIT_L(0); PG8_BAR; PG8_MMA(0, 0, At, B0); PG8_MMA(0, 1, At, B1); PG8_BAR; PG8_SCHED;
            PG8_LDA(At, 1, 1); PG8_STAGE(PG8_SB(1, 0), b3, voffB); PG8_STAGE(PG8_SB(1, 1), b3 + hstep, voffB); PG8_STAGE(PG8_SA(1, 0), a3, voffA);
            PG8_WAIT_V(8); PG8_WAIT_L(0); PG8_BAR; PG8_MMA(1, 0, At, B0); PG8_MMA(1, 1, At, B1); PG8_BAR; PG8_SCHED;
            } else {
            PG8_LDB(B0, 0, 0); PG8_SCHED; PG8_LDA(At, 0, 0); PG8_STAGE(PG8_SA(1, 1), a1 + hstep, voffA);
            PG8_WAIT_L(8); PG8_BAR; PG8_WAIT_L(0); PG8_MMA(0, 0, At, B0); PG8_BAR; PG8_SCHED;
            PG8_LDB(B1, 0, 1); PG8_STAGE(PG8_SB(0, 0), b2, voffB);
            PG8_BAR; PG8_WAIT_L(0); PG8_MMA(0, 1, At, B1); PG8_BAR;
            PG8_LDA(At, 0, 1); PG8_STAGE(PG8_SA(0, 0), a2, voffA);
            PG8_BAR; PG8_WAIT_L(0); PG8_MMA(1, 0, At, B0); PG8_BAR; PG8_SCHED;
            PG8_STAGE(PG8_SB(0, 1), b2 + hstep, voffB);
            PG8_WAIT_V(6); PG8_BAR; PG8_MMA(1, 1, At, B1); PG8_BAR;
            PG8_LDB(B0, 1, 0); PG8_SCHED; PG8_LDA(At, 1, 0); PG8_STAGE(PG8_SA(0, 1), a2 + hstep, voffA);
            PG8_WAIT_L(8); PG8_BAR; PG8_WAIT_L(0); PG8_MMA(0, 0, At, B0); PG8_BAR; PG8_SCHED;
            PG8_LDB(B1, 1, 1); PG8_STAGE(PG8_SB(1, 0), b3, voffB);
            PG8_BAR; PG8_WAIT_L(0); PG8_MMA(0, 1, At, B1); PG8_BAR;
            PG8_LDA(At, 1, 1); PG8_STAGE(PG8_SA(1, 0), a3, voffA);
            PG8_BAR; PG8_WAIT_L(0); PG8_MMA(1, 0, At, B0); PG8_BAR; PG8_SCHED;
            PG8_STAGE(PG8_SB(1, 1), b3 + hstep, voffB);
            PG8_WAIT_V(6); PG8_BAR; PG8_MMA(1, 1, At, B1); PG8_BAR;
            }
        }
        if constexpr (ALIGN_EPI) { if (wr == 0) PG8_BAR; }
        E(acc, cur, wr, wc, fr, fq, ui & 1);
        if (!has_next) break;
#pragma unroll
        for (int a = 0; a < 2; ++a)
#pragma unroll
            for (int b = 0; b < 2; ++b)
#pragma unroll
                for (int m = 0; m < 4; ++m)
#pragma unroll
                    for (int n = 0; n < 2; ++n) acc[a][b][m][n] = (f32x4){0.f, 0.f, 0.f, 0.f};
        cur = nxt; cA = nA; cB = nB; ++ui;
        if constexpr (ALIGN_EPI) { if (wr == 1) PG8_BAR; }
    }
    PG8_WAIT_V(0);
    if constexpr (!ALIGN_EPI) { if (wr == 0) PG8_BAR; }
    PG8_BAR;
#undef PG8_SA
#undef PG8_SB
#undef PG8_STAGE
#undef PG8_LDA
#undef PG8_LDB
#undef PG8_MMA
#undef PG8_WAIT_V
#undef PG8_WAIT_L
#undef PG8_BAR
#undef PG8_SCHED
}
}

#define GAS __attribute__((address_space(1)))
#define LAS __attribute__((address_space(3)))
typedef unsigned short bf16;
typedef unsigned v4u __attribute__((ext_vector_type(4)));
typedef unsigned v2u __attribute__((ext_vector_type(2)));
typedef float f32x4 __attribute__((ext_vector_type(4)));
typedef float f32x2 __attribute__((ext_vector_type(2)));
typedef short bf16x8 __attribute__((ext_vector_type(8)));
typedef short bf16x4 __attribute__((ext_vector_type(4)));

constexpr int NWAVES = 8, NTHR = 512;
constexpr int M = 8192, MC = 4096, D = 1024, NIN = 1952, NINP = 2048, DFF = 2816, NGU = 5632;
constexpr int O_SC = 768, O_CQ = 1536, O_CKV = 1792, O_KPE = 1920;
constexpr int NH = 8, QKD = 96, VD = 64, QL = 256, KVL = 128, ROPE = 32;
constexpr float EPS = 1e-6f;
constexpr float QSCALE = 0.10206207261596575f * 1.4426950408889634f;
constexpr int XL0 = 2 * 256 + 32, XL1 = 2 * 1024 + 32;
constexpr int FILT_LAYER = 256 * (XL0 + XL1);
constexpr int OUT_CKV = M * D, OUT_KPE = OUT_CKV + 16 * 2 * 256 * 128;
constexpr int N_PHASES = 14;

constexpr size_t MiB = 1u << 20;
constexpr size_t WS_CTL = 0, CTL_ZERO_BYTES = 1 * MiB;
constexpr size_t CTL_SSQHY = 256 * 1024;
constexpr size_t WS_MOD = 1 * MiB;
constexpr size_t WS_GG = WS_MOD + 2 * 5 * 6144 * 4;
constexpr size_t WS_BIN = WS_GG + 2 * 2 * 5 * 1024 * 4;
constexpr size_t WS_BGU = WS_BIN + 2 * 5 * 2048 * 4;
constexpr size_t WS_SSQ1P = 2 * MiB;
constexpr size_t WS_SSQ2P = WS_SSQ1P + 16 * M * 4;
constexpr size_t WS_SSQSC = WS_SSQ2P + 16 * M * 4;
constexpr size_t WS_SSQAT = WS_SSQSC + M * 4;
constexpr size_t WS_ROPE = WS_SSQAT + 8 * M * 4;
constexpr size_t WS_FILT = 4 * MiB;
constexpr size_t WS_WIN = 8 * MiB;
constexpr size_t WS_WOUT = WS_WIN + 2ull * NINP * D * 2;
constexpr size_t WS_WGU = WS_WOUT + 2ull * D * D * 2;
constexpr size_t WS_WD = WS_WGU + 2ull * NGU * D * 2;
constexpr size_t WS_WUQ = WS_WD + 2ull * D * DFF * 2;
constexpr size_t WS_WUKV = WS_WUQ + 2ull * 768 * 256 * 2;
constexpr size_t WS_XG = 58 * MiB;
constexpr size_t WS_XR = WS_XG + (size_t)M * D * 2;
constexpr size_t WS_PROJ = WS_XR + (size_t)M * D * 4;
constexpr size_t WS_Q = WS_PROJ + (size_t)M * NINP * 2;
constexpr size_t WS_ACT = WS_PROJ;
constexpr size_t WS_KC = WS_Q + (size_t)M * 768 * 2;
constexpr size_t WS_VTC = WS_KC + 16ull * 256 * 768 * 2;
constexpr size_t WS_KL = WS_VTC + 16ull * 8 * 64 * 256 * 2;
constexpr size_t WS_VTL = WS_KL + 2ull * 4 * 1280 * 768 * 2;
constexpr size_t WS_YMIX = WS_VTL + 2ull * 4 * 8 * 64 * 1280 * 2;
constexpr size_t WS_Z = WS_YMIX + (size_t)M * D * 2;
constexpr size_t WS_END = WS_Z + (size_t)M * 256 * 4;
static_assert(WS_BGU + 2 * 5 * 5632 * 4 <= WS_SSQ1P && WS_ROPE + 1024 * 32 * 4 <= WS_FILT && WS_FILT + 2ull * FILT_LAYER * 2 <= WS_WIN && WS_WUKV + 2ull * 1024 * 128 * 2 <= WS_XG, "ws map");
static_assert((size_t)M * DFF * 2 == (size_t)M * NINP * 2 + (size_t)M * 768 * 2, "ACT overlays PROJ|Q exactly");
static_assert(WS_END <= 256 * MiB, "ws fits 256 MiB");
constexpr int CW_BAR = 4096;

constexpr int RING_BYTES = 131072;
constexpr int MISC_OFF = RING_BYTES;
constexpr int AUX_OFF = RING_BYTES + 1024;
constexpr int LDS_BYTES = 155648;
static_assert(AUX_OFF + 5 * 1024 * 4 <= LDS_BYTES, "LDS map");

#define LDS_WAIT() asm volatile("s_waitcnt lgkmcnt(0)" ::: "memory")
#define VM_WAIT() asm volatile("s_waitcnt vmcnt(0)" ::: "memory")
__device__ __forceinline__ unsigned f2bf(float f) { unsigned u = __builtin_bit_cast(unsigned, f); return (u + 0x7fffu + ((u >> 16) & 1u)) >> 16; }
__device__ __forceinline__ unsigned pk2(float lo, float hi) { return f2bf(lo) | (f2bf(hi) << 16); }
__device__ __forceinline__ float bf2f(unsigned short b) { return __builtin_bit_cast(float, (unsigned)b << 16); }
__device__ __forceinline__ float bflo(unsigned w) { return __builtin_bit_cast(float, w << 16); }
__device__ __forceinline__ float bfhi(unsigned w) { return __builtin_bit_cast(float, w & 0xffff0000u); }
__device__ __forceinline__ float shx(float v, int mask, int lane) { return __builtin_bit_cast(float, __builtin_amdgcn_ds_bpermute((lane ^ mask) << 2, __builtin_bit_cast(int, v))); }
__device__ __forceinline__ float rdl(float v, int src) { return __builtin_bit_cast(float, __builtin_amdgcn_readlane(__builtin_bit_cast(int, v), src)); }
__device__ __forceinline__ float wave_sum(float v, int lane) {
#pragma unroll
    for (int o = 1; o < 64; o <<= 1) v += shx(v, o, lane);
    return v;
}
__device__ __forceinline__ int modidx(int row) { return row < MC ? 0 : 1 + ((row - MC) >> 10); }

struct Args { const float* in[31]; float* out; unsigned char* ws; int ph_lo, ph_hi, use_bar, pad; };
enum { I_XP = 0, I_XS, I_CCKV, I_CKPE, I_C, I_CCTX, I_WMOD, I_BMOD, I_GN1, I_WIN, I_HYCONV, I_HYW1, I_HYB1, I_HYFREQ, I_HYW2, I_HYB2, I_HYW3, I_HYBIAS, I_SCCONV,
       I_GQ, I_WUQ, I_GKV, I_WUKV, I_GQH, I_GKH, I_GGRP, I_WOUT, I_GN2, I_WG, I_WU, I_WD };

typedef const __attribute__((address_space(4))) Args* KArgs;
struct Frame {
    LAS unsigned char* lds;
    int tid, lane, wave, G, bid;
    KArgs a;
    unsigned char* ws;
};
#define WSP(T, off) ((T*)(F.ws + (off)))

__device__ __forceinline__ void tr_item(const float* W, int N, int k0, int n0, bf16* WT, int ldk, int dst_row0, const float* kscale, LAS float* scr, int lane) {
#pragma unroll 8
    for (int i = 0; i < 32; ++i) { const int kk = 2 * i + (lane >> 5); float v = W[(size_t)(k0 + kk) * N + n0 + (lane & 31)]; if (kscale) v *= kscale[k0 + kk]; scr[kk * 33 + (lane & 31)] = v; }
    LDS_WAIT(); asm volatile("" ::: "memory");
    const int c = lane & 7;
#pragma unroll
    for (int j = 0; j < 4; ++j) { const int n = (lane >> 3) + 8 * j; const LAS float* s = scr + (8 * c) * 33 + n;
        v4u o; o.x = pk2(s[0 * 33], s[1 * 33]); o.y = pk2(s[2 * 33], s[3 * 33]); o.z = pk2(s[4 * 33], s[5 * 33]); o.w = pk2(s[6 * 33], s[7 * 33]);
        *(v4u*)(WT + (size_t)(dst_row0 + n) * ldk + k0 + 8 * c) = o; }
    LDS_WAIT(); asm volatile("" ::: "memory");
}
constexpr int T_IN = 16 * 61, T_OUT = 16 * 32, T_G = 16 * 88, T_D = 44 * 32, T_UQ = 4 * 24, T_UKV = 2 * 32;
constexpr int T_LAYER = T_IN + T_OUT + 2 * T_G + T_D + T_UQ + T_UKV;
constexpr int IT_MOD = 192, IT_FILT = 2 * 1280, IT_ROPE = 256;
constexpr int P0_ITEMS = IT_MOD + IT_FILT + IT_ROPE + 2 * T_LAYER;

__device__ __forceinline__ void p0_mod_item(Frame& F, int it, const LAS float* sv) {
    const int l = it / 96, n0 = (it % 96) * 64 + F.lane;
    const float* W = F.a->in[I_WMOD] + (size_t)l * D * 6144 + n0;
    float acc[5] = {0.f, 0.f, 0.f, 0.f, 0.f};
    for (int k = 0; k < D; k += 8) {
        float w[8];
#pragma unroll
        for (int u = 0; u < 8; ++u) w[u] = W[(size_t)(k + u) * 6144];
#pragma unroll
        for (int u = 0; u < 8; ++u)
#pragma unroll
            for (int j = 0; j < 5; ++j) acc[j] += sv[j * 1024 + k + u] * w[u];
    }
    const float b = F.a->in[I_BMOD][l * 6144 + n0];
    float* mod = WSP(float, WS_MOD) + (size_t)l * 5 * 6144 + n0;
#pragma unroll
    for (int j = 0; j < 5; ++j) mod[j * 6144] = acc[j] + b;
}
__device__ __forceinline__ void p0_filt_item(Frame& F, int it) {
    const int l = it / 1280, r = it % 1280, sel = r >= 256, m = sel ? r - 256 : r, L = sel ? 1024 : 256, lane = F.lane;
    const float* w1 = F.a->in[I_HYW1] + l * 33 * 64; const float* w2 = F.a->in[I_HYW2] + l * 64 * 64; const float* w3 = F.a->in[I_HYW3] + l * 64 * 512;
    const float zt = (float)m / (float)(L - 1), wang = 6.283185307179586f * (float)m / (float)L;
    float zv = 0.f;
    if (lane == 0) zv = zt;
    else if (lane <= 16) { const float band = 1e-4f + (float)(lane - 1) * ((15.0f - 1e-4f) / 15.0f); zv = cosf(band * wang); }
    else if (lane <= 32) { const float band = 1e-4f + (float)(lane - 17) * ((15.0f - 1e-4f) / 15.0f); zv = -sinf(band * wang); }
    const float fr = F.a->in[I_HYFREQ][l * 64 + lane];
    float s = F.a->in[I_HYB1][l * 64 + lane];
    for (int i = 0; i < 33; ++i) s += rdl(zv, i) * w1[i * 64 + lane];
    const float h1 = sinf(fr * s);
    s = F.a->in[I_HYB2][l * 64 + lane];
    for (int i = 0; i < 64; ++i) s += rdl(h1, i) * w2[i * 64 + lane];
    const float h2 = sinf(fr * s);
    float h3[8] = {0.f, 0.f, 0.f, 0.f, 0.f, 0.f, 0.f, 0.f};
    for (int i = 0; i < 64; ++i) { const float hv = rdl(h2, i);
#pragma unroll
        for (int q = 0; q < 8; ++q) h3[q] += hv * w3[i * 512 + q * 64 + lane]; }
    const int XL = 2 * L + 32;
    bf16* R = WSP(bf16, WS_FILT) + (size_t)l * FILT_LAYER + (sel ? 256 * XL0 : 0);
    const float da = logf(0.01f) / 0.3f, db = logf(0.01f) / 1.5f;
#pragma unroll
    for (int q = 0; q < 4; ++q) { const int c = q * 64 + lane; const float delta = fabsf(da + (float)c * ((db - da) / 255.0f)); const float win = expf(-zt * delta) + 0.05f;
        R[(size_t)c * XL + (L + 32 - m)] = (bf16)f2bf(h3[q] * win);
        if (m >= 1) R[(size_t)c * XL + (L + 32 + m)] = (bf16)f2bf(h3[q + 4] * win);
        if (m == 0) for (int i = 0; i <= 32; ++i) R[(size_t)c * XL + i] = 0; }
}
__device__ __forceinline__ void p0_phase(Frame& F) {
    LAS float* sv = (LAS float*)(F.lds + AUX_OFF);
    for (int i = F.tid; i < 5 * 1024; i += NTHR) { const int j = i >> 10, k = i & 1023; const float c = (j == 0) ? F.a->in[I_CCTX][k] : F.a->in[I_C][(j - 1) * 1024 + k]; sv[i] = c / (1.f + expf(-c)); }
    __syncthreads();
    LAS float* scr = (LAS float*)(F.lds + F.wave * 16384);
    const int gw = F.wave * F.G + F.bid, NGW = F.G * NWAVES;
    for (int it = gw; it < P0_ITEMS; it += NGW) {
        int r = it;
        if (r < IT_MOD) { p0_mod_item(F, r, sv); continue; } r -= IT_MOD;
        if (r < IT_FILT) { p0_filt_item(F, r); continue; } r -= IT_FILT;
        if (r < IT_ROPE) { const int t = r * 4 + (F.lane >> 4), e16 = F.lane & 15; const float pos = (float)((e16 < 8) ? (t >> 6) : (t & 63));
            const float x = pos * exp2f(-(float)(e16 & 7) * (13.287712379549449f / 8.0f));
            const float k = rintf(x * 0.15915494309189535f); float rr = fmaf(-k, 6.2831854820251465f, x); rr = fmaf(-k, -1.7484555e-07f, rr);
            float* T = WSP(float, WS_ROPE) + (size_t)t * 32; T[e16] = cosf(rr); T[16 + e16] = sinf(rr); continue; } r -= IT_ROPE;
        const int l = r / T_LAYER; r -= l * T_LAYER;
        if (r < T_IN) { const int kb = r / 61, nb = r % 61; tr_item(F.a->in[I_WIN] + (size_t)l * D * NIN, NIN, kb * 64, nb * 32, WSP(bf16, WS_WIN) + (size_t)l * NINP * D, D, nb * 32, nullptr, scr, F.lane); continue; } r -= T_IN;
        if (r < T_OUT) { const int kb = r / 32, nb = r % 32; tr_item(F.a->in[I_WOUT] + (size_t)l * D * D, D, kb * 64, nb * 32, WSP(bf16, WS_WOUT) + (size_t)l * D * D, D, nb * 32, F.a->in[I_GGRP] + l * D, scr, F.lane); continue; } r -= T_OUT;
        if (r < 2 * T_G) { const int up = r >= T_G; if (up) r -= T_G; const int kb = r / 88, nb = r % 88, u0 = nb * 32;
            tr_item(F.a->in[up ? I_WU : I_WG] + (size_t)l * D * DFF, DFF, kb * 64, u0, WSP(bf16, WS_WGU) + (size_t)l * NGU * D, D, (u0 >> 7) * 256 + up * 128 + (u0 & 127), nullptr, scr, F.lane); continue; } r -= 2 * T_G;
        if (r < T_D) { const int kb = r / 32, nb = r % 32; tr_item(F.a->in[I_WD] + (size_t)l * DFF * D, D, kb * 64, nb * 32, WSP(bf16, WS_WD) + (size_t)l * D * DFF, DFF, nb * 32, nullptr, scr, F.lane); continue; } r -= T_D;
        if (r < T_UQ) { const int kb = r / 24, nb = r % 24; tr_item(F.a->in[I_WUQ] + (size_t)l * QL * 768, 768, kb * 64, nb * 32, WSP(bf16, WS_WUQ) + (size_t)l * 768 * QL, QL, nb * 32, nullptr, scr, F.lane); continue; } r -= T_UQ;
        { const int kb = r / 32, nb = r % 32; tr_item(F.a->in[I_WUKV] + (size_t)l * KVL * 1024, 1024, kb * 64, nb * 32, WSP(bf16, WS_WUKV) + (size_t)l * 1024 * KVL, KVL, nb * 32, nullptr, scr, F.lane); }
    }
}

constexpr int AQ_LD = 264, AKV_LD = 136;
constexpr int QK_AQ = 0, QK_AKV = QK_AQ + 64 * AQ_LD * 2, QK_KPE = QK_AKV + 64 * AKV_LD * 2, QK_KSS = QK_KPE + 64 * 32 * 4, QK_KRS = QK_KSS + 64 * 4, QK_END = QK_KRS + 8 * 64 * 4;
static_assert(QK_END <= RING_BYTES, "qkv LDS");

template <bool FROM_CACHE>
__device__ __forceinline__ void qkv_unit(Frame& F, int l, int u) {
    LAS bf16* Aq = (LAS bf16*)(F.lds + QK_AQ); LAS bf16* Akv = (LAS bf16*)(F.lds + QK_AKV);
    LAS float* kpe = (LAS float*)(F.lds + QK_KPE); LAS float* kss = (LAS float*)(F.lds + QK_KSS); LAS float* krs = (LAS float*)(F.lds + QK_KRS);
    const int tid = F.tid, lane = F.lane, h = F.wave, f = lane & 15, g = lane >> 4;
    const int row0 = FROM_CACHE ? 0 : u * 64;
    const bool latent = FROM_CACHE ? false : (row0 >= MC);
    int t0, Lk; bf16* Kseg; bf16* Vtseg;
    if (FROM_CACHE) { const int ridx = (u & 15) * 64, b = ridx >> 8; t0 = 1024 + (ridx & 255); Lk = 1280;
        Kseg = WSP(bf16, WS_KL) + ((size_t)(l * 4 + b) * 1280) * 768; Vtseg = WSP(bf16, WS_VTL) + (size_t)(l * 4 + b) * 8 * 64 * 1280; }
    else if (latent) { const int b = (row0 - MC) >> 10; t0 = (row0 - MC) & 1023; Lk = 1280;
        Kseg = WSP(bf16, WS_KL) + ((size_t)(l * 4 + b) * 1280) * 768; Vtseg = WSP(bf16, WS_VTL) + (size_t)(l * 4 + b) * 8 * 64 * 1280; }
    else { const int b = row0 >> 8; t0 = row0 & 255; Lk = 256; Kseg = WSP(bf16, WS_KC) + ((size_t)b * 256) * 768; Vtseg = WSP(bf16, WS_VTC) + (size_t)b * 8 * 64 * 256; }
    {
        const int r = tid >> 3, s = tid & 7;
        if (!FROM_CACHE) {
            const bf16* prow = WSP(bf16, WS_PROJ) + (size_t)(row0 + r) * NINP;
            float v[32]; float ss = 0.f;
#pragma unroll
            for (int i = 0; i < 4; ++i) { const v4u w = *(const v4u*)(prow + O_CQ + s * 32 + i * 8);
                v[i * 8 + 0] = bflo(w.x); v[i * 8 + 1] = bfhi(w.x); v[i * 8 + 2] = bflo(w.y); v[i * 8 + 3] = bfhi(w.y); v[i * 8 + 4] = bflo(w.z); v[i * 8 + 5] = bfhi(w.z); v[i * 8 + 6] = bflo(w.w); v[i * 8 + 7] = bfhi(w.w); }
#pragma unroll
            for (int i = 0; i < 32; ++i) ss += v[i] * v[i];
            ss += shx(ss, 1, lane); ss += shx(ss, 2, lane); ss += shx(ss, 4, lane);
            const float rstd = rsqrtf(ss * (1.0f / QL) + EPS);
            const float* gq = F.a->in[I_GQ] + l * QL + s * 32;
#pragma unroll
            for (int i = 0; i < 4; ++i) { v4u o; o.x = pk2(v[i * 8 + 0] * rstd * gq[i * 8 + 0], v[i * 8 + 1] * rstd * gq[i * 8 + 1]); o.y = pk2(v[i * 8 + 2] * rstd * gq[i * 8 + 2], v[i * 8 + 3] * rstd * gq[i * 8 + 3]);
                o.z = pk2(v[i * 8 + 4] * rstd * gq[i * 8 + 4], v[i * 8 + 5] * rstd * gq[i * 8 + 5]); o.w = pk2(v[i * 8 + 6] * rstd * gq[i * 8 + 6], v[i * 8 + 7] * rstd * gq[i * 8 + 7]);
                *(LAS v4u*)(Aq + r * AQ_LD + s * 32 + i * 8) = o; }
        }
        float c[16], p[4];
        if (FROM_CACHE) { const int ridx = (u & 15) * 64 + r, b = ridx >> 8, t = ridx & 255;
            const float* ck = F.a->in[I_CCKV] + ((size_t)((b * 2 + l) * 256 + t)) * 128 + s * 16; const float* kp = F.a->in[I_CKPE] + ((size_t)((b * 2 + l) * 256 + t)) * 32 + s * 4;
#pragma unroll
            for (int i = 0; i < 4; ++i) { const f32x4 w = *(const f32x4*)(ck + i * 4); c[i * 4] = w.x; c[i * 4 + 1] = w.y; c[i * 4 + 2] = w.z; c[i * 4 + 3] = w.w; }
            const f32x4 w = *(const f32x4*)kp; p[0] = w.x; p[1] = w.y; p[2] = w.z; p[3] = w.w;
        } else { const bf16* prow = WSP(bf16, WS_PROJ) + (size_t)(row0 + r) * NINP;
#pragma unroll
            for (int i = 0; i < 2; ++i) { const v4u w = *(const v4u*)(prow + O_CKV + s * 16 + i * 8);
                c[i * 8 + 0] = bflo(w.x); c[i * 8 + 1] = bfhi(w.x); c[i * 8 + 2] = bflo(w.y); c[i * 8 + 3] = bfhi(w.y); c[i * 8 + 4] = bflo(w.z); c[i * 8 + 5] = bfhi(w.z); c[i * 8 + 6] = bflo(w.w); c[i * 8 + 7] = bfhi(w.w); }
            const v2u w = *(const v2u*)(prow + O_KPE + s * 4); p[0] = bflo(w.x); p[1] = bfhi(w.x); p[2] = bflo(w.y); p[3] = bfhi(w.y);
        }
        float ss = 0.f;
#pragma unroll
        for (int i = 0; i < 16; ++i) ss += c[i] * c[i];
        ss += shx(ss, 1, lane); ss += shx(ss, 2, lane); ss += shx(ss, 4, lane);
        const float rstd = rsqrtf(ss * (1.0f / KVL) + EPS);
        const float* gkv = F.a->in[I_GKV] + l * KVL + s * 16;
#pragma unroll
        for (int i = 0; i < 2; ++i) { v4u o; o.x = pk2(c[i * 8 + 0] * rstd * gkv[i * 8 + 0], c[i * 8 + 1] * rstd * gkv[i * 8 + 1]); o.y = pk2(c[i * 8 + 2] * rstd * gkv[i * 8 + 2], c[i * 8 + 3] * rstd * gkv[i * 8 + 3]);
            o.z = pk2(c[i * 8 + 4] * rstd * gkv[i * 8 + 4], c[i * 8 + 5] * rstd * gkv[i * 8 + 5]); o.w = pk2(c[i * 8 + 6] * rstd * gkv[i * 8 + 6], c[i * 8 + 7] * rstd * gkv[i * 8 + 7]);
            *(LAS v4u*)(Akv + r * AKV_LD + s * 16 + i * 8) = o; }
        float ps = p[0] * p[0] + p[1] * p[1] + p[2] * p[2] + p[3] * p[3];
        ps += shx(ps, 1, lane); ps += shx(ps, 2, lane); ps += shx(ps, 4, lane);
        *(LAS f32x4*)(kpe + r * 32 + s * 4) = (f32x4){p[0], p[1], p[2], p[3]};
        if (s == 0) kss[r] = ps;
    }
    __syncthreads();
    if (!FROM_CACHE) {
        const bf16* Wt = WSP(bf16, WS_WUQ) + (size_t)l * 768 * QL + (size_t)(h * QKD) * QL;
        const float* gqh = F.a->in[I_GQH] + l * QKD;
        float gq[6];
#pragma unroll
        for (int ct = 0; ct < 6; ++ct) gq[ct] = gqh[ct * 16 + f];
        const float* RT = WSP(float, WS_ROPE);
        bf16* Qo = WSP(bf16, WS_Q);
#pragma unroll 1
        for (int rh = 0; rh < 2; ++rh) {
        f32x4 acc[2][6];
#pragma unroll
        for (int rt = 0; rt < 2; ++rt)
#pragma unroll
            for (int ct = 0; ct < 6; ++ct) acc[rt][ct] = (f32x4){0.f, 0.f, 0.f, 0.f};
#pragma unroll 1
        for (int kk = 0; kk < 8; ++kk) {
            bf16x8 a[2], b[6];
#pragma unroll
            for (int rt = 0; rt < 2; ++rt) a[rt] = *(const LAS bf16x8*)(Aq + ((rh * 2 + rt) * 16 + f) * AQ_LD + kk * 32 + g * 8);
#pragma unroll
            for (int ct = 0; ct < 6; ++ct) b[ct] = *(const bf16x8*)(Wt + (size_t)(ct * 16 + f) * QL + kk * 32 + g * 8);
#pragma unroll
            for (int rt = 0; rt < 2; ++rt)
#pragma unroll
                for (int ct = 0; ct < 6; ++ct) acc[rt][ct] = __builtin_amdgcn_mfma_f32_16x16x32_bf16(a[rt], b[ct], acc[rt][ct], 0, 0, 0);
        }
#pragma unroll
        for (int rt = 0; rt < 2; ++rt)
#pragma unroll
            for (int i = 0; i < 4; ++i) {
                float ss = 0.f;
#pragma unroll
                for (int ct = 0; ct < 6; ++ct) ss += acc[rt][ct][i] * acc[rt][ct][i];
                ss += shx(ss, 1, lane); ss += shx(ss, 2, lane); ss += shx(ss, 4, lane); ss += shx(ss, 8, lane);
                const float rstd = rsqrtf(ss * (1.0f / QKD) + EPS);
                const int tok = (rh * 2 + rt) * 16 + 4 * g + i, t = t0 + tok;
                float v[6];
#pragma unroll
                for (int ct = 0; ct < 6; ++ct) v[ct] = acc[rt][ct][i] * rstd * gq[ct];
                if (latent) {
#pragma unroll
                    for (int ct = 4; ct < 6; ++ct) { const float partner = shx(v[ct], 8, lane); const float cs = RT[(size_t)t * 32 + (ct - 4) * 8 + (f & 7)], sn = RT[(size_t)t * 32 + 16 + (ct - 4) * 8 + (f & 7)];
                        v[ct] = v[ct] * cs + (f < 8 ? -partner : partner) * sn; }
                }
                bf16* qrow = Qo + (size_t)(row0 + tok) * 768 + h * QKD + f;
#pragma unroll
                for (int ct = 0; ct < 6; ++ct) qrow[ct * 16] = (bf16)f2bf(v[ct] * QSCALE);
            }
        }
    }
    {
        const bf16* Wt = WSP(bf16, WS_WUKV) + (size_t)l * 1024 * KVL + (size_t)(h * 128) * KVL;
        const float* gkh = F.a->in[I_GKH] + l * QKD;
        float gk[4];
#pragma unroll
        for (int ct = 0; ct < 4; ++ct) gk[ct] = gkh[ct * 16 + f];
#pragma unroll 1
        for (int rh = 0; rh < 2; ++rh) {
        f32x4 acc[2][8];
#pragma unroll
        for (int rt = 0; rt < 2; ++rt)
#pragma unroll
            for (int ct = 0; ct < 8; ++ct) acc[rt][ct] = (f32x4){0.f, 0.f, 0.f, 0.f};
#pragma unroll 1
        for (int kk = 0; kk < 4; ++kk) {
            bf16x8 a[2], b[8];
#pragma unroll
            for (int rt = 0; rt < 2; ++rt) a[rt] = *(const LAS bf16x8*)(Akv + ((rh * 2 + rt) * 16 + f) * AKV_LD + kk * 32 + g * 8);
#pragma unroll
            for (int ct = 0; ct < 8; ++ct) b[ct] = *(const bf16x8*)(Wt + (size_t)(ct * 16 + f) * KVL + kk * 32 + g * 8);
#pragma unroll
            for (int rt = 0; rt < 2; ++rt)
#pragma unroll
                for (int ct = 0; ct < 8; ++ct) acc[rt][ct] = __builtin_amdgcn_mfma_f32_16x16x32_bf16(a[rt], b[ct], acc[rt][ct], 0, 0, 0);
        }
#pragma unroll
        for (int rt = 0; rt < 2; ++rt) {
#pragma unroll
            for (int i = 0; i < 4; ++i) {
                float ss = 0.f;
#pragma unroll
                for (int ct = 0; ct < 4; ++ct) ss += acc[rt][ct][i] * acc[rt][ct][i];
                ss += shx(ss, 1, lane); ss += shx(ss, 2, lane); ss += shx(ss, 4, lane); ss += shx(ss, 8, lane);
                const int tok = (rh * 2 + rt) * 16 + 4 * g + i;
                const float rstd = rsqrtf((ss + kss[tok]) * (1.0f / QKD) + EPS);
                if (f == 0) krs[h * 64 + tok] = rstd;
                bf16* krow = Kseg + (size_t)(t0 + tok) * 768 + h * QKD + f;
#pragma unroll
                for (int ct = 0; ct < 4; ++ct) krow[ct * 16] = (bf16)f2bf(acc[rt][ct][i] * rstd * gk[ct]);
            }
#pragma unroll
            for (int ct = 4; ct < 8; ++ct) { const int d = (ct - 4) * 16 + f;
                v2u o; o.x = pk2(acc[rt][ct][0], acc[rt][ct][1]); o.y = pk2(acc[rt][ct][2], acc[rt][ct][3]);
                *(v2u*)(Vtseg + ((size_t)h * 64 + d) * Lk + t0 + (rh * 2 + rt) * 16 + 4 * g) = o; }
        }
        }
        LDS_WAIT(); asm volatile("" ::: "memory");
        {
            const int tok = lane, t = t0 + tok; const float rs = krs[h * 64 + tok];
            float v[32];
#pragma unroll
            for (int i = 0; i < 8; ++i) { const f32x4 w = *(const LAS f32x4*)(kpe + tok * 32 + i * 4); v[i * 4] = w.x; v[i * 4 + 1] = w.y; v[i * 4 + 2] = w.z; v[i * 4 + 3] = w.w; }
#pragma unroll
            for (int i = 0; i < 32; ++i) v[i] *= rs * gkh[64 + i];
            if (latent) {
#pragma unroll
                for (int ax = 0; ax < 2; ++ax) { const float* RT = WSP(float, WS_ROPE) + (size_t)t * 32 + ax * 8;
#pragma unroll
                    for (int e = 0; e < 8; ++e) { const float cs = RT[e], sn = RT[16 + e]; const float A = v[ax * 16 + e], B = v[ax * 16 + 8 + e]; v[ax * 16 + e] = A * cs - B * sn; v[ax * 16 + 8 + e] = B * cs + A * sn; } }
            }
            bf16* krow = Kseg + (size_t)t * 768 + h * QKD + 64;
#pragma unroll
            for (int i = 0; i < 4; ++i) { v4u o; o.x = pk2(v[i * 8], v[i * 8 + 1]); o.y = pk2(v[i * 8 + 2], v[i * 8 + 3]); o.z = pk2(v[i * 8 + 4], v[i * 8 + 5]); o.w = pk2(v[i * 8 + 6], v[i * 8 + 7]); *(v4u*)(krow + i * 8) = o; }
        }
    }
    __syncthreads();
}

constexpr int P1_XROWS = M, P1_GG = 20, P1_BIAS = 2 * (NIN / 8 + NGU / 8);
constexpr int P1_ITEMS = P1_XROWS + P1_GG + P1_BIAS;
__device__ __forceinline__ void p1_phase(Frame& F) {
    const int gw = F.wave * F.G + F.bid, NGW = F.G * NWAVES, lane = F.lane;
    const float* MOD = WSP(float, WS_MOD);
    for (int it = gw; it < P1_ITEMS; it += NGW) {
        int r = it;
        if (r < P1_XROWS) {
            const float* xr = (r < MC) ? F.a->in[I_XP] + (size_t)r * D : F.a->in[I_XS] + (size_t)(r - MC) * D;
            const int j = modidx(r); const float* sc1 = MOD + (size_t)j * 6144 + 1024; const float* gn = F.a->in[I_GN1];
            f32x4 v[4]; float s = 0.f;
#pragma unroll
            for (int q = 0; q < 4; ++q) { v[q] = *(const f32x4*)(xr + 256 * q + 4 * lane); s += (v[q].x * v[q].x + v[q].y * v[q].y) + (v[q].z * v[q].z + v[q].w * v[q].w); }
            s = wave_sum(s, lane);
            bf16* o = WSP(bf16, WS_XG) + (size_t)r * D;
#pragma unroll
            for (int q = 0; q < 4; ++q) { const int c = 256 * q + 4 * lane; const f32x4 g = *(const f32x4*)(gn + c); const f32x4 sc = *(const f32x4*)(sc1 + c);
                v2u w; w.x = pk2(v[q].x * g.x * (1.f + sc.x), v[q].y * g.y * (1.f + sc.y)); w.y = pk2(v[q].z * g.z * (1.f + sc.z), v[q].w * g.w * (1.f + sc.w)); *(v2u*)(o + c) = w; }
            if (lane == 0) WSP(float, WS_SSQ1P)[r] = s;
            continue;
        }
        r -= P1_XROWS;
        if (r < P1_GG) { const int l = r / 10, kind = (r % 10) / 5, j = r % 5;
            const float* gn = F.a->in[kind ? I_GN2 : I_GN1] + l * D; const float* sc = MOD + ((size_t)l * 5 + j) * 6144 + (kind ? 4096 : 1024);
            float* o = WSP(float, WS_GG) + ((size_t)(l * 2 + kind) * 5 + j) * D;
#pragma unroll
            for (int q = 0; q < 4; ++q) { const int c = 256 * q + 4 * lane; const f32x4 g = *(const f32x4*)(gn + c); const f32x4 s4 = *(const f32x4*)(sc + c); *(f32x4*)(o + c) = (f32x4){g.x * (1.f + s4.x), g.y * (1.f + s4.y), g.z * (1.f + s4.z), g.w * (1.f + s4.w)}; }
            continue;
        }
        r -= P1_GG;
        {
            const int per = NIN / 8 + NGU / 8, l = r / per; int q = r % per; const bool gu = q >= NIN / 8; if (gu) q -= NIN / 8;
            const bf16* Wt = gu ? WSP(bf16, WS_WGU) + (size_t)l * NGU * D : WSP(bf16, WS_WIN) + (size_t)l * NINP * D;
            float* bo = gu ? WSP(float, WS_BGU) + (size_t)l * 5 * NGU : WSP(float, WS_BIN) + (size_t)l * 5 * NINP; const int ldb = gu ? NGU : NINP;
            const float* shb = MOD + (size_t)l * 5 * 6144 + (gu ? 3072 : 0);
            float sh[5][16];
#pragma unroll
            for (int j = 0; j < 5; ++j)
#pragma unroll
                for (int hh = 0; hh < 2; ++hh)
#pragma unroll
                    for (int e = 0; e < 2; ++e) { const f32x4 w = *(const f32x4*)(shb + (size_t)j * 6144 + hh * 512 + lane * 8 + e * 4); sh[j][hh * 8 + e * 4] = w.x; sh[j][hh * 8 + e * 4 + 1] = w.y; sh[j][hh * 8 + e * 4 + 2] = w.z; sh[j][hh * 8 + e * 4 + 3] = w.w; }
            for (int n8 = 0; n8 < 8; ++n8) { const int n = q * 8 + n8; const bf16* wr = Wt + (size_t)n * D;
                float w[16];
#pragma unroll
                for (int hh = 0; hh < 2; ++hh) { const v4u x = *(const v4u*)(wr + hh * 512 + lane * 8); w[hh * 8] = bflo(x.x); w[hh * 8 + 1] = bfhi(x.x); w[hh * 8 + 2] = bflo(x.y); w[hh * 8 + 3] = bfhi(x.y); w[hh * 8 + 4] = bflo(x.z); w[hh * 8 + 5] = bfhi(x.z); w[hh * 8 + 6] = bflo(x.w); w[hh * 8 + 7] = bfhi(x.w); }
#pragma unroll
                for (int j = 0; j < 5; ++j) { float s = 0.f;
#pragma unroll
                    for (int e = 0; e < 16; ++e) s += w[e] * sh[j][e];
                    s = wave_sum(s, lane); if (lane == 0) bo[(size_t)j * ldb + n] = s; }
            }
        }
    }
    for (int u = F.bid; u < 32; u += F.G) qkv_unit<true>(F, u >> 4, u);
}

__device__ __forceinline__ void prep_phase(Frame& F, int l) {
    for (int u = F.bid; u < M / 64; u += F.G) qkv_unit<false>(F, l, u);
    const bf16* P = WSP(bf16, WS_PROJ); float* Z = WSP(float, WS_Z); const float* cw = F.a->in[I_HYCONV] + l * 3 * 768;
    const int c = F.tid & 255;
    const float a0 = cw[256 + c], a1 = cw[768 + 256 + c], a2 = cw[1536 + 256 + c], b0 = cw[512 + c], b1 = cw[768 + 512 + c], b2 = cw[1536 + 512 + c];
    for (int u = F.bid; u < M / 2; u += F.G) {
        const int row = u * 2 + (F.tid >> 8); const int L = row < MC ? 256 : 1024, t = row < MC ? (row & 255) : ((row - MC) & 1023);
        const bf16* pr = P + (size_t)row * NINP;
        float x1 = a1 * bf2f(pr[256 + c]), v = b1 * bf2f(pr[512 + c]);
        if (t > 0) { x1 += a0 * bf2f(pr[256 + c - NINP]); v += b0 * bf2f(pr[512 + c - NINP]); }
        if (t < L - 1) { x1 += a2 * bf2f(pr[256 + c + NINP]); v += b2 * bf2f(pr[512 + c + NINP]); }
        Z[(size_t)row * 256 + c] = x1 * v;
    }
}

__device__ __forceinline__ void attn_unit(Frame& F, int l, bool latent, int seg, int h, int qb) {
    const int lane = F.lane, f = lane & 15, g = lane >> 4;
    const int Lk = latent ? 1280 : 256;
    const int qrow0 = (latent ? MC + seg * 1024 : seg * 256) + qb * 128 + F.wave * 16;
    const bf16* Kb = latent ? WSP(bf16, WS_KL) + ((size_t)(l * 4 + seg) * 1280) * 768 + h * QKD : WSP(bf16, WS_KC) + ((size_t)seg * 256) * 768 + h * QKD;
    const bf16* Vt = latent ? WSP(bf16, WS_VTL) + ((size_t)(l * 4 + seg) * 8 + h) * 64 * 1280 : WSP(bf16, WS_VTC) + ((size_t)seg * 8 + h) * 64 * 256;
    const bf16* Qp = WSP(bf16, WS_Q) + (size_t)(qrow0 + f) * 768 + h * QKD + g * 8;
    bf16x8 qB[3];
#pragma unroll
    for (int kk = 0; kk < 3; ++kk) qB[kk] = *(const bf16x8*)(Qp + kk * 32);
    float mrun = -1e30f, lsum = 0.f;
    f32x4 o[4];
#pragma unroll
    for (int dt = 0; dt < 4; ++dt) o[dt] = (f32x4){0.f, 0.f, 0.f, 0.f};
    for (int kb = 0; kb < Lk; kb += 32) {
        f32x4 s0 = (f32x4){0.f, 0.f, 0.f, 0.f}, s1 = s0;
        const bf16* kp = Kb + (size_t)(kb + f) * 768 + g * 8;
#pragma unroll
        for (int kk = 0; kk < 3; ++kk) { const bf16x8 k0 = *(const bf16x8*)(kp + kk * 32), k1 = *(const bf16x8*)(kp + 16 * 768 + kk * 32);
            s0 = __builtin_amdgcn_mfma_f32_16x16x32_bf16(k0, qB[kk], s0, 0, 0, 0); s1 = __builtin_amdgcn_mfma_f32_16x16x32_bf16(k1, qB[kk], s1, 0, 0, 0); }
        float mx = fmaxf(fmaxf(fmaxf(s0[0], s0[1]), fmaxf(s0[2], s0[3])), fmaxf(fmaxf(s1[0], s1[1]), fmaxf(s1[2], s1[3])));
        mx = fmaxf(mx, shx(mx, 16, lane)); mx = fmaxf(mx, shx(mx, 32, lane));
        const float mnew = fmaxf(mrun, mx), alpha = exp2f(mrun - mnew); mrun = mnew;
        float p0[4], p1[4]; float ps = 0.f;
#pragma unroll
        for (int i = 0; i < 4; ++i) { p0[i] = exp2f(s0[i] - mnew); p1[i] = exp2f(s1[i] - mnew); ps += p0[i] + p1[i]; }
        lsum = lsum * alpha + ps;
        v4u pw; pw.x = pk2(p0[0], p0[1]); pw.y = pk2(p0[2], p0[3]); pw.z = pk2(p1[0], p1[1]); pw.w = pk2(p1[2], p1[3]);
        const bf16x8 pB = __builtin_bit_cast(bf16x8, pw);
#pragma unroll
        for (int dt = 0; dt < 4; ++dt) { const bf16* vp = Vt + (size_t)(dt * 16 + f) * Lk + kb + 4 * g;
            const v2u lo = *(const v2u*)vp, hi = *(const v2u*)(vp + 16); v4u vw; vw.x = lo.x; vw.y = lo.y; vw.z = hi.x; vw.w = hi.y;
            o[dt] = o[dt] * alpha; o[dt] = __builtin_amdgcn_mfma_f32_16x16x32_bf16(__builtin_bit_cast(bf16x8, vw), pB, o[dt], 0, 0, 0); }
    }
    lsum += shx(lsum, 16, lane); lsum += shx(lsum, 32, lane);
    const float inv = 1.0f / lsum; float ss = 0.f;
    bf16* yo = WSP(bf16, WS_YMIX) + (size_t)(qrow0 + f) * D + 512 + h * 64 + 4 * g;
#pragma unroll
    for (int dt = 0; dt < 4; ++dt) { const f32x4 v = o[dt] * inv; v2u w; w.x = pk2(v[0], v[1]); w.y = pk2(v[2], v[3]); *(v2u*)(yo + dt * 16) = w;
        const float r0 = bflo(w.x), r1 = bfhi(w.x), r2 = bflo(w.y), r3 = bfhi(w.y); ss += (r0 * r0 + r1 * r1) + (r2 * r2 + r3 * r3); }
    ss += shx(ss, 16, lane); ss += shx(ss, 32, lane);
    if (g == 0) WSP(float, WS_SSQAT)[(size_t)h * M + qrow0 + f] = ss;
}
__device__ __forceinline__ void hyena_unit_v1(Frame& F, int l, int u) {
    const int c = F.tid & 255, tr = F.tid >> 8;
    const int row0 = u * 16; const bool latent = row0 >= MC; const int L = latent ? 1024 : 256, XL = 2 * L + 32;
    const int seg0 = latent ? MC + ((row0 - MC) & ~1023) : (row0 & ~255); const int t0 = row0 - seg0 + tr * 8;
    const bf16* R = WSP(bf16, WS_FILT) + (size_t)l * FILT_LAYER + (latent ? 256 * XL0 : 0) + (size_t)c * XL;
    const float* Z = WSP(float, WS_Z) + (size_t)seg0 * 256 + c;
    const int idx0 = L + 32 - t0;
    float acc[8], w[16];
#pragma unroll
    for (int i = 0; i < 8; ++i) acc[i] = 0.f;
    { const v4u x = *(const v4u*)(R + idx0 - 8); w[8] = bflo(x.x); w[9] = bfhi(x.x); w[10] = bflo(x.y); w[11] = bfhi(x.y); w[12] = bflo(x.z); w[13] = bfhi(x.z); w[14] = bflo(x.w); w[15] = bfhi(x.w); }
    for (int s = 0; s < L; s += 8) {
#pragma unroll
        for (int k = 0; k < 8; ++k) w[k] = w[k + 8];
        const v4u x = *(const v4u*)(R + idx0 + s); w[8] = bflo(x.x); w[9] = bfhi(x.x); w[10] = bflo(x.y); w[11] = bfhi(x.y); w[12] = bflo(x.z); w[13] = bfhi(x.z); w[14] = bflo(x.w); w[15] = bfhi(x.w);
#pragma unroll
        for (int e = 0; e < 8; ++e) { const float zv = Z[(size_t)(s + e) * 256];
#pragma unroll
            for (int i = 0; i < 8; ++i) acc[i] += zv * w[8 + e - i]; }
    }
    const float bias = F.a->in[I_HYBIAS][l * 256 + c];
    const float* cw = F.a->in[I_HYCONV] + l * 3 * 768; const float w0 = cw[c], w1 = cw[768 + c], w2 = cw[1536 + c];
    const bf16* P = WSP(bf16, WS_PROJ); bf16* Y = WSP(bf16, WS_YMIX); float* ssq = (float*)(F.ws + WS_CTL + CTL_SSQHY) + (size_t)l * M;
#pragma unroll
    for (int i = 0; i < 8; ++i) { const int t = t0 + i, row = seg0 + t; const bf16* pr = P + (size_t)row * NINP + c;
        float x0 = w1 * bf2f(pr[0]); if (t > 0) x0 += w0 * bf2f(pr[-NINP]); if (t < L - 1) x0 += w2 * bf2f(pr[NINP]);
        const float y = acc[i] + Z[(size_t)t * 256] * bias; const unsigned short ob = (unsigned short)f2bf(x0 * y); Y[(size_t)row * D + c] = ob;
        const float of = bf2f(ob); const float s = wave_sum(of * of, F.lane); if (F.lane == 0) atomicAdd(ssq + row, s); }
}
__device__ __forceinline__ void sconv_rows(Frame& F, int l, int u) {
    const int row = u * 8 + F.wave, c4 = F.lane * 4; const bool latent = row >= MC; const int L = latent ? 1024 : 256, t = latent ? ((row - MC) & 1023) : (row & 255);
    const bf16* pr = WSP(bf16, WS_PROJ) + (size_t)row * NINP + O_SC + c4; const float* cw = F.a->in[I_SCCONV] + l * 3 * 256 + c4;
    float conv[4] = {0.f, 0.f, 0.f, 0.f};
#pragma unroll
    for (int dr = -1; dr <= 1; ++dr) { if (t + dr < 0 || t + dr >= L) continue;
        const v2u cg_ = *(const v2u*)(pr + dr * NINP + 256), hx = *(const v2u*)(pr + dr * NINP + 512); const f32x4 w = *(const f32x4*)(cw + (dr + 1) * 256);
        conv[0] += w.x * bflo(cg_.x) * bflo(hx.x); conv[1] += w.y * bfhi(cg_.x) * bfhi(hx.x); conv[2] += w.z * bflo(cg_.y) * bflo(hx.y); conv[3] += w.w * bfhi(cg_.y) * bfhi(hx.y); }
    const v2u bg = *(const v2u*)pr;
    v2u o; o.x = pk2(bflo(bg.x) * conv[0], bfhi(bg.x) * conv[1]); o.y = pk2(bflo(bg.y) * conv[2], bfhi(bg.y) * conv[3]);
    *(v2u*)(WSP(bf16, WS_YMIX) + (size_t)row * D + 256 + c4) = o;
    const float r0 = bflo(o.x), r1 = bfhi(o.x), r2 = bflo(o.y), r3 = bfhi(o.y);
    const float s = wave_sum((r0 * r0 + r1 * r1) + (r2 * r2 + r3 * r3), F.lane); if (F.lane == 0) WSP(float, WS_SSQSC)[row] = s;
}
constexpr int MX_ATL = 256, MX_ATC = 256, MX_HY = M / 16, MX_SC = M / 8, MX_UNITS = MX_ATL + MX_ATC + MX_HY + MX_SC;
__device__ __forceinline__ void mix_phase(Frame& F, int l) {
    for (int u = F.bid; u < MX_UNITS; u += F.G) {
        int r = u;
        if (r < MX_ATL) { attn_unit(F, l, true, r >> 6, (r >> 3) & 7, r & 7); continue; } r -= MX_ATL;
        if (r < MX_ATC) { attn_unit(F, l, false, r >> 4, (r >> 1) & 7, r & 1); continue; } r -= MX_ATC;
        if (r < MX_HY) { hyena_unit_v1(F, l, r); continue; } r -= MX_HY;
        sconv_rows(F, l, r);
    }
}

#define AUXT(par, k) (aux + ((par) * 3 + (k)) * 256)
struct EpiBase {
    LAS float* aux; int tid;
    __device__ __forceinline__ void rescale(pg8::f32x4 (&acc)[2][2][4][2], int which, int par, int wr, int fr) const {
        const LAS float* T = AUXT(par, 1 + which);
#pragma unroll
        for (int ai = 0; ai < 2; ++ai)
#pragma unroll
            for (int m = 0; m < 4; ++m) { const float s = T[ai * 128 + wr * 64 + m * 16 + fr];
#pragma unroll
                for (int bj = 0; bj < 2; ++bj)
#pragma unroll
                    for (int n = 0; n < 2; ++n) acc[ai][bj][m][n] = acc[ai][bj][m][n] * s; }
    }
};
struct EpiIn : EpiBase {
    static constexpr bool PERM = true, KRESCALE = false;
    const float* ssqp; int np; const float* bias; bf16* proj; float* out; int l;
    __device__ __forceinline__ void prep(const pg8::Unit& u, int par) const {
        if (tid < 256) { const int row = u.pm * 256 + tid; float s = 0.f;
#pragma unroll 1
            for (int p = 0; p < np; ++p) s += ssqp[(size_t)p * M + row]; AUXT(par, 0)[tid] = rsqrtf(s * (1.0f / D) + EPS); }
    }
    __device__ __forceinline__ void operator()(const pg8::f32x4 (&acc)[2][2][4][2], const pg8::Unit& u, int wr, int wc, int fr, int fq, int par) const {
        const int row0 = u.pm * 256 + wr * 64 + fr, j = modidx(u.pm * 256); const LAS float* T = AUXT(par, 0);
        const float* bp = bias + (size_t)j * NINP + u.pn * 256 + wc * 32 + 8 * fq;
        f32x4 bv[2][2];
#pragma unroll
        for (int bj = 0; bj < 2; ++bj)
#pragma unroll
            for (int n = 0; n < 2; ++n) bv[bj][n] = *(const f32x4*)(bp + bj * 128 + 4 * n);
#pragma unroll
        for (int ai = 0; ai < 2; ++ai)
#pragma unroll
            for (int m = 0; m < 4; ++m) { const int row = row0 + ai * 128 + m * 16; const float rs = T[ai * 128 + wr * 64 + m * 16 + fr];
#pragma unroll
                for (int bj = 0; bj < 2; ++bj) { const f32x4 v0 = acc[ai][bj][m][0] * rs + bv[bj][0], v1 = acc[ai][bj][m][1] * rs + bv[bj][1];
                    const int col = u.pn * 256 + bj * 128 + wc * 32 + 8 * fq;
                    v4u w; w.x = pk2(v0[0], v0[1]); w.y = pk2(v0[2], v0[3]); w.z = pk2(v1[0], v1[1]); w.w = pk2(v1[2], v1[3]);
                    *(v4u*)(proj + (size_t)row * NINP + col) = w;
                    if (u.pn == 7 && row < MC && col < NIN) { const int b = row >> 8, t = row & 255;
                        float* o = (col < O_KPE) ? out + OUT_CKV + ((size_t)((b * 2 + l) * 256 + t)) * 128 + (col - O_CKV) : out + OUT_KPE + ((size_t)((b * 2 + l) * 256 + t)) * 32 + (col - O_KPE);
                        *(f32x4*)o = v0; *(f32x4*)(o + 4) = v1; } } }
    }
};
struct EpiOut : EpiBase {
    static constexpr bool PERM = true, KRESCALE = true;
    const float* ssq_hy; const float* ssq_sc; const float* ssq_at; const float* xa; const float* xb; float* xr; bf16* xg; const float* g1; const float* gg2; float* ssqp;
    __device__ __forceinline__ void prep(const pg8::Unit& u, int par) const {
        if (tid < 256) { const int row = u.pm * 256 + tid; float sa = 0.f;
#pragma unroll 1
            for (int h = 0; h < 8; ++h) sa += ssq_at[(size_t)h * M + row];
            const float rh = rsqrtf(ssq_hy[row] * (1.0f / 256) + EPS), rs = rsqrtf(ssq_sc[row] * (1.0f / 256) + EPS), ra = rsqrtf(sa * (1.0f / 512) + EPS);
            AUXT(par, 0)[tid] = ra; AUXT(par, 1)[tid] = rh / rs; AUXT(par, 2)[tid] = rs / ra; }
    }
    __device__ __forceinline__ void operator()(const pg8::f32x4 (&acc)[2][2][4][2], const pg8::Unit& u, int wr, int wc, int fr, int fq, int par) const {
        const int row0 = u.pm * 256 + wr * 64 + fr, j = modidx(u.pm * 256); const LAS float* T = AUXT(par, 0);
        const float* xin = (u.pm * 256 < MC) ? xa : xb;
        const int lane = fq * 16 + fr;
        const int cb = u.pn * 256 + wc * 32 + 8 * fq;
#pragma unroll
        for (int ai = 0; ai < 2; ++ai)
#pragma unroll
            for (int m = 0; m < 4; ++m) { const int row = row0 + ai * 128 + m * 16; const float rs = T[ai * 128 + wr * 64 + m * 16 + fr]; float ss = 0.f;
#pragma unroll
                for (int bj = 0; bj < 2; ++bj) { const int col = cb + bj * 128; v4u w;
#pragma unroll
                    for (int n = 0; n < 2; ++n) { const f32x4 gv = *(const f32x4*)(g1 + (size_t)j * 6144 + col + 4 * n), gg = *(const f32x4*)(gg2 + (size_t)j * D + col + 4 * n);
                        const f32x4 xv = *(const f32x4*)(xin + (size_t)row * D + col + 4 * n); const f32x4 x1 = xv + gv * (acc[ai][bj][m][n] * rs);
                        *(f32x4*)(xr + (size_t)row * D + col + 4 * n) = x1; ss += (x1[0] * x1[0] + x1[1] * x1[1]) + (x1[2] * x1[2] + x1[3] * x1[3]);
                        const f32x4 y = x1 * gg; if (n == 0) { w.x = pk2(y[0], y[1]); w.y = pk2(y[2], y[3]); } else { w.z = pk2(y[0], y[1]); w.w = pk2(y[2], y[3]); } }
                    *(v4u*)(xg + (size_t)row * D + col) = w; }
                ss += shx(ss, 16, lane); ss += shx(ss, 32, lane);
                if (fq == 0) ssqp[(size_t)(u.pn * 4 + wc) * M + row] = ss; }
    }
};
struct EpiUp : EpiBase {
    static constexpr bool PERM = true, KRESCALE = false;
    const float* ssqp; const float* bias; bf16* act;
    __device__ __forceinline__ void prep(const pg8::Unit& u, int par) const {
        if (tid < 256) { const int row = u.pm * 256 + tid; float s = 0.f;
#pragma unroll 1
            for (int p = 0; p < 16; ++p) s += ssqp[(size_t)p * M + row];
            AUXT(par, 0)[tid] = rsqrtf(s * (1.0f / D) + EPS); }
    }
    __device__ __forceinline__ void operator()(const pg8::f32x4 (&acc)[2][2][4][2], const pg8::Unit& u, int wr, int wc, int fr, int fq, int par) const {
        const int row0 = u.pm * 256 + wr * 64 + fr, j = modidx(u.pm * 256); const LAS float* T = AUXT(par, 0);
        const float* bp = bias + (size_t)j * NGU + u.pn * 256 + wc * 32 + 8 * fq;
        f32x4 bv[2][2];
#pragma unroll
        for (int bj = 0; bj < 2; ++bj)
#pragma unroll
            for (int n = 0; n < 2; ++n) bv[bj][n] = *(const f32x4*)(bp + bj * 128 + 4 * n);
#pragma unroll
        for (int ai = 0; ai < 2; ++ai)
#pragma unroll
            for (int m = 0; m < 4; ++m) { const int row = row0 + ai * 128 + m * 16; const float rs = T[ai * 128 + wr * 64 + m * 16 + fr]; float a[8];
#pragma unroll
                for (int n = 0; n < 2; ++n) { const f32x4 gt = acc[ai][0][m][n] * rs + bv[0][n], up = acc[ai][1][m][n] * rs + bv[1][n];
#pragma unroll
                    for (int e = 0; e < 4; ++e) a[n * 4 + e] = gt[e] / (1.0f + __expf(-gt[e])) * up[e]; }
                v4u w; w.x = pk2(a[0], a[1]); w.y = pk2(a[2], a[3]); w.z = pk2(a[4], a[5]); w.w = pk2(a[6], a[7]);
                *(v4u*)(act + (size_t)row * DFF + u.pn * 128 + wc * 32 + 8 * fq) = w; }
    }
};
struct EpiDown : EpiBase {
    static constexpr bool PERM = true, KRESCALE = false;
    const float* xr; float* xo; bf16* xg; const float* g2; const float* gg1n; float* ssqp; int last;
    __device__ __forceinline__ void prep(const pg8::Unit&, int) const {}
    __device__ __forceinline__ void operator()(const pg8::f32x4 (&acc)[2][2][4][2], const pg8::Unit& u, int wr, int wc, int fr, int fq, int) const {
        const int row0 = u.pm * 256 + wr * 64 + fr, j = modidx(u.pm * 256), lane = fq * 16 + fr;
        const int cb = u.pn * 256 + wc * 32 + 8 * fq;
#pragma unroll
        for (int ai = 0; ai < 2; ++ai)
#pragma unroll
            for (int m = 0; m < 4; ++m) { const int row = row0 + ai * 128 + m * 16; float ss = 0.f;
#pragma unroll
                for (int bj = 0; bj < 2; ++bj) { const int col = cb + bj * 128; v4u w;
#pragma unroll
                    for (int n = 0; n < 2; ++n) { const f32x4 gv = *(const f32x4*)(g2 + (size_t)j * 6144 + col + 4 * n);
                        const f32x4 xv = *(const f32x4*)(xr + (size_t)row * D + col + 4 * n); const f32x4 x2 = xv + gv * acc[ai][bj][m][n];
                        *(f32x4*)(xo + (size_t)row * D + col + 4 * n) = x2;
                        if (!last) { const f32x4 gg = *(const f32x4*)(gg1n + (size_t)j * D + col + 4 * n); ss += (x2[0] * x2[0] + x2[1] * x2[1]) + (x2[2] * x2[2] + x2[3] * x2[3]);
                            const f32x4 y = x2 * gg; if (n == 0) { w.x = pk2(y[0], y[1]); w.y = pk2(y[2], y[3]); } else { w.z = pk2(y[0], y[1]); w.w = pk2(y[2], y[3]); } } }
                    if (!last) *(v4u*)(xg + (size_t)row * D + col) = w; }
                if (!last) { ss += shx(ss, 16, lane); ss += shx(ss, 32, lane); if (fq == 0) ssqp[(size_t)(u.pn * 4 + wc) * M + row] = ss; } }
    }
};

#define MK_FRAME() Frame F; { int l_; asm volatile("v_mbcnt_lo_u32_b32 %0, -1, 0\n\tv_mbcnt_hi_u32_b32 %0, -1, %0" : "=v"(l_)); int w_ = wave0; asm volatile("" : "+s"(w_)); F.tid = w_ * 64 + l_; F.lane = l_; F.wave = w_; \
        KArgs k_ = (KArgs)__builtin_amdgcn_kernarg_segment_ptr(); asm volatile("" : "+s"(k_)); F.a = k_; F.ws = k_->ws; int g_ = gridDim.x, b_ = blockIdx.x; asm volatile("" : "+s"(g_), "+s"(b_)); F.G = g_; F.bid = b_; } \
        F.lds = (LAS unsigned char*)lds; LAS float* aux = (LAS float*)(F.lds + AUX_OFF); (void)aux
#define MK_IN(k) (ph_lo <= (k) && (k) < ph_hi)
#define MK_BAR(k) do { if (use_bar && (k) + 1 < ph_hi) { __threadfence(); cg::this_grid().sync(); } } while (0)

template <int KM, int L> __device__ __forceinline__ void layer_phases(unsigned char* lds, int wave0, int ph_lo, int ph_hi, int use_bar) {
    constexpr int l = L, P = 2 + 6 * L;
    if (MK_IN(P + 0)) { if constexpr (KM & 4) { MK_FRAME();
        pg8::Gemm g{WSP(bf16, WS_XG), WSP(bf16, WS_WIN) + (size_t)l * NINP * D, M, NINP, D}; pg8::StaticOrder S; S.init(M, NINP, F.G, F.bid);
        EpiIn E; E.aux = aux; E.tid = F.tid; E.ssqp = WSP(float, WS_SSQ1P); E.np = l == 0 ? 1 : 16; E.bias = WSP(float, WS_BIN) + (size_t)l * 5 * NINP; E.proj = WSP(bf16, WS_PROJ); E.out = F.a->out; E.l = l;
        pg8::gemm_phase<EpiIn, pg8::StaticOrder, true, true>(F.lds, g, S, E, F.tid); }
        MK_BAR(P + 0); }
    if (MK_IN(P + 1)) { if constexpr (KM & 8) { MK_FRAME(); prep_phase(F, l); } MK_BAR(P + 1); }
    if (MK_IN(P + 2)) { if constexpr (KM & 16) { MK_FRAME(); mix_phase(F, l); } MK_BAR(P + 2); }
    if (MK_IN(P + 3)) { if constexpr (KM & 32) { MK_FRAME(); float* MOD = WSP(float, WS_MOD); float* GG = WSP(float, WS_GG);
        pg8::Gemm g{WSP(bf16, WS_YMIX), WSP(bf16, WS_WOUT) + (size_t)l * D * D, M, D, D}; pg8::StaticOrder S; S.init(M, D, F.G, F.bid);
        EpiOut E; E.aux = aux; E.tid = F.tid; E.ssq_hy = (const float*)(F.ws + WS_CTL + CTL_SSQHY) + (size_t)l * M; E.ssq_sc = WSP(float, WS_SSQSC); E.ssq_at = WSP(float, WS_SSQAT);
        E.xa = l == 0 ? F.a->in[I_XP] : WSP(float, WS_XR); E.xb = l == 0 ? F.a->in[I_XS] - (size_t)MC * D : WSP(float, WS_XR); E.xr = WSP(float, WS_XR); E.xg = WSP(bf16, WS_XG);
        E.g1 = MOD + (size_t)l * 5 * 6144 + 2048; E.gg2 = GG + (size_t)((l * 2 + 1) * 5) * D; E.ssqp = WSP(float, WS_SSQ2P);
        pg8::gemm_phase<EpiOut, pg8::StaticOrder, true, true>(F.lds, g, S, E, F.tid); }
        MK_BAR(P + 3); }
    if (MK_IN(P + 4)) { if constexpr (KM & 64) { MK_FRAME();
        pg8::Gemm g{WSP(bf16, WS_XG), WSP(bf16, WS_WGU) + (size_t)l * NGU * D, M, NGU, D}; pg8::StaticOrder S; S.init(M, NGU, F.G, F.bid);
        EpiUp E; E.aux = aux; E.tid = F.tid; E.ssqp = WSP(float, WS_SSQ2P); E.bias = WSP(float, WS_BGU) + (size_t)l * 5 * NGU; E.act = WSP(bf16, WS_ACT);
        pg8::gemm_phase<EpiUp, pg8::StaticOrder, true, true>(F.lds, g, S, E, F.tid); }
        MK_BAR(P + 4); }
    if (MK_IN(P + 5)) { if constexpr (KM & 128) { MK_FRAME(); float* MOD = WSP(float, WS_MOD); float* GG = WSP(float, WS_GG);
        pg8::Gemm g{WSP(bf16, WS_ACT), WSP(bf16, WS_WD) + (size_t)l * D * DFF, M, D, DFF}; pg8::StaticOrder S; S.init(M, D, F.G, F.bid);
        EpiDown E; E.aux = aux; E.tid = F.tid; E.xr = WSP(float, WS_XR); E.xo = l == 1 ? F.a->out : WSP(float, WS_XR); E.xg = WSP(bf16, WS_XG);
        E.g2 = MOD + (size_t)l * 5 * 6144 + 5120; E.gg1n = GG + (size_t)((l == 1 ? 0 : (l + 1) * 2) * 5) * D; E.ssqp = WSP(float, WS_SSQ1P); E.last = (l == 1);
        pg8::gemm_phase<EpiDown, pg8::StaticOrder, true, true>(F.lds, g, S, E, F.tid); }
        MK_BAR(P + 5); }
}
template <int KM> __global__ void __launch_bounds__(NTHR, 2) mk_fwd(Args args) {
    extern __shared__ __attribute__((aligned(16))) unsigned char lds[];
    KArgs ka0 = (KArgs)__builtin_amdgcn_kernarg_segment_ptr();
    const int wave0 = __builtin_amdgcn_readfirstlane(threadIdx.x >> 6);
    const int ph_lo = ka0->ph_lo, ph_hi = ka0->ph_hi, use_bar = ka0->use_bar;
    if (MK_IN(0)) { if constexpr (KM & 1) { MK_FRAME(); p0_phase(F); } MK_BAR(0); }
    if (MK_IN(1)) { if constexpr (KM & 2) { MK_FRAME(); p1_phase(F); } MK_BAR(1); }
    layer_phases<KM, 0>(lds, wave0, ph_lo, ph_hi, use_bar);
    layer_phases<KM, 1>(lds, wave0, ph_lo, ph_hi, use_bar);
}

extern "C" void kernel_launch(void* const* d_in, const int* in_sizes, int n_in, void* d_out, int out_size, void* d_ws, size_t ws_size, hipStream_t stream) {
    static int grid = 0;
    if (grid == 0) {
        if (n_in != 31 || ws_size < WS_END) { fprintf(stderr, "kernel_launch: expected 31 inputs and >= %zu bytes of workspace; got %d, %zu\n", (size_t)WS_END, n_in, ws_size); grid = -1; return; }
        int dev = 0, cus = 0;
        if (hipGetDevice(&dev) != hipSuccess || hipDeviceGetAttribute(&cus, hipDeviceAttributeMultiprocessorCount, dev) != hipSuccess) { grid = -1; return; }
        if (hipFuncSetAttribute((const void*)mk_fwd<255>, hipFuncAttributeMaxDynamicSharedMemorySize, LDS_BYTES) != hipSuccess) { fprintf(stderr, "kernel_launch: hipFuncSetAttribute failed\n"); grid = -1; return; }
        int per_cu = 0;
        if (hipOccupancyMaxActiveBlocksPerMultiprocessor(&per_cu, (const void*)mk_fwd<255>, NTHR, LDS_BYTES) != hipSuccess || per_cu < 1) { fprintf(stderr, "kernel_launch: occupancy query says %d blocks per CU\n", per_cu); (void)hipGetLastError(); }
        grid = cus > 0 ? cus : 256;
    }
    if (grid < 0) return;
    (void)hipMemsetAsync((char*)d_ws + WS_CTL, 0, CTL_ZERO_BYTES, stream);
    Args a{};
    for (int i = 0; i < 31; ++i) a.in[i] = (const float*)d_in[i];
    a.out = (float*)d_out; a.ws = (unsigned char*)d_ws;
    a.ph_lo = 0; a.ph_hi = N_PHASES; a.use_bar = 1; a.pad = 0;
    void* kargs[] = {&a};
    hipError_t e = hipLaunchCooperativeKernel((const void*)mk_fwd<255>, dim3(grid), dim3(NTHR), kargs, LDS_BYTES, stream);
    if (e != hipSuccess) fprintf(stderr, "kernel_launch: cooperative launch failed: %s (grid %d)\n", hipGetErrorString(e), grid);
}
```

```cpp
#include <hip/hip_runtime.h>
#include <cstdio>
#include <cstdint>

namespace pg8 {
#define PG8_LAS __attribute__((address_space(3)))
typedef unsigned short bf16_t;
typedef short bf16x8 __attribute__((ext_vector_type(8)));
typedef float f32x4 __attribute__((ext_vector_type(4)));
typedef unsigned u32x4 __attribute__((ext_vector_type(4)));
constexpr int BM = 256, BK = 64, HALF = 128, HTB = HALF * BK * 2  , STAGE_BYTES = 8 * HTB, NXCD = 8, WGM = 8;

__host__ __device__ __forceinline__ int lds_byte(int r, int c) { const int st = (r >> 4) * 2 + (c >> 5), rr = r & 15, cc = c & 31, ob = rr * 64 + cc * 2; return st * 1024 + (ob ^ (((ob >> 9) & 1) << 5)); }
__host__ __device__ __forceinline__ void stage_rc(int b, int& R, int& C) { const int st = b / 1024, sb = b % 1024, swz = sb ^ (((sb >> 9) & 1) << 5); R = (st >> 1) * 16 + swz / 64; C = (st & 1) * 32 + (swz % 64) / 2; }
__host__ __device__ __forceinline__ int perm32(int rho) { const int n = rho >> 4, i = rho & 15; return 8 * (i >> 2) + 4 * n + (i & 3); }

struct Unit { int pm, pn; };
struct Gemm { const bf16_t* A; const bf16_t* Bt; int M, N, K; };

struct StaticOrder {
    int nM, nN, nwg, G, c;
    __host__ __device__ void init(int M, int N, int G_, int c_) { nM = M / BM; nN = N / BM; nwg = nM * nN; G = G_; c = c_; }
    __host__ __device__ bool next(int i, Unit& u) const {
        const long L = (long)i * G + c; if (L >= nwg) return false;
        int wgid = (int)L; { const int q = nwg / NXCD, r = nwg % NXCD, xcd = wgid % NXCD, off = wgid / NXCD; wgid = (xcd < r ? xcd * (q + 1) : r * (q + 1) + (xcd - r) * q) + off; }
        const int nig = WGM * nN, gid = wgid / nig, fm = gid * WGM, gsz = (nM - fm) < WGM ? (nM - fm) : WGM;
        u.pm = fm + ((wgid % nig) % gsz); u.pn = (wgid % nig) / gsz; return true;
    }
};
__device__ __forceinline__ unsigned cvt_pk_bf16(float lo, float hi) { unsigned r; asm volatile("v_cvt_pk_bf16_f32 %0, %1, %2" : "=v"(r) : "v"(lo), "v"(hi)); return r; }

template <class Epi, class Sched, bool ALIGN_EPI = false, bool SP2 = false>
__device__ __forceinline__ void gemm_phase(PG8_LAS unsigned char* lds, const Gemm g, const Sched& S, const Epi& E, int tid_in) {
    int tid_ = tid_in; asm volatile("" : "+v"(tid_));
    const int tid = tid_, wid = __builtin_amdgcn_readfirstlane(tid >> 6), lane = tid & 63, wr = wid >> 2, wc = wid & 3, fr = lane & 15, fq = lane >> 4;
    const int K = g.K, nt = K / BK;
    unsigned voffA[2], voffB[2];
#pragma unroll
    for (int i = 0; i < 2; ++i) { int R, C; stage_rc(tid * 16 + i * 8192, R, C); const int Rb = Epi::PERM ? ((R & ~31) + perm32(R & 31)) : R;
        voffA[i] = (unsigned)(R * K + C) * 2u; voffB[i] = (unsigned)(Rb * K + C) * 2u; }
    const size_t kstep = (size_t)(BK * 2);
    const size_t hstep = (size_t)HALF * K * 2;
    const size_t tstep = 2 * hstep;
    const unsigned ldsw = (unsigned)wid * 1024u;
    const int aoff = lds_byte(wr * 64 + fr, fq * 8), boff = lds_byte(wc * 32 + fr, fq * 8);
#define PG8_SA(b, h) (((b) * 2 + (h)) * HTB)
#define PG8_SB(b, h) ((4 + (b) * 2 + (h)) * HTB)
#define PG8_STAGE(bufoff, gbase, voff) do { _Pragma("unroll") for (int _i = 0; _i < 2; ++_i) \
        __builtin_amdgcn_global_load_lds((const unsigned*)((const char*)(gbase) + (voff)[_i]), (PG8_LAS unsigned*)(lds + (bufoff) + ldsw + _i * 8192), 16, 0, 0); } while (0)
#define PG8_LDA(dst, b, h) do { _Pragma("unroll") for (int m = 0; m < 4; ++m) _Pragma("unroll") for (int k = 0; k < 2; ++k) dst[m][k] = *(const PG8_LAS bf16x8*)(lds + PG8_SA(b, h) + aoff + m * 2048 + k * 1024); } while (0)
#define PG8_LDB(dst, b, h) do { _Pragma("unroll") for (int n = 0; n < 2; ++n) _Pragma("unroll") for (int k = 0; k < 2; ++k) dst[n][k] = *(const PG8_LAS bf16x8*)(lds + PG8_SB(b, h) + boff + n * 2048 + k * 1024); } while (0)
#define PG8_MMA(ai, bj, At, Bt) do { __builtin_amdgcn_s_setprio(1); _Pragma("unroll") for (int m = 0; m < 4; ++m) _Pragma("unroll") for (int n = 0; n < 2; ++n) _Pragma("unroll") for (int k = 0; k < 2; ++k) \
        acc[ai][bj][m][n] = __builtin_amdgcn_mfma_f32_16x16x32_bf16(Bt[n][k], At[m][k], acc[ai][bj][m][n], 0, 0, 0); __builtin_amdgcn_s_setprio(0); } while (0)
#define PG8_WAIT_V(n) asm volatile("s_waitcnt vmcnt(" #n ")" ::: "memory")
#define PG8_WAIT_L(n) asm volatile("s_waitcnt lgkmcnt(" #n ")" ::: "memory")
#define PG8_BAR __builtin_amdgcn_s_barrier()
#define PG8_SCHED __builtin_amdgcn_sched_barrier(0)
    Unit cur, nxt; int ui = 0;
    if (!S.next(0, cur)) return;
    f32x4 acc[2][2][4][2];
#pragma unroll
    for (int a = 0; a < 2; ++a)
#pragma unroll
        for (int b = 0; b < 2; ++b)
#pragma unroll
            for (int m = 0; m < 4; ++m)
#pragma unroll
                for (int n = 0; n < 2; ++n) acc[a][b][m][n] = (f32x4){0.f, 0.f, 0.f, 0.f};
    bf16x8 At[4][2], B0[2][2], B1[2][2];
    const char* cA = (const char*)g.A + (size_t)cur.pm * tstep; const char* cB = (const char*)g.Bt + (size_t)cur.pn * tstep;
    E.prep(cur, 0);
    if constexpr (SP2) {
        PG8_STAGE(PG8_SB(0, 0), cB, voffB); PG8_STAGE(PG8_SB(0, 1), cB + hstep, voffB); PG8_STAGE(PG8_SA(0, 0), cA, voffA); PG8_STAGE(PG8_SA(0, 1), cA + hstep, voffA);
        if (wr == 1) PG8_BAR;
        PG8_WAIT_V(2); PG8_BAR;
        PG8_STAGE(PG8_SB(1, 0), cB + kstep, voffB); PG8_STAGE(PG8_SA(1, 0), cA + kstep, voffA); PG8_STAGE(PG8_SB(1, 1), cB + hstep + kstep, voffB);
        PG8_WAIT_V(6); PG8_BAR;
    } else {
        PG8_STAGE(PG8_SB(0, 0), cB, voffB); PG8_STAGE(PG8_SA(0, 0), cA, voffA); PG8_STAGE(PG8_SB(0, 1), cB + hstep, voffB); PG8_STAGE(PG8_SA(0, 1), cA + hstep, voffA);
        if (wr == 1) PG8_BAR;
        PG8_WAIT_V(4); PG8_BAR;
        PG8_STAGE(PG8_SB(1, 0), cB + kstep, voffB); PG8_STAGE(PG8_SA(1, 0), cA + kstep, voffA); PG8_STAGE(PG8_SB(1, 1), cB + hstep + kstep, voffB);
        PG8_WAIT_V(6); PG8_BAR;
    }
    for (;;) {
        const bool has_next = S.next(ui + 1, nxt);
        const char* nA = has_next ? (const char*)g.A + (size_t)nxt.pm * tstep : cA; const char* nB = has_next ? (const char*)g.Bt + (size_t)nxt.pn * tstep : cB;
        for (int t = 0; t < nt; t += 2) {
            const bool last = (t == nt - 2);
            const char* a1 = cA + (size_t)(t + 1) * kstep;
            const char* a2 = last ? nA : cA + (size_t)(t + 2) * kstep; const char* b2 = last ? nB : cB + (size_t)(t + 2) * kstep;
            const char* a3 = a2 + kstep; const char* b3 = b2 + kstep;
            if (last && has_next) E.prep(nxt, (ui + 1) & 1);
            if constexpr (Epi::KRESCALE) { if (t == 4) E.rescale(acc, 0, ui & 1, wr, fr); else if (t == 8) E.rescale(acc, 1, ui & 1, wr, fr); }
            if constexpr (SP2) {
            PG8_LDB(B0, 0, 0); PG8_LDB(B1, 0, 1); PG8_SCHED; PG8_LDA(At, 0, 0); PG8_STAGE(PG8_SA(1, 1), a1 + hstep, voffA);
            PG8_WAIT_V(8); PG8_WAIT_L(0); PG8_BAR; PG8_MMA(0, 0, At, B0); PG8_MMA(0, 1, At, B1); PG8_BAR; PG8_SCHED;
            PG8_LDA(At, 0, 1); PG8_STAGE(PG8_SB(0, 0), b2, voffB); PG8_STAGE(PG8_SB(0, 1), b2 + hstep, voffB); PG8_STAGE(PG8_SA(0, 0), a2, voffA);
            PG8_WAIT_V(8); PG8_WAIT_L(0); PG8_BAR; PG8_MMA(1, 0, At, B0); PG8_MMA(1, 1, At, B1); PG8_BAR; PG8_SCHED;
            PG8_LDB(B0, 1, 0); PG8_LDB(B1, 1, 1); PG8_SCHED; PG8_LDA(At, 1, 0); PG8_STAGE(PG8_SA(0, 1), a2 + hstep, voffA);
            PG8_WAIT_V(8); PG8_WAIT_L(0); PG8_BAR; PG8_MMA(0, 0, At, B0); PG8_MMA(0, 1, At, B1); PG8_BAR; PG8_SCHED;
            PG8_LDA(At, 1, 1); PG8_STAGE(PG8_SB(1, 0), b3, voffB); PG8_STAGE(PG8_SB(1, 1), b3 + hstep, voffB); PG8_STAGE(PG8_SA(1, 0), a3, voffA);
            PG8_WAIT_V(8); PG8_WAIT_L(0); PG8_BAR; PG8_MMA(1, 0, At, B0); PG8_MMA(1, 1, At, B1); PG8_BAR; PG8_SCHED;
            } else {
            PG8_LDB(B0, 0, 0); PG8_SCHED; PG8_LDA(At, 0, 0); PG8_STAGE(PG8_SA(1, 1), a1 + hstep, voffA);
            PG8_WAIT_L(8); PG8_BAR; PG8_WAIT_L(0); PG8_MMA(0, 0, At, B0); PG8_BAR; PG8_SCHED;
            PG8_LDB(B1, 0, 1); PG8_STAGE(PG8_SB(0, 0), b2, voffB);
            PG8_BAR; PG8_WAIT_L(0); PG8_MMA(0, 1, At, B1); PG8_BAR;
            PG8_LDA(At, 0, 1); PG8_STAGE(PG8_SA(0, 0), a2, voffA);
            PG8_BAR; PG8_WAIT_L(0); PG8_MMA(1, 0, At, B0); PG8_BAR; PG8_SCHED;
            PG8_STAGE(PG8_SB(0, 1), b2 + hstep, voffB);
            PG8_WAIT_V(6); PG8_BAR; PG8_MMA(1, 1, At, B1); PG8_BAR;
            PG8_LDB(B0, 1, 0); PG8_SCHED; PG8_LDA(At, 1, 0); PG8_STAGE(PG8_SA(0, 1), a2 + hstep, voffA);
            PG8_WAIT_L(8); PG8_BAR; PG8_WAIT_L(0); PG8_MMA(0, 0, At, B0); PG8_BAR; PG8_SCHED;
            PG8_LDB(B1, 1, 1); PG8_STAGE(PG8_SB(1, 0), b3, voffB);
            PG8_BAR; PG8_WAIT_L(0); PG8_MMA(0, 1, At, B1); PG8_BAR;
            PG8_LDA(At, 1, 1); PG8_STAGE(PG8_SA(1, 0), a3, voffA);
            PG8_BAR; PG8_WAIT_L(0); PG8_MMA(1, 0, At, B0); PG8_BAR; PG8_SCHED;
            PG8_STAGE(PG8_SB(1, 1), b3 + hstep, voffB);
            PG8_WAIT_V(6); PG8_BAR; PG8_MMA(1, 1, At, B1); PG8_BAR;
            }
        }
        if constexpr (ALIGN_EPI) { if (wr == 0) PG8_BAR; }
        E(acc, cur, wr, wc, fr, fq, ui & 1);
        if (!has_next) break;
#pragma unroll
        for (int a = 0; a < 2; ++a)
#pragma unroll
            for (int b = 0; b < 2; ++b)
#pragma unroll
                for (int m = 0; m < 4; ++m)
#pragma unroll
                    for (int n = 0; n < 2; ++n) acc[a][b][m][n] = (f32x4){0.f, 0.f, 0.f, 0.f};
        cur = nxt; cA = nA; cB = nB; ++ui;
        if constexpr (ALIGN_EPI) { if (wr == 1) PG8_BAR; }
    }
    PG8_WAIT_V(0);
    if constexpr (!ALIGN_EPI) { if (wr == 0) PG8_BAR; }
    PG8_BAR;
#undef PG8_SA
#undef PG8_SB
#undef PG8_STAGE
#undef PG8_LDA
#undef PG8_LDB
#undef PG8_MMA
#undef PG8_WAIT_V
#undef PG8_WAIT_L
#undef PG8_BAR
#undef PG8_SCHED
}
}

#define GAS __attribute__((address_space(1)))
#define LAS __attribute__((address_space(3)))
typedef unsigned short bf16;
typedef unsigned v4u __attribute__((ext_vector_type(4)));
typedef unsigned v2u __attribute__((ext_vector_type(2)));
typedef float f32x4 __attribute__((ext_vector_type(4)));
typedef float f32x2 __attribute__((ext_vector_type(2)));
typedef short bf16x8 __attribute__((ext_vector_type(8)));
typedef short bf16x4 __attribute__((ext_vector_type(4)));

constexpr int NWAVES = 8, NTHR = 512;
constexpr int M = 8192, MC = 4096, D = 1024, NIN = 1952, NINP = 2048, DFF = 2816, NGU = 5632;
constexpr int O_SC = 768, O_CQ = 1536, O_CKV = 1792, O_KPE = 1920;
constexpr int NH = 8, QKD = 96, VD = 64, QL = 256, KVL = 128, ROPE = 32;
constexpr float EPS = 1e-6f;
constexpr float QSCALE = 0.10206207261596575f * 1.4426950408889634f;
constexpr int XL0 = 2 * 256 + 32, XL1 = 2 * 1024 + 32;
constexpr int FILT_LAYER = 256 * (XL0 + XL1);
constexpr int OUT_CKV = M * D, OUT_KPE = OUT_CKV + 16 * 2 * 256 * 128;
constexpr int N_PHASES = 14;

constexpr size_t MiB = 1u << 20;
constexpr size_t WS_CTL = 0, CTL_ZERO_BYTES = 1 * MiB;
constexpr size_t CTL_QCTR = 128 * 1024;
constexpr size_t CTL_SSQHY = 256 * 1024;
constexpr size_t WS_MOD = 384 * 1024;
constexpr size_t WS_GG = 1 * MiB;
constexpr size_t WS_BIN = WS_GG + 2 * 2 * 5 * 1024 * 4;
constexpr size_t WS_BGU = WS_BIN + 2 * 5 * 2048 * 4;
constexpr size_t WS_SSQ1P = 2 * MiB;
constexpr size_t WS_SSQ2P = WS_SSQ1P + 16 * M * 4;
constexpr size_t WS_SSQSC = WS_SSQ2P + 16 * M * 4;
constexpr size_t WS_SSQAT = WS_SSQSC + M * 4;
constexpr size_t WS_ROPE = WS_SSQAT + 8 * M * 4;
constexpr size_t WS_FILT = 4 * MiB;
constexpr size_t WS_WIN = 8 * MiB;
constexpr size_t WS_WOUT = WS_WIN + 2ull * NINP * D * 2;
constexpr size_t WS_WGU = WS_WOUT + 2ull * D * D * 2;
constexpr size_t WS_WD = WS_WGU + 2ull * NGU * D * 2;
constexpr size_t WS_WUQ = WS_WD + 2ull * D * DFF * 2;
constexpr size_t WS_WUKV = WS_WUQ + 2ull * 768 * 256 * 2;
constexpr size_t WS_XG = 58 * MiB;
constexpr size_t WS_XR = WS_XG + (size_t)M * D * 2;
constexpr size_t WS_PROJ = WS_XR + (size_t)M * D * 4;
constexpr size_t WS_Q = WS_PROJ + (size_t)M * NINP * 2;
constexpr size_t WS_ACT = WS_PROJ;
constexpr size_t WS_KC = WS_Q + (size_t)M * 768 * 2;
constexpr size_t WS_VTC = WS_KC + 16ull * 256 * 768 * 2;
constexpr size_t WS_KL = WS_VTC + 16ull * 8 * 64 * 256 * 2;
constexpr size_t WS_VTL = WS_KL + 2ull * 4 * 1280 * 768 * 2;
constexpr size_t WS_YMIX = WS_VTL + 2ull * 4 * 8 * 64 * 1280 * 2;
constexpr size_t WS_END = WS_YMIX + (size_t)M * D * 2;
static_assert(WS_MOD + 2 * 5 * 6144 * 4 <= CTL_ZERO_BYTES && CTL_SSQHY + 2 * M * 4 <= WS_MOD && WS_BGU + 2 * 5 * 5632 * 4 <= WS_SSQ1P && WS_ROPE + 1024 * 32 * 4 <= WS_FILT && WS_FILT + 2ull * FILT_LAYER * 2 <= WS_WIN && WS_WUKV + 2ull * 1024 * 128 * 2 <= WS_XG, "ws map");
static_assert((size_t)M * DFF * 2 == (size_t)M * NINP * 2 + (size_t)M * 768 * 2, "ACT overlays PROJ|Q exactly");
static_assert(WS_END <= 256 * MiB, "ws fits 256 MiB");
constexpr int CW_BAR = 4096;

constexpr int RING_BYTES = 131072;
constexpr int MISC_OFF = RING_BYTES;
constexpr int AUX_OFF = RING_BYTES + 1024;
constexpr int LDS_BYTES = 155648;
static_assert(AUX_OFF + 5 * 1024 * 4 <= LDS_BYTES, "LDS map");

#define LDS_WAIT() asm volatile("s_waitcnt lgkmcnt(0)" ::: "memory")
#define VM_WAIT() asm volatile("s_waitcnt vmcnt(0)" ::: "memory")
__device__ __forceinline__ unsigned f2bf(float f) { unsigned u = __builtin_bit_cast(unsigned, f); return (u + 0x7fffu + ((u >> 16) & 1u)) >> 16; }
__device__ __forceinline__ unsigned pk2(float lo, float hi) { return f2bf(lo) | (f2bf(hi) << 16); }
__device__ __forceinline__ float bf2f(unsigned short b) { return __builtin_bit_cast(float, (unsigned)b << 16); }
__device__ __forceinline__ float bflo(unsigned w) { return __builtin_bit_cast(float, w << 16); }
__device__ __forceinline__ float bfhi(unsigned w) { return __builtin_bit_cast(float, w & 0xffff0000u); }
__device__ __forceinline__ float shx(float v, int mask, int lane) { return __builtin_bit_cast(float, __builtin_amdgcn_ds_bpermute((lane ^ mask) << 2, __builtin_bit_cast(int, v))); }
__device__ __forceinline__ float rdl(float v, int src) { return __builtin_bit_cast(float, __builtin_amdgcn_readlane(__builtin_bit_cast(int, v), src)); }
__device__ __forceinline__ float wave_sum(float v, int lane) {
#pragma unroll
    for (int o = 1; o < 64; o <<= 1) v += shx(v, o, lane);
    return v;
}
__device__ __forceinline__ int modidx(int row) { return row < MC ? 0 : 1 + ((row - MC) >> 10); }


#define XB_TMO      128
#define XB_XCNT(j)  (256  + 64 * (j))
#define XB_XSUB(j)  (1280 + 64 * (j))
#define XB_XGEN(j)  (2304 + 64 * (j))
#define XB_TOP      3328
#define XB_TOPGEN   3392
#define XCD_BAR_WORDS 3456
#define XB_SPIN_CAP (1u << 18)
__device__ __forceinline__ unsigned xb_ld(unsigned* p)              { return __hip_atomic_load(p, __ATOMIC_RELAXED, __HIP_MEMORY_SCOPE_AGENT); }
__device__ __forceinline__ unsigned xb_add(unsigned* p, unsigned v) { return __hip_atomic_fetch_add(p, v, __ATOMIC_RELAXED, __HIP_MEMORY_SCOPE_AGENT); }
__device__ __forceinline__ unsigned xb_xcc_id() { return (unsigned)__builtin_amdgcn_s_getreg((3 << 11) | 20) & 0xFu; }
#define XB_SPIN(cond, bar) do { unsigned _sp = 0; while (cond) { __builtin_amdgcn_s_sleep(1); \
    if ((++_sp & 255u) == 0u) { if (xb_ld(&(bar)[XB_TMO])) break; if (_sp > XB_SPIN_CAP) { atomicAdd(&(bar)[XB_TMO], 1u); break; } } } } while (0)
__device__ __forceinline__ void xcd_barrier_complete(unsigned* bar, unsigned x, unsigned& nloc, unsigned& nx) {
    const unsigned G = gridDim.x * gridDim.y * gridDim.z;
    unsigned sum, cnt, mine, sp = 0u;
    for (;;) {
        sum = 0u; cnt = 0u; mine = 0u;
#pragma unroll
        for (unsigned j = 0; j < 16; ++j) { const unsigned c = xb_ld(&bar[XB_XCNT(j)]); sum += c; cnt += (c > 0u) ? 1u : 0u; mine = (j == x) ? c : mine; }
        if (sum == G) break;
        __builtin_amdgcn_s_sleep(1);
        if ((++sp & 255u) == 0u) { if (xb_ld(&bar[XB_TMO])) break; if (sp > XB_SPIN_CAP) { atomicAdd(&bar[XB_TMO], 1u); break; } }
    }
    nloc = mine > 0u ? mine : 1u; nx = cnt > 0u ? cnt : 1u;
}
__device__ __forceinline__ void xcd_barrier(unsigned* bar, unsigned x, volatile LAS unsigned* st, bool leader) {
    asm volatile("s_waitcnt vmcnt(0)" ::: "memory");
    __syncthreads();
    if (leader) {
        __builtin_amdgcn_s_waitcnt(0);
        unsigned nloc = st[0], nx = st[1];
        if (nloc == 0u) { xcd_barrier_complete(bar, x, nloc, nx); st[0] = nloc; st[1] = nx; }
        const unsigned old = xb_add(&bar[XB_XSUB(x)], 1u);
        const unsigned gen = old / nloc;
        if (old + 1u == (gen + 1u) * nloc) {
            __builtin_amdgcn_fence(__ATOMIC_RELEASE, "agent");
            asm volatile("s_waitcnt vmcnt(0)" ::: "memory");
            const unsigned og = xb_add(&bar[XB_TOP], 1u);
            const unsigned tg = og / nx;
            if (og + 1u == (tg + 1u) * nx) xb_add(&bar[XB_TOPGEN], 1u);
            else XB_SPIN(xb_ld(&bar[XB_TOPGEN]) == tg, bar);
            __builtin_amdgcn_fence(__ATOMIC_ACQUIRE, "agent");
            xb_add(&bar[XB_XGEN(x)], 1u);
            asm volatile("s_waitcnt vmcnt(0)" ::: "memory");
        } else {
            XB_SPIN(xb_ld(&bar[XB_XGEN(x)]) == gen, bar);
            __builtin_amdgcn_fence(__ATOMIC_ACQUIRE, "agent");
            asm volatile("s_waitcnt vmcnt(0)" ::: "memory");
        }
    }
    __syncthreads();
}

struct Args { const float* in[31]; float* out; unsigned char* ws; int ph_lo, ph_hi, use_bar, li, no_ssq, pad; };
enum { I_XP = 0, I_XS, I_CCKV, I_CKPE, I_C, I_CCTX, I_WMOD, I_BMOD, I_GN1, I_WIN, I_HYCONV, I_HYW1, I_HYB1, I_HYFREQ, I_HYW2, I_HYB2, I_HYW3, I_HYBIAS, I_SCCONV,
       I_GQ, I_WUQ, I_GKV, I_WUKV, I_GQH, I_GKH, I_GGRP, I_WOUT, I_GN2, I_WG, I_WU, I_WD };

typedef const __attribute__((address_space(4))) Args* KArgs;
struct Frame {
    LAS unsigned char* lds;
    int tid, lane, wave, G, bid;
    KArgs a;
    unsigned char* ws;
};
#define WSP(T, off) ((T*)(F.ws + (off)))

__device__ __forceinline__ void tr_item(const float* W, int N, int k0, int n0, bf16* WT, int ldk, int dst_row0, const float* kscale, LAS float* scr, int lane) {
#pragma unroll 8
    for (int i = 0; i < 32; ++i) { const int kk = 2 * i + (lane >> 5); float v = W[(size_t)(k0 + kk) * N + n0 + (lane & 31)]; if (kscale) v *= kscale[k0 + kk]; scr[kk * 33 + (lane & 31)] = v; }
    LDS_WAIT(); asm volatile("" ::: "memory");
    const int c = lane & 7;
#pragma unroll
    for (int j = 0; j < 4; ++j) { const int n = (lane >> 3) + 8 * j; const LAS float* s = scr + (8 * c) * 33 + n;
        v4u o; o.x = pk2(s[0 * 33], s[1 * 33]); o.y = pk2(s[2 * 33], s[3 * 33]); o.z = pk2(s[4 * 33], s[5 * 33]); o.w = pk2(s[6 * 33], s[7 * 33]);
        *(v4u*)(WT + (size_t)(dst_row0 + n) * ldk + k0 + 8 * c) = o; }
    LDS_WAIT(); asm volatile("" ::: "memory");
}
constexpr int T_IN = 16 * 61, T_OUT = 16 * 32, T_G = 16 * 88, T_D = 44 * 32, T_UQ = 4 * 24, T_UKV = 2 * 32;
constexpr int T_LAYER = T_IN + T_OUT + 2 * T_G + T_D + T_UQ + T_UKV;
constexpr int IT_MOD = 192 * 8, IT_FILT = 2 * 1280, IT_ROPE = 256;
constexpr int P0_ITEMS = IT_MOD + IT_FILT + IT_ROPE + 2 * T_LAYER;

__device__ __forceinline__ void p0_mod_item(Frame& F, int it, const LAS float* sv) {
    const int kc = it & 7, nbl = it >> 3, l = nbl / 96, n0 = (nbl % 96) * 64 + F.lane, k0 = kc * 128;
    const float* W = F.a->in[I_WMOD] + (size_t)l * D * 6144 + n0;
    float acc[5] = {0.f, 0.f, 0.f, 0.f, 0.f};
    for (int k = k0; k < k0 + 128; k += 8) {
        float w[8];
#pragma unroll
        for (int u = 0; u < 8; ++u) w[u] = W[(size_t)(k + u) * 6144];
#pragma unroll
        for (int u = 0; u < 8; ++u)
#pragma unroll
            for (int j = 0; j < 5; ++j) acc[j] += sv[j * 1024 + k + u] * w[u];
    }
    const float b = kc == 0 ? F.a->in[I_BMOD][l * 6144 + n0] : 0.f;
    float* mod = WSP(float, WS_MOD) + (size_t)l * 5 * 6144 + n0;
#pragma unroll
    for (int j = 0; j < 5; ++j) atomicAdd(mod + j * 6144, acc[j] + b);
}
__device__ __forceinline__ void p0_filt_item(Frame& F, int it) {
    const int l = it / 1280, r = it % 1280, sel = r >= 256, m = sel ? r - 256 : r, L = sel ? 1024 : 256, lane = F.lane;
    const float* w1 = F.a->in[I_HYW1] + l * 33 * 64; const float* w2 = F.a->in[I_HYW2] + l * 64 * 64; const float* w3 = F.a->in[I_HYW3] + l * 64 * 512;
    const float zt = (float)m / (float)(L - 1), wang = 6.283185307179586f * (float)m / (float)L;
    float zv = 0.f;
    if (lane == 0) zv = zt;
    else if (lane <= 16) { const float band = 1e-4f + (float)(lane - 1) * ((15.0f - 1e-4f) / 15.0f); zv = cosf(band * wang); }
    else if (lane <= 32) { const float band = 1e-4f + (float)(lane - 17) * ((15.0f - 1e-4f) / 15.0f); zv = -sinf(band * wang); }
    const float fr = F.a->in[I_HYFREQ][l * 64 + lane];
    float s = F.a->in[I_HYB1][l * 64 + lane];
    for (int i = 0; i < 33; ++i) s += rdl(zv, i) * w1[i * 64 + lane];
    const float h1 = sinf(fr * s);
    s = F.a->in[I_HYB2][l * 64 + lane];
    for (int i = 0; i < 64; ++i) s += rdl(h1, i) * w2[i * 64 + lane];
    const float h2 = sinf(fr * s);
    float h3[8] = {0.f, 0.f, 0.f, 0.f, 0.f, 0.f, 0.f, 0.f};
    for (int i = 0; i < 64; ++i) { const float hv = rdl(h2, i);
#pragma unroll
        for (int q = 0; q < 8; ++q) h3[q] += hv * w3[i * 512 + q * 64 + lane]; }
    const int XL = 2 * L + 32;
    bf16* R = WSP(bf16, WS_FILT) + (size_t)l * FILT_LAYER + (sel ? 256 * XL0 : 0);
    const float da = logf(0.01f) / 0.3f, db = logf(0.01f) / 1.5f;
#pragma unroll
    for (int q = 0; q < 4; ++q) { const int c = q * 64 + lane; const float delta = fabsf(da + (float)c * ((db - da) / 255.0f)); const float win = expf(-zt * delta) + 0.05f;
        R[(size_t)c * XL + (L + 32 - m)] = (bf16)f2bf(h3[q] * win + (m == 0 ? F.a->in[I_HYBIAS][l * 256 + c] : 0.f));
        if (m >= 1) R[(size_t)c * XL + (L + 32 + m)] = (bf16)f2bf(h3[q + 4] * win);
        if (m == 0) for (int i = 0; i <= 32; ++i) R[(size_t)c * XL + i] = 0; }
}
__device__ __forceinline__ void p0_phase(Frame& F) {
    LAS float* sv = (LAS float*)(F.lds + AUX_OFF);
    for (int i = F.tid; i < 5 * 1024; i += NTHR) { const int j = i >> 10, k = i & 1023; const float c = (j == 0) ? F.a->in[I_CCTX][k] : F.a->in[I_C][(j - 1) * 1024 + k]; sv[i] = c / (1.f + expf(-c)); }
    __syncthreads();
    LAS float* scr = (LAS float*)(F.lds + F.wave * 16384);
    const int gw = F.wave * F.G + F.bid, NGW = F.G * NWAVES;
    for (int it = gw; it < P0_ITEMS; it += NGW) {
        int r = it;
        if (r < IT_MOD) { p0_mod_item(F, r, sv); continue; } r -= IT_MOD;
        if (r < IT_FILT) { p0_filt_item(F, r); continue; } r -= IT_FILT;
        if (r < IT_ROPE) { const int t = r * 4 + (F.lane >> 4), e16 = F.lane & 15; const float pos = (float)((e16 < 8) ? (t >> 6) : (t & 63));
            const float x = pos * exp2f(-(float)(e16 & 7) * (13.287712379549449f / 8.0f));
            const float k = rintf(x * 0.15915494309189535f); float rr = fmaf(-k, 6.2831854820251465f, x); rr = fmaf(-k, -1.7484555e-07f, rr);
            float* T = WSP(float, WS_ROPE) + (size_t)t * 32; T[e16] = cosf(rr); T[16 + e16] = sinf(rr); continue; } r -= IT_ROPE;
        const int l = r / T_LAYER; r -= l * T_LAYER;
        if (r < T_IN) { const int kb = r / 61, nb = r % 61; tr_item(F.a->in[I_WIN] + (size_t)l * D * NIN, NIN, kb * 64, nb * 32, WSP(bf16, WS_WIN) + (size_t)l * NINP * D, D, nb * 32, nullptr, scr, F.lane); continue; } r -= T_IN;
        if (r < T_OUT) { const int kb = r / 32, nb = r % 32; tr_item(F.a->in[I_WOUT] + (size_t)l * D * D, D, kb * 64, nb * 32, WSP(bf16, WS_WOUT) + (size_t)l * D * D, D, nb * 32, F.a->in[I_GGRP] + l * D, scr, F.lane); continue; } r -= T_OUT;
        if (r < 2 * T_G) { const int up = r >= T_G; if (up) r -= T_G; const int kb = r / 88, nb = r % 88, u0 = nb * 32;
            tr_item(F.a->in[up ? I_WU : I_WG] + (size_t)l * D * DFF, DFF, kb * 64, u0, WSP(bf16, WS_WGU) + (size_t)l * NGU * D, D, (u0 >> 7) * 256 + up * 128 + (u0 & 127), nullptr, scr, F.lane); continue; } r -= 2 * T_G;
        if (r < T_D) { const int kb = r / 32, nb = r % 32; tr_item(F.a->in[I_WD] + (size_t)l * DFF * D, D, kb * 64, nb * 32, WSP(bf16, WS_WD) + (size_t)l * D * DFF, DFF, nb * 32, nullptr, scr, F.lane); continue; } r -= T_D;
        if (r < T_UQ) { const int kb = r / 24, nb = r % 24; tr_item(F.a->in[I_WUQ] + (size_t)l * QL * 768, 768, kb * 64, nb * 32, WSP(bf16, WS_WUQ) + (size_t)l * 768 * QL, QL, nb * 32, nullptr, scr, F.lane); continue; } r -= T_UQ;
        { const int kb = r / 32, nb = r % 32; tr_item(F.a->in[I_WUKV] + (size_t)l * KVL * 1024, 1024, kb * 64, nb * 32, WSP(bf16, WS_WUKV) + (size_t)l * 1024 * KVL, KVL, nb * 32, nullptr, scr, F.lane); }
    }
}

constexpr int AQ_LD = 264, AKV_LD = 136;
constexpr int QK_AQ = 0, QK_AKV = QK_AQ + 64 * AQ_LD * 2, QK_KPE = QK_AKV + 64 * AKV_LD * 2, QK_KSS = QK_KPE + 64 * 32 * 4, QK_KRS = QK_KSS + 64 * 4, QK_END = QK_KRS + 8 * 64 * 4;
static_assert(QK_END <= RING_BYTES, "qkv LDS");

template <bool FROM_CACHE>
__device__ __forceinline__ void qkv_unit(Frame& F, int l, int u) {
    LAS bf16* Aq = (LAS bf16*)(F.lds + QK_AQ); LAS bf16* Akv = (LAS bf16*)(F.lds + QK_AKV);
    LAS float* kpe = (LAS float*)(F.lds + QK_KPE); LAS float* kss = (LAS float*)(F.lds + QK_KSS); LAS float* krs = (LAS float*)(F.lds + QK_KRS);
    const int tid = F.tid, lane = F.lane, h = F.wave, f = lane & 15, g = lane >> 4;
    const int row0 = FROM_CACHE ? 0 : u * 64;
    const bool latent = FROM_CACHE ? false : (row0 >= MC);
    int t0, Lk; bf16* Kseg; bf16* Vtseg;
    if (FROM_CACHE) { const int ridx = (u & 15) * 64, b = ridx >> 8; t0 = 1024 + (ridx & 255); Lk = 1280;
        Kseg = WSP(bf16, WS_KL) + ((size_t)(l * 4 + b) * 1280) * 768; Vtseg = WSP(bf16, WS_VTL) + (size_t)(l * 4 + b) * 8 * 64 * 1280; }
    else if (latent) { const int b = (row0 - MC) >> 10; t0 = (row0 - MC) & 1023; Lk = 1280;
        Kseg = WSP(bf16, WS_KL) + ((size_t)(l * 4 + b) * 1280) * 768; Vtseg = WSP(bf16, WS_VTL) + (size_t)(l * 4 + b) * 8 * 64 * 1280; }
    else { const int b = row0 >> 8; t0 = row0 & 255; Lk = 256; Kseg = WSP(bf16, WS_KC) + ((size_t)b * 256) * 768; Vtseg = WSP(bf16, WS_VTC) + (size_t)b * 8 * 64 * 256; }
    {
        const int r = tid >> 3, s = tid & 7;
        if (!FROM_CACHE) {
            const bf16* prow = WSP(bf16, WS_PROJ) + (size_t)(row0 + r) * NINP;
            float v[32]; float ss = 0.f;
#pragma unroll
            for (int i = 0; i < 4; ++i) { const v4u w = *(const v4u*)(prow + O_CQ + s * 32 + i * 8);
                v[i * 8 + 0] = bflo(w.x); v[i * 8 + 1] = bfhi(w.x); v[i * 8 + 2] = bflo(w.y); v[i * 8 + 3] = bfhi(w.y); v[i * 8 + 4] = bflo(w.z); v[i * 8 + 5] = bfhi(w.z); v[i * 8 + 6] = bflo(w.w); v[i * 8 + 7] = bfhi(w.w); }
#pragma unroll
            for (int i = 0; i < 32; ++i) ss += v[i] * v[i];
            ss += shx(ss, 1, lane); ss += shx(ss, 2, lane); ss += shx(ss, 4, lane);
            const float rstd = rsqrtf(ss * (1.0f / QL) + EPS);
            const float* gq = F.a->in[I_GQ] + l * QL + s * 32;
#pragma unroll
            for (int i = 0; i < 4; ++i) { v4u o; o.x = pk2(v[i * 8 + 0] * rstd * gq[i * 8 + 0], v[i * 8 + 1] * rstd * gq[i * 8 + 1]); o.y = pk2(v[i * 8 + 2] * rstd * gq[i * 8 + 2], v[i * 8 + 3] * rstd * gq[i * 8 + 3]);
                o.z = pk2(v[i * 8 + 4] * rstd * gq[i * 8 + 4], v[i * 8 + 5] * rstd * gq[i * 8 + 5]); o.w = pk2(v[i * 8 + 6] * rstd * gq[i * 8 + 6], v[i * 8 + 7] * rstd * gq[i * 8 + 7]);
                *(LAS v4u*)(Aq + r * AQ_LD + s * 32 + i * 8) = o; }
        }
        float c[16], p[4];
        if (FROM_CACHE) { const int ridx = (u & 15) * 64 + r, b = ridx >> 8, t = ridx & 255;
            const float* ck = F.a->in[I_CCKV] + ((size_t)((b * 2 + l) * 256 + t)) * 128 + s * 16; const float* kp = F.a->in[I_CKPE] + ((size_t)((b * 2 + l) * 256 + t)) * 32 + s * 4;
#pragma unroll
            for (int i = 0; i < 4; ++i) { const f32x4 w = *(const f32x4*)(ck + i * 4); c[i * 4] = w.x; c[i * 4 + 1] = w.y; c[i * 4 + 2] = w.z; c[i * 4 + 3] = w.w; }
            const f32x4 w = *(const f32x4*)kp; p[0] = w.x; p[1] = w.y; p[2] = w.z; p[3] = w.w;
        } else { const bf16* prow = WSP(bf16, WS_PROJ) + (size_t)(row0 + r) * NINP;
#pragma unroll
            for (int i = 0; i < 2; ++i) { const v4u w = *(const v4u*)(prow + O_CKV + s * 16 + i * 8);
                c[i * 8 + 0] = bflo(w.x); c[i * 8 + 1] = bfhi(w.x); c[i * 8 + 2] = bflo(w.y); c[i * 8 + 3] = bfhi(w.y); c[i * 8 + 4] = bflo(w.z); c[i * 8 + 5] = bfhi(w.z); c[i * 8 + 6] = bflo(w.w); c[i * 8 + 7] = bfhi(w.w); }
            const v2u w = *(const v2u*)(prow + O_KPE + s * 4); p[0] = bflo(w.x); p[1] = bfhi(w.x); p[2] = bflo(w.y); p[3] = bfhi(w.y);
        }
        float ss = 0.f;
#pragma unroll
        for (int i = 0; i < 16; ++i) ss += c[i] * c[i];
        ss += shx(ss, 1, lane); ss += shx(ss, 2, lane); ss += shx(ss, 4, lane);
        const float rstd = rsqrtf(ss * (1.0f / KVL) + EPS);
        const float* gkv = F.a->in[I_GKV] + l * KVL + s * 16;
#pragma unroll
        for (int i = 0; i < 2; ++i) { v4u o; o.x = pk2(c[i * 8 + 0] * rstd * gkv[i * 8 + 0], c[i * 8 + 1] * rstd * gkv[i * 8 + 1]); o.y = pk2(c[i * 8 + 2] * rstd * gkv[i * 8 + 2], c[i * 8 + 3] * rstd * gkv[i * 8 + 3]);
            o.z = pk2(c[i * 8 + 4] * rstd * gkv[i * 8 + 4], c[i * 8 + 5] * rstd * gkv[i * 8 + 5]); o.w = pk2(c[i * 8 + 6] * rstd * gkv[i * 8 + 6], c[i * 8 + 7] * rstd * gkv[i * 8 + 7]);
            *(LAS v4u*)(Akv + r * AKV_LD + s * 16 + i * 8) = o; }
        float ps = p[0] * p[0] + p[1] * p[1] + p[2] * p[2] + p[3] * p[3];
        ps += shx(ps, 1, lane); ps += shx(ps, 2, lane); ps += shx(ps, 4, lane);
        *(LAS f32x4*)(kpe + r * 32 + s * 4) = (f32x4){p[0], p[1], p[2], p[3]};
        if (s == 0) kss[r] = ps;
    }
    __syncthreads();
    if (!FROM_CACHE) {
        const bf16* Wt = WSP(bf16, WS_WUQ) + (size_t)l * 768 * QL + (size_t)(h * QKD) * QL;
        const float* gqh = F.a->in[I_GQH] + l * QKD;
        float gq[6];
#pragma unroll
        for (int ct = 0; ct < 6; ++ct) gq[ct] = gqh[ct * 16 + f];
        const float* RT = WSP(float, WS_ROPE);
        bf16* Qo = WSP(bf16, WS_Q);
#pragma unroll 1
        for (int rh = 0; rh < 2; ++rh) {
        f32x4 acc[2][6];
#pragma unroll
        for (int rt = 0; rt < 2; ++rt)
#pragma unroll
            for (int ct = 0; ct < 6; ++ct) acc[rt][ct] = (f32x4){0.f, 0.f, 0.f, 0.f};
#pragma unroll 1
        for (int kk = 0; kk < 8; ++kk) {
            bf16x8 a[2], b[6];
#pragma unroll
            for (int rt = 0; rt < 2; ++rt) a[rt] = *(const LAS bf16x8*)(Aq + ((rh * 2 + rt) * 16 + f) * AQ_LD + kk * 32 + g * 8);
#pragma unroll
            for (int ct = 0; ct < 6; ++ct) b[ct] = *(const bf16x8*)(Wt + (size_t)(ct * 16 + f) * QL + kk * 32 + g * 8);
#pragma unroll
            for (int rt = 0; rt < 2; ++rt)
#pragma unroll
                for (int ct = 0; ct < 6; ++ct) acc[rt][ct] = __builtin_amdgcn_mfma_f32_16x16x32_bf16(a[rt], b[ct], acc[rt][ct], 0, 0, 0);
        }
#pragma unroll
        for (int rt = 0; rt < 2; ++rt)
#pragma unroll
            for (int i = 0; i < 4; ++i) {
                float ss = 0.f;
#pragma unroll
                for (int ct = 0; ct < 6; ++ct) ss += acc[rt][ct][i] * acc[rt][ct][i];
                ss += shx(ss, 1, lane); ss += shx(ss, 2, lane); ss += shx(ss, 4, lane); ss += shx(ss, 8, lane);
                const float rstd = rsqrtf(ss * (1.0f / QKD) + EPS);
                const int tok = (rh * 2 + rt) * 16 + 4 * g + i, t = t0 + tok;
                float v[6];
#pragma unroll
                for (int ct = 0; ct < 6; ++ct) v[ct] = acc[rt][ct][i] * rstd * gq[ct];
                if (latent) {
#pragma unroll
                    for (int ct = 4; ct < 6; ++ct) { const float partner = shx(v[ct], 8, lane); const float cs = RT[(size_t)t * 32 + (ct - 4) * 8 + (f & 7)], sn = RT[(size_t)t * 32 + 16 + (ct - 4) * 8 + (f & 7)];
                        v[ct] = v[ct] * cs + (f < 8 ? -partner : partner) * sn; }
                }
                bf16* qrow = Qo + (size_t)(row0 + tok) * 768 + h * QKD + f;
#pragma unroll
                for (int ct = 0; ct < 6; ++ct) qrow[ct * 16] = (bf16)f2bf(v[ct] * QSCALE);
            }
        }
    }
    {
        const bf16* Wt = WSP(bf16, WS_WUKV) + (size_t)l * 1024 * KVL + (size_t)(h * 128) * KVL;
        const float* gkh = F.a->in[I_GKH] + l * QKD;
        float gk[4];
#pragma unroll
        for (int ct = 0; ct < 4; ++ct) gk[ct] = gkh[ct * 16 + f];
#pragma unroll 1
        for (int rh = 0; rh < 2; ++rh) {
        f32x4 acc[2][8];
#pragma unroll
        for (int rt = 0; rt < 2; ++rt)
#pragma unroll
            for (int ct = 0; ct < 8; ++ct) acc[rt][ct] = (f32x4){0.f, 0.f, 0.f, 0.f};
#pragma unroll 1
        for (int kk = 0; kk < 4; ++kk) {
            bf16x8 a[2], b[8];
#pragma unroll
            for (int rt = 0; rt < 2; ++rt) a[rt] = *(const LAS bf16x8*)(Akv + ((rh * 2 + rt) * 16 + f) * AKV_LD + kk * 32 + g * 8);
#pragma unroll
            for (int ct = 0; ct < 8; ++ct) b[ct] = *(const bf16x8*)(Wt + (size_t)(ct * 16 + f) * KVL + kk * 32 + g * 8);
#pragma unroll
            for (int rt = 0; rt < 2; ++rt)
#pragma unroll
                for (int ct = 0; ct < 8; ++ct) acc[rt][ct] = __builtin_amdgcn_mfma_f32_16x16x32_bf16(a[rt], b[ct], acc[rt][ct], 0, 0, 0);
        }
#pragma unroll
        for (int rt = 0; rt < 2; ++rt) {
#pragma unroll
            for (int i = 0; i < 4; ++i) {
                float ss = 0.f;
#pragma unroll
                for (int ct = 0; ct < 4; ++ct) ss += acc[rt][ct][i] * acc[rt][ct][i];
                ss += shx(ss, 1, lane); ss += shx(ss, 2, lane); ss += shx(ss, 4, lane); ss += shx(ss, 8, lane);
                const int tok = (rh * 2 + rt) * 16 + 4 * g + i;
                const float rstd = rsqrtf((ss + kss[tok]) * (1.0f / QKD) + EPS);
                if (f == 0) krs[h * 64 + tok] = rstd;
                bf16* krow = Kseg + (size_t)(t0 + tok) * 768 + h * QKD + f;
#pragma unroll
                for (int ct = 0; ct < 4; ++ct) krow[ct * 16] = (bf16)f2bf(acc[rt][ct][i] * rstd * gk[ct]);
            }
#pragma unroll
            for (int ct = 4; ct < 8; ++ct) { const int d = (ct - 4) * 16 + f;
                v2u o; o.x = pk2(acc[rt][ct][0], acc[rt][ct][1]); o.y = pk2(acc[rt][ct][2], acc[rt][ct][3]);
                *(v2u*)(Vtseg + ((size_t)h * 64 + d) * Lk + t0 + (rh * 2 + rt) * 16 + 4 * g) = o; }
        }
        }
        LDS_WAIT(); asm volatile("" ::: "memory");
        {
            const int tok = lane, t = t0 + tok; const float rs = krs[h * 64 + tok];
            float v[32];
#pragma unroll
            for (int i = 0; i < 8; ++i) { const f32x4 w = *(const LAS f32x4*)(kpe + tok * 32 + i * 4); v[i * 4] = w.x; v[i * 4 + 1] = w.y; v[i * 4 + 2] = w.z; v[i * 4 + 3] = w.w; }
#pragma unroll
            for (int i = 0; i < 32; ++i) v[i] *= rs * gkh[64 + i];
            if (latent) {
#pragma unroll
                for (int ax = 0; ax < 2; ++ax) { const float* RT = WSP(float, WS_ROPE) + (size_t)t * 32 + ax * 8;
#pragma unroll
                    for (int e = 0; e < 8; ++e) { const float cs = RT[e], sn = RT[16 + e]; const float A = v[ax * 16 + e], B = v[ax * 16 + 8 + e]; v[ax * 16 + e] = A * cs - B * sn; v[ax * 16 + 8 + e] = B * cs + A * sn; } }
            }
            bf16* krow = Kseg + (size_t)t * 768 + h * QKD + 64;
#pragma unroll
            for (int i = 0; i < 4; ++i) { v4u o; o.x = pk2(v[i * 8], v[i * 8 + 1]); o.y = pk2(v[i * 8 + 2], v[i * 8 + 3]); o.z = pk2(v[i * 8 + 4], v[i * 8 + 5]); o.w = pk2(v[i * 8 + 6], v[i * 8 + 7]); *(v4u*)(krow + i * 8) = o; }
        }
    }
    __syncthreads();
}

constexpr int P1_XROWS = M, P1_GG = 20, P1_BIAS = 2 * (NIN / 8 + NGU / 8);
constexpr int P1_ITEMS = P1_XROWS + P1_GG + P1_BIAS;
__device__ __forceinline__ void p1_phase(Frame& F) {
    const int gw = F.wave * F.G + F.bid, NGW = F.G * NWAVES, lane = F.lane;
    const float* MOD = WSP(float, WS_MOD);
    for (int it = gw; it < P1_ITEMS; it += NGW) {
        int r = it;
        if (r < P1_XROWS) {
            const float* xr = (r < MC) ? F.a->in[I_XP] + (size_t)r * D : F.a->in[I_XS] + (size_t)(r - MC) * D;
            const int j = modidx(r); const float* sc1 = MOD + (size_t)j * 6144 + 1024; const float* gn = F.a->in[I_GN1];
            f32x4 v[4]; float s = 0.f;
#pragma unroll
            for (int q = 0; q < 4; ++q) { v[q] = *(const f32x4*)(xr + 256 * q + 4 * lane); s += (v[q].x * v[q].x + v[q].y * v[q].y) + (v[q].z * v[q].z + v[q].w * v[q].w); }
            s = wave_sum(s, lane);
            bf16* o = WSP(bf16, WS_XG) + (size_t)r * D;
#pragma unroll
            for (int q = 0; q < 4; ++q) { const int c = 256 * q + 4 * lane; const f32x4 g = *(const f32x4*)(gn + c); const f32x4 sc = *(const f32x4*)(sc1 + c);
                v2u w; w.x = pk2(v[q].x * g.x * (1.f + sc.x), v[q].y * g.y * (1.f + sc.y)); w.y = pk2(v[q].z * g.z * (1.f + sc.z), v[q].w * g.w * (1.f + sc.w)); *(v2u*)(o + c) = w; }
            if (lane == 0) WSP(float, WS_SSQ1P)[r] = s;
            continue;
        }
        r -= P1_XROWS;
        if (r < P1_GG) { const int l = r / 10, kind = (r % 10) / 5, j = r % 5;
            const float* gn = F.a->in[kind ? I_GN2 : I_GN1] + l * D; const float* sc = MOD + ((size_t)l * 5 + j) * 6144 + (kind ? 4096 : 1024);
            float* o = WSP(float, WS_GG) + ((size_t)(l * 2 + kind) * 5 + j) * D;
#pragma unroll
            for (int q = 0; q < 4; ++q) { const int c = 256 * q + 4 * lane; const f32x4 g = *(const f32x4*)(gn + c); const f32x4 s4 = *(const f32x4*)(sc + c); *(f32x4*)(o + c) = (f32x4){g.x * (1.f + s4.x), g.y * (1.f + s4.y), g.z * (1.f + s4.z), g.w * (1.f + s4.w)}; }
            continue;
        }
        r -= P1_GG;
        {
            const int per = NIN / 8 + NGU / 8, l = r / per; int q = r % per; const bool gu = q >= NIN / 8; if (gu) q -= NIN / 8;
            const bf16* Wt = gu ? WSP(bf16, WS_WGU) + (size_t)l * NGU * D : WSP(bf16, WS_WIN) + (size_t)l * NINP * D;
            float* bo = gu ? WSP(float, WS_BGU) + (size_t)l * 5 * NGU : WSP(float, WS_BIN) + (size_t)l * 5 * NINP; const int ldb = gu ? NGU : NINP;
            const float* shb = MOD + (size_t)l * 5 * 6144 + (gu ? 3072 : 0);
            float sh[5][16];
#pragma unroll
            for (int j = 0; j < 5; ++j)
#pragma unroll
                for (int hh = 0; hh < 2; ++hh)
#pragma unroll
                    for (int e = 0; e < 2; ++e) { const f32x4 w = *(const f32x4*)(shb + (size_t)j * 6144 + hh * 512 + lane * 8 + e * 4); sh[j][hh * 8 + e * 4] = w.x; sh[j][hh * 8 + e * 4 + 1] = w.y; sh[j][hh * 8 + e * 4 + 2] = w.z; sh[j][hh * 8 + e * 4 + 3] = w.w; }
            for (int n8 = 0; n8 < 8; ++n8) { const int n = q * 8 + n8; const bf16* wr = Wt + (size_t)n * D;
                float w[16];
#pragma unroll
                for (int hh = 0; hh < 2; ++hh) { const v4u x = *(const v4u*)(wr + hh * 512 + lane * 8); w[hh * 8] = bflo(x.x); w[hh * 8 + 1] = bfhi(x.x); w[hh * 8 + 2] = bflo(x.y); w[hh * 8 + 3] = bfhi(x.y); w[hh * 8 + 4] = bflo(x.z); w[hh * 8 + 5] = bfhi(x.z); w[hh * 8 + 6] = bflo(x.w); w[hh * 8 + 7] = bfhi(x.w); }
#pragma unroll
                for (int j = 0; j < 5; ++j) { float s = 0.f;
#pragma unroll
                    for (int e = 0; e < 16; ++e) s += w[e] * sh[j][e];
                    s = wave_sum(s, lane); if (lane == 0) bo[(size_t)j * ldb + n] = s; }
            }
        }
    }
    for (int u = F.bid; u < 32; u += F.G) qkv_unit<true>(F, u >> 4, u);
}

__device__ __forceinline__ void prep_phase(Frame& F, int l) {
    for (int u = F.bid; u < M / 64; u += F.G) qkv_unit<false>(F, l, u);
}

typedef float f32x16 __attribute__((ext_vector_type(16)));
constexpr int AT_KLD = 208, AT_VLD = 136;
constexpr int AT_KT = 64 * AT_KLD, AT_VT = 64 * AT_VLD, AT_BUF = AT_KT + AT_VT;
static_assert(2 * AT_BUF <= RING_BYTES, "attention LDS");
__device__ __forceinline__ void attn_unit(Frame& F, int l, bool latent, int seg, int h, int qb) {
    const int tid = F.tid, lane = F.lane, r32 = lane & 31, hh = lane >> 5;
    const int Lk = latent ? 1280 : 256, NT = Lk / 64;
    const int qrow0 = (latent ? MC + seg * 1024 : seg * 256) + qb * 256 + F.wave * 32;
    const bf16* Kb = latent ? WSP(bf16, WS_KL) + ((size_t)(l * 4 + seg) * 1280) * 768 + h * QKD : WSP(bf16, WS_KC) + ((size_t)seg * 256) * 768 + h * QKD;
    const bf16* Vt = latent ? WSP(bf16, WS_VTL) + ((size_t)(l * 4 + seg) * 8 + h) * 64 * 1280 : WSP(bf16, WS_VTC) + ((size_t)seg * 8 + h) * 64 * 256;
    bf16x8 qf[6];
    { const bf16* Qp = WSP(bf16, WS_Q) + (size_t)(qrow0 + r32) * 768 + h * QKD + hh * 8;
#pragma unroll
      for (int kk = 0; kk < 6; ++kk) qf[kk] = *(const bf16x8*)(Qp + kk * 16); }
    const int kr0 = tid / 12, kc0 = tid % 12, kr1 = (tid + 512) / 12, kc1 = (tid + 512) % 12, vr = tid >> 3, vc = tid & 7;
    const bf16* ksrc0 = Kb + (size_t)kr0 * 768 + kc0 * 8; const bf16* ksrc1 = Kb + (size_t)kr1 * 768 + kc1 * 8; const bf16* vsrc = Vt + (size_t)vr * Lk + vc * 8;
    const int kdst0 = kr0 * AT_KLD + kc0 * 16, kdst1 = kr1 * AT_KLD + kc1 * 16, vdst = AT_KT + vr * AT_VLD + vc * 16;
    const bool k2 = tid < 256;
    v4u sk0, sk1 = (v4u){0u, 0u, 0u, 0u}, sv;
#define AT_LOAD(t) do { sk0 = *(const v4u*)(ksrc0 + (size_t)(t) * 64 * 768); if (k2) sk1 = *(const v4u*)(ksrc1 + (size_t)(t) * 64 * 768); sv = *(const v4u*)(vsrc + (t) * 64); } while (0)
#define AT_WRITE(buf) do { LAS unsigned char* b_ = F.lds + (buf) * AT_BUF; *(LAS v4u*)(b_ + kdst0) = sk0; if (k2) *(LAS v4u*)(b_ + kdst1) = sk1; \
        *(LAS v2u*)(b_ + vdst) = (v2u){sv.x, sv.y}; *(LAS v2u*)(b_ + vdst + 8) = (v2u){sv.z, sv.w}; } while (0)
    AT_LOAD(0); AT_WRITE(0);
    __syncthreads();
    float mrun = -1e30f, lsum = 0.f;
    f32x16 o0, o1;
#pragma unroll
    for (int r = 0; r < 16; ++r) { o0[r] = 0.f; o1[r] = 0.f; }
    const int koff = r32 * AT_KLD + hh * 16, voff = AT_KT + r32 * AT_VLD + hh * 8;
    for (int t = 0; t < NT; ++t) {
        if (t + 1 < NT) AT_LOAD(t + 1);
        const LAS unsigned char* B = F.lds + (t & 1) * AT_BUF;
        f32x16 s0, s1;
#pragma unroll
        for (int r = 0; r < 16; ++r) { s0[r] = 0.f; s1[r] = 0.f; }
#pragma unroll
        for (int kk = 0; kk < 6; ++kk) {
            const bf16x8 a0 = *(const LAS bf16x8*)(B + koff + kk * 32), a1 = *(const LAS bf16x8*)(B + koff + 32 * AT_KLD + kk * 32);
            s0 = __builtin_amdgcn_mfma_f32_32x32x16_bf16(a0, qf[kk], s0, 0, 0, 0); s1 = __builtin_amdgcn_mfma_f32_32x32x16_bf16(a1, qf[kk], s1, 0, 0, 0);
        }
        float mx = fmaxf(s0[0], s1[0]);
#pragma unroll
        for (int r = 1; r < 16; ++r) mx = fmaxf(mx, fmaxf(s0[r], s1[r]));
        mx = fmaxf(mx, shx(mx, 32, lane));
        const float mnew = fmaxf(mrun, mx), alpha = __builtin_amdgcn_exp2f(mrun - mnew); mrun = mnew;
        float ps = 0.f;
#pragma unroll
        for (int r = 0; r < 16; ++r) { s0[r] = __builtin_amdgcn_exp2f(s0[r] - mnew); s1[r] = __builtin_amdgcn_exp2f(s1[r] - mnew); ps += s0[r] + s1[r]; }
        lsum = lsum * alpha + ps;
#pragma unroll
        for (int r = 0; r < 16; ++r) { o0[r] *= alpha; o1[r] *= alpha; }
#pragma unroll
        for (int gs = 0; gs < 4; ++gs) {
            v4u pw;
            if (gs == 0) { pw.x = pk2(s0[0], s0[1]); pw.y = pk2(s0[2], s0[3]); pw.z = pk2(s0[4], s0[5]); pw.w = pk2(s0[6], s0[7]); }
            else if (gs == 1) { pw.x = pk2(s0[8], s0[9]); pw.y = pk2(s0[10], s0[11]); pw.z = pk2(s0[12], s0[13]); pw.w = pk2(s0[14], s0[15]); }
            else if (gs == 2) { pw.x = pk2(s1[0], s1[1]); pw.y = pk2(s1[2], s1[3]); pw.z = pk2(s1[4], s1[5]); pw.w = pk2(s1[6], s1[7]); }
            else { pw.x = pk2(s1[8], s1[9]); pw.y = pk2(s1[10], s1[11]); pw.z = pk2(s1[12], s1[13]); pw.w = pk2(s1[14], s1[15]); }
            const bf16x8 pB = __builtin_bit_cast(bf16x8, pw);
            const v2u a0 = *(const LAS v2u*)(B + voff + gs * 32), a1 = *(const LAS v2u*)(B + voff + gs * 32 + 16);
            const v2u b0 = *(const LAS v2u*)(B + voff + 32 * AT_VLD + gs * 32), b1 = *(const LAS v2u*)(B + voff + 32 * AT_VLD + gs * 32 + 16);
            o0 = __builtin_amdgcn_mfma_f32_32x32x16_bf16(__builtin_bit_cast(bf16x8, (v4u){a0.x, a0.y, a1.x, a1.y}), pB, o0, 0, 0, 0);
            o1 = __builtin_amdgcn_mfma_f32_32x32x16_bf16(__builtin_bit_cast(bf16x8, (v4u){b0.x, b0.y, b1.x, b1.y}), pB, o1, 0, 0, 0);
        }
        if (t + 1 < NT) AT_WRITE((t + 1) & 1);
        __syncthreads();
    }
#undef AT_LOAD
#undef AT_WRITE
    lsum += shx(lsum, 32, lane);
    const float inv = 1.0f / lsum; float ss = 0.f;
    bf16* yo = WSP(bf16, WS_YMIX) + (size_t)(qrow0 + r32) * D + 512 + h * 64 + 4 * hh;
#pragma unroll
    for (int rg = 0; rg < 4; ++rg) {
        v2u w0, w1; w0.x = pk2(o0[4 * rg] * inv, o0[4 * rg + 1] * inv); w0.y = pk2(o0[4 * rg + 2] * inv, o0[4 * rg + 3] * inv);
        w1.x = pk2(o1[4 * rg] * inv, o1[4 * rg + 1] * inv); w1.y = pk2(o1[4 * rg + 2] * inv, o1[4 * rg + 3] * inv);
        *(v2u*)(yo + 8 * rg) = w0; *(v2u*)(yo + 32 + 8 * rg) = w1;
        const float a0 = bflo(w0.x), a1 = bfhi(w0.x), a2 = bflo(w0.y), a3 = bfhi(w0.y), b0 = bflo(w1.x), b1 = bfhi(w1.x), b2 = bflo(w1.y), b3 = bfhi(w1.y);
        ss += (a0 * a0 + a1 * a1) + (a2 * a2 + a3 * a3) + (b0 * b0 + b1 * b1) + (b2 * b2 + b3 * b3);
    }
    ss += shx(ss, 32, lane);
    if (hh == 0) WSP(float, WS_SSQAT)[(size_t)h * M + qrow0 + r32] = ss;
}
constexpr int HY_Z8 = 0, HY_ZIMG = 65536, HY_R = HY_ZIMG + 1064 * 32, HY_END = HY_R + 4160;
static_assert(HY_END <= RING_BYTES, "hyena LDS");
typedef short v4i16_t __attribute__((ext_vector_type(4)));
__device__ __forceinline__ bf16x4 ds_tr16(const LAS unsigned char* p) { return __builtin_bit_cast(bf16x4, __builtin_amdgcn_ds_read_tr16_b64_v4i16((LAS v4i16_t*)p)); }
__device__ __forceinline__ void hyena_unit(Frame& F, int l, bool latent, int cgp, bool do_ssq) {
    const int tid = F.tid, lane = F.lane, w = F.wave, c0 = cgp * 8;
    const int L = latent ? 1024 : 256, XL = 2 * L + 32, base_row = latent ? MC : 0, NB = L / 32 + 1;
    LAS unsigned short* Z8 = (LAS unsigned short*)(F.lds + HY_Z8); LAS unsigned char* Zimg = F.lds + HY_ZIMG; LAS unsigned char* Rl = F.lds + HY_R;
    const bf16* P = WSP(bf16, WS_PROJ); const float* cw = F.a->in[I_HYCONV] + l * 3 * 768;
    {
        float a[3][8], b[3][8];
#pragma unroll
        for (int k = 0; k < 3; ++k)
#pragma unroll
            for (int e = 0; e < 8; ++e) { a[k][e] = cw[k * 768 + 256 + c0 + e]; b[k][e] = cw[k * 768 + 512 + c0 + e]; }
#pragma unroll 1
        for (int it = 0; it < 8; ++it) { const int p = tid + 512 * it, t = p & (L - 1); const bf16* pr = P + (size_t)(base_row + p) * NINP + c0;
            float x1[8], vv[8];
#pragma unroll
            for (int e = 0; e < 8; ++e) { x1[e] = 0.f; vv[e] = 0.f; }
#pragma unroll
            for (int dr = -1; dr <= 1; ++dr) { if (t + dr < 0 || t + dr >= L) continue;
                const v4u xa = *(const v4u*)(pr + dr * NINP + 256), xb = *(const v4u*)(pr + dr * NINP + 512);
                x1[0] += a[dr + 1][0] * bflo(xa.x); x1[1] += a[dr + 1][1] * bfhi(xa.x); x1[2] += a[dr + 1][2] * bflo(xa.y); x1[3] += a[dr + 1][3] * bfhi(xa.y);
                x1[4] += a[dr + 1][4] * bflo(xa.z); x1[5] += a[dr + 1][5] * bfhi(xa.z); x1[6] += a[dr + 1][6] * bflo(xa.w); x1[7] += a[dr + 1][7] * bfhi(xa.w);
                vv[0] += b[dr + 1][0] * bflo(xb.x); vv[1] += b[dr + 1][1] * bfhi(xb.x); vv[2] += b[dr + 1][2] * bflo(xb.y); vv[3] += b[dr + 1][3] * bfhi(xb.y);
                vv[4] += b[dr + 1][4] * bflo(xb.z); vv[5] += b[dr + 1][5] * bfhi(xb.z); vv[6] += b[dr + 1][6] * bflo(xb.w); vv[7] += b[dr + 1][7] * bfhi(xb.w); }
#pragma unroll
            for (int e = 0; e < 8; ++e) Z8[e * 4096 + p] = (unsigned short)f2bf(x1[e] * vv[e]);
        }
    }
    __syncthreads();
    const int r = lane & 15, g = lane >> 4, q = (lane & 15) >> 2, pp = lane & 3;
    const int t0 = latent ? 128 * w : 128 * (w >> 2), sh0 = latent ? 0 : 2 * (w & 3), sh1 = latent ? 4 : 2 * (w & 3) + 1;
    const int aoff = 2 * (L + 32 - t0 - 8 * r + 8 * g);
    const int boff = (32 + 8 * g + q) * 32 + pp * 8;
#pragma unroll 1
    for (int ch = 0; ch < 8; ++ch) {
        const LAS unsigned short* Zc = Z8 + ch * 4096;
        for (int idx = tid; idx < (L + 40) * 4; idx += NTHR) { const int rho = idx >> 2, q4 = idx & 3, s = rho - 32; unsigned short v0 = 0, v1 = 0, v2 = 0, v3 = 0;
            if (latent) { const LAS unsigned short* zb = Zc + q4 * 1024; if (s >= 0 && s < L) v0 = zb[s]; if (s + 1 >= 0 && s + 1 < L) v1 = zb[s + 1]; if (s + 2 >= 0 && s + 2 < L) v2 = zb[s + 2]; if (s + 3 >= 0 && s + 3 < L) v3 = zb[s + 3]; }
            else if (s >= 0 && s < L) { const LAS unsigned short* zb = Zc + (q4 * 4) * 256 + s; v0 = zb[0]; v1 = zb[256]; v2 = zb[512]; v3 = zb[768]; }
            *(LAS v2u*)(Zimg + rho * 32 + q4 * 8) = (v2u){(unsigned)v0 | ((unsigned)v1 << 16), (unsigned)v2 | ((unsigned)v3 << 16)}; }
        { const bf16* Rg = WSP(bf16, WS_FILT) + (size_t)l * FILT_LAYER + (latent ? 256 * XL0 : 0) + (size_t)(c0 + ch) * XL;
          for (int i = tid; i < XL / 8; i += NTHR) *(LAS v4u*)(Rl + i * 16) = *(const v4u*)(Rg + i * 8); }
        __syncthreads();
        f32x4 acc0 = (f32x4){0.f, 0.f, 0.f, 0.f}, acc1 = acc0;
#pragma unroll 1
        for (int kb = 0; kb < NB; ++kb) { const int s0p = 32 * kb - 32;
            const bf16x8 A = *(const LAS bf16x8*)(Rl + aoff + 2 * s0p);
            const LAS unsigned char* b0 = Zimg + boff + (s0p + sh0) * 32; const LAS unsigned char* b1 = Zimg + boff + (s0p + sh1) * 32;
            const bf16x4 l0 = ds_tr16(b0), h0 = ds_tr16(b0 + 128), l1 = ds_tr16(b1), h1 = ds_tr16(b1 + 128);
            const bf16x8 B0 = (bf16x8){l0[0], l0[1], l0[2], l0[3], h0[0], h0[1], h0[2], h0[3]}, B1 = (bf16x8){l1[0], l1[1], l1[2], l1[3], h1[0], h1[1], h1[2], h1[3]};
            acc0 = __builtin_amdgcn_mfma_f32_16x16x32_bf16(A, B0, acc0, 0, 0, 0); acc1 = __builtin_amdgcn_mfma_f32_16x16x32_bf16(A, B1, acc1, 0, 0, 0); }
        { LAS unsigned short* Yc = Z8 + ch * 4096; const int n = lane & 15;
#pragma unroll
          for (int i = 0; i < 4; ++i) { const int tb = t0 + 8 * (4 * g + i);
              if (latent) { const int pb = (n >> 2) * 1024 + tb + (n & 3); Yc[pb + sh0] = (unsigned short)f2bf(acc0[i]); Yc[pb + sh1] = (unsigned short)f2bf(acc1[i]); }
              else { const int pb = n * 256 + tb; Yc[pb + sh0] = (unsigned short)f2bf(acc0[i]); Yc[pb + sh1] = (unsigned short)f2bf(acc1[i]); } } }
        __syncthreads();
    }
    {
        float a[3][8];
#pragma unroll
        for (int k = 0; k < 3; ++k)
#pragma unroll
            for (int e = 0; e < 8; ++e) a[k][e] = cw[k * 768 + c0 + e];
        bf16* Y = WSP(bf16, WS_YMIX); float* ssq = (float*)(F.ws + WS_CTL + CTL_SSQHY) + (size_t)l * M;
#pragma unroll 1
        for (int it = 0; it < 8; ++it) { const int p = tid + 512 * it, t = p & (L - 1), row = base_row + p; const bf16* pr = P + (size_t)row * NINP + c0;
            float x0[8];
#pragma unroll
            for (int e = 0; e < 8; ++e) x0[e] = 0.f;
#pragma unroll
            for (int dr = -1; dr <= 1; ++dr) { if (t + dr < 0 || t + dr >= L) continue;
                const v4u xa = *(const v4u*)(pr + dr * NINP);
                x0[0] += a[dr + 1][0] * bflo(xa.x); x0[1] += a[dr + 1][1] * bfhi(xa.x); x0[2] += a[dr + 1][2] * bflo(xa.y); x0[3] += a[dr + 1][3] * bfhi(xa.y);
                x0[4] += a[dr + 1][4] * bflo(xa.z); x0[5] += a[dr + 1][5] * bfhi(xa.z); x0[6] += a[dr + 1][6] * bflo(xa.w); x0[7] += a[dr + 1][7] * bfhi(xa.w); }
            float o[8];
#pragma unroll
            for (int e = 0; e < 8; ++e) o[e] = x0[e] * bf2f(Z8[e * 4096 + p]);
            v4u wv; wv.x = pk2(o[0], o[1]); wv.y = pk2(o[2], o[3]); wv.z = pk2(o[4], o[5]); wv.w = pk2(o[6], o[7]);
            *(v4u*)(Y + (size_t)row * D + c0) = wv;
            const float r0 = bflo(wv.x), r1 = bfhi(wv.x), r2 = bflo(wv.y), r3 = bfhi(wv.y), r4 = bflo(wv.z), r5 = bfhi(wv.z), r6 = bflo(wv.w), r7 = bfhi(wv.w);
            if (do_ssq) atomicAdd(ssq + row, ((r0 * r0 + r1 * r1) + (r2 * r2 + r3 * r3)) + ((r4 * r4 + r5 * r5) + (r6 * r6 + r7 * r7)));
        }
    }
    __syncthreads();
}
__device__ __forceinline__ void sconv_row(Frame& F, int l, int row) {
    const int c4 = F.lane * 4; const bool latent = row >= MC; const int L = latent ? 1024 : 256, t = latent ? ((row - MC) & 1023) : (row & 255);
    const bf16* pr = WSP(bf16, WS_PROJ) + (size_t)row * NINP + O_SC + c4; const float* cw = F.a->in[I_SCCONV] + l * 3 * 256 + c4;
    float conv[4] = {0.f, 0.f, 0.f, 0.f};
#pragma unroll
    for (int dr = -1; dr <= 1; ++dr) { if (t + dr < 0 || t + dr >= L) continue;
        const v2u cg_ = *(const v2u*)(pr + dr * NINP + 256), hx = *(const v2u*)(pr + dr * NINP + 512); const f32x4 w = *(const f32x4*)(cw + (dr + 1) * 256);
        conv[0] += w.x * bflo(cg_.x) * bflo(hx.x); conv[1] += w.y * bfhi(cg_.x) * bfhi(hx.x); conv[2] += w.z * bflo(cg_.y) * bflo(hx.y); conv[3] += w.w * bfhi(cg_.y) * bfhi(hx.y); }
    const v2u bg = *(const v2u*)pr;
    v2u o; o.x = pk2(bflo(bg.x) * conv[0], bfhi(bg.x) * conv[1]); o.y = pk2(bflo(bg.y) * conv[2], bfhi(bg.y) * conv[3]);
    *(v2u*)(WSP(bf16, WS_YMIX) + (size_t)row * D + 256 + c4) = o;
    const float r0 = bflo(o.x), r1 = bfhi(o.x), r2 = bflo(o.y), r3 = bfhi(o.y);
    const float s = wave_sum((r0 * r0 + r1 * r1) + (r2 * r2 + r3 * r3), F.lane); if (F.lane == 0) WSP(float, WS_SSQSC)[row] = s;
}
constexpr int MX_ATL = 128, MX_HYL = 32, MX_ATC = 128, MX_HYC = 32, MX_SC = M / 64, MX_UNITS = MX_ATL + MX_HYL + MX_ATC + MX_HYC + MX_SC;
__device__ __forceinline__ void mix_phase(Frame& F, int l, int mode) {
    const bool do_ssq = mode == 0;
    unsigned* ctr = (unsigned*)(F.ws + WS_CTL + CTL_QCTR) + (l * 4 + F.a->li) * 64;
    volatile LAS unsigned* slot = (volatile LAS unsigned*)(F.lds + MISC_OFF) + 16;
    for (;;) {
        if (F.tid == 0) slot[0] = __hip_atomic_fetch_add(ctr, 1u, __ATOMIC_RELAXED, __HIP_MEMORY_SCOPE_AGENT);
        __syncthreads();
        const int u = (int)slot[0];
        __syncthreads();
        if (u >= MX_UNITS) break;
        int r = u;
        if (r < MX_ATL) { if (mode != 3) attn_unit(F, l, true, r >> 5, (r >> 2) & 7, r & 3); continue; } r -= MX_ATL;
        if (r < MX_HYL) { if (mode != 2) hyena_unit(F, l, true, r, do_ssq); continue; } r -= MX_HYL;
        if (r < MX_ATC) { if (mode != 3) attn_unit(F, l, false, r >> 3, r & 7, 0); continue; } r -= MX_ATC;
        if (r < MX_HYC) { if (mode != 2) hyena_unit(F, l, false, r, do_ssq); continue; } r -= MX_HYC;
        if (mode < 2) {
#pragma unroll 1
            for (int i = 0; i < 8; ++i) sconv_row(F, l, r * 64 + i * 8 + F.wave); }
    }
}

#define AUXT(par, k) (aux + ((par) * 3 + (k)) * 256)
struct EpiBase {
    LAS float* aux; int tid;
    __device__ __forceinline__ void rescale(pg8::f32x4 (&acc)[2][2][4][2], int which, int par, int wr, int fr) const {
        const LAS float* T = AUXT(par, 1 + which);
#pragma unroll
        for (int ai = 0; ai < 2; ++ai)
#pragma unroll
            for (int m = 0; m < 4; ++m) { const float s = T[ai * 128 + wr * 64 + m * 16 + fr];
#pragma unroll
                for (int bj = 0; bj < 2; ++bj)
#pragma unroll
                    for (int n = 0; n < 2; ++n) acc[ai][bj][m][n] = acc[ai][bj][m][n] * s; }
    }
};
struct EpiIn : EpiBase {
    static constexpr bool PERM = true, KRESCALE = false;
    const float* ssqp; int np; const float* bias; bf16* proj; float* out; int l;
    __device__ __forceinline__ void prep(const pg8::Unit& u, int par) const {
        if (tid < 256) { const int row = u.pm * 256 + tid; float s = 0.f;
#pragma unroll 1
            for (int p = 0; p < np; ++p) s += ssqp[(size_t)p * M + row]; AUXT(par, 0)[tid] = rsqrtf(s * (1.0f / D) + EPS); }
    }
    __device__ __forceinline__ void operator()(const pg8::f32x4 (&acc)[2][2][4][2], const pg8::Unit& u, int wr, int wc, int fr, int fq, int par) const {
        const int row0 = u.pm * 256 + wr * 64 + fr, j = modidx(u.pm * 256); const LAS float* T = AUXT(par, 0);
        const float* bp = bias + (size_t)j * NINP + u.pn * 256 + wc * 32 + 8 * fq;
        f32x4 bv[2][2];
#pragma unroll
        for (int bj = 0; bj < 2; ++bj)
#pragma unroll
            for (int n = 0; n < 2; ++n) bv[bj][n] = *(const f32x4*)(bp + bj * 128 + 4 * n);
#pragma unroll
        for (int ai = 0; ai < 2; ++ai)
#pragma unroll
            for (int m = 0; m < 4; ++m) { const int row = row0 + ai * 128 + m * 16; const float rs = T[ai * 128 + wr * 64 + m * 16 + fr];
#pragma unroll
                for (int bj = 0; bj < 2; ++bj) { const f32x4 v0 = acc[ai][bj][m][0] * rs + bv[bj][0], v1 = acc[ai][bj][m][1] * rs + bv[bj][1];
                    const int col = u.pn * 256 + bj * 128 + wc * 32 + 8 * fq;
                    v4u w; w.x = pk2(v0[0], v0[1]); w.y = pk2(v0[2], v0[3]); w.z = pk2(v1[0], v1[1]); w.w = pk2(v1[2], v1[3]);
                    *(v4u*)(proj + (size_t)row * NINP + col) = w;
                    if (u.pn == 7 && row < MC && col < NIN) { const int b = row >> 8, t = row & 255;
                        float* o = (col < O_KPE) ? out + OUT_CKV + ((size_t)((b * 2 + l) * 256 + t)) * 128 + (col - O_CKV) : out + OUT_KPE + ((size_t)((b * 2 + l) * 256 + t)) * 32 + (col - O_KPE);
                        *(f32x4*)o = v0; *(f32x4*)(o + 4) = v1; } } }
    }
};
struct EpiOut : EpiBase {
    static constexpr bool PERM = true, KRESCALE = true;
    const float* ssq_hy; const float* ssq_sc; const float* ssq_at; const float* xa; const float* xb; float* xr; bf16* xg; const float* g1; const float* gg2; float* ssqp;
    __device__ __forceinline__ void prep(const pg8::Unit& u, int par) const {
        if (tid < 256) { const int row = u.pm * 256 + tid; float sa = 0.f;
#pragma unroll 1
            for (int h = 0; h < 8; ++h) sa += ssq_at[(size_t)h * M + row];
            const float rh = rsqrtf(ssq_hy[row] * (1.0f / 256) + EPS), rs = rsqrtf(ssq_sc[row] * (1.0f / 256) + EPS), ra = rsqrtf(sa * (1.0f / 512) + EPS);
            AUXT(par, 0)[tid] = ra; AUXT(par, 1)[tid] = rh / rs; AUXT(par, 2)[tid] = rs / ra; }
    }
    __device__ __forceinline__ void operator()(const pg8::f32x4 (&acc)[2][2][4][2], const pg8::Unit& u, int wr, int wc, int fr, int fq, int par) const {
        const int row0 = u.pm * 256 + wr * 64 + fr, j = modidx(u.pm * 256); const LAS float* T = AUXT(par, 0);
        const float* xin = (u.pm * 256 < MC) ? xa : xb;
        const int lane = fq * 16 + fr;
        const int cb = u.pn * 256 + wc * 32 + 8 * fq;
#pragma unroll
        for (int ai = 0; ai < 2; ++ai)
#pragma unroll
            for (int m = 0; m < 4; ++m) { const int row = row0 + ai * 128 + m * 16; const float rs = T[ai * 128 + wr * 64 + m * 16 + fr]; float ss = 0.f;
#pragma unroll
                for (int bj = 0; bj < 2; ++bj) { const int col = cb + bj * 128; v4u w;
#pragma unroll
                    for (int n = 0; n < 2; ++n) { const f32x4 gv = *(const f32x4*)(g1 + (size_t)j * 6144 + col + 4 * n), gg = *(const f32x4*)(gg2 + (size_t)j * D + col + 4 * n);
                        const f32x4 xv = *(const f32x4*)(xin + (size_t)row * D + col + 4 * n); const f32x4 x1 = xv + gv * (acc[ai][bj][m][n] * rs);
                        *(f32x4*)(xr + (size_t)row * D + col + 4 * n) = x1; ss += (x1[0] * x1[0] + x1[1] * x1[1]) + (x1[2] * x1[2] + x1[3] * x1[3]);
                        const f32x4 y = x1 * gg; if (n == 0) { w.x = pk2(y[0], y[1]); w.y = pk2(y[2], y[3]); } else { w.z = pk2(y[0], y[1]); w.w = pk2(y[2], y[3]); } }
                    *(v4u*)(xg + (size_t)row * D + col) = w; }
                ss += shx(ss, 16, lane); ss += shx(ss, 32, lane);
                if (fq == 0) ssqp[(size_t)(u.pn * 4 + wc) * M + row] = ss; }
    }
};
struct EpiUp : EpiBase {
    static constexpr bool PERM = true, KRESCALE = false;
    const float* ssqp; const float* bias; bf16* act;
    __device__ __forceinline__ void prep(const pg8::Unit& u, int par) const {
        if (tid < 256) { const int row = u.pm * 256 + tid; float s = 0.f;
#pragma unroll 1
            for (int p = 0; p < 16; ++p) s += ssqp[(size_t)p * M + row];
            AUXT(par, 0)[tid] = rsqrtf(s * (1.0f / D) + EPS); }
    }
    __device__ __forceinline__ void operator()(const pg8::f32x4 (&acc)[2][2][4][2], const pg8::Unit& u, int wr, int wc, int fr, int fq, int par) const {
        const int row0 = u.pm * 256 + wr * 64 + fr, j = modidx(u.pm * 256); const LAS float* T = AUXT(par, 0);
        const float* bp = bias + (size_t)j * NGU + u.pn * 256 + wc * 32 + 8 * fq;
        f32x4 bv[2][2];
#pragma unroll
        for (int bj = 0; bj < 2; ++bj)
#pragma unroll
            for (int n = 0; n < 2; ++n) bv[bj][n] = *(const f32x4*)(bp + bj * 128 + 4 * n);
#pragma unroll
        for (int ai = 0; ai < 2; ++ai)
#pragma unroll
            for (int m = 0; m < 4; ++m) { const int row = row0 + ai * 128 + m * 16; const float rs = T[ai * 128 + wr * 64 + m * 16 + fr]; float a[8];
#pragma unroll
                for (int n = 0; n < 2; ++n) { const f32x4 gt = acc[ai][0][m][n] * rs + bv[0][n], up = acc[ai][1][m][n] * rs + bv[1][n];
#pragma unroll
                    for (int e = 0; e < 4; ++e) a[n * 4 + e] = gt[e] / (1.0f + __expf(-gt[e])) * up[e]; }
                v4u w; w.x = pk2(a[0], a[1]); w.y = pk2(a[2], a[3]); w.z = pk2(a[4], a[5]); w.w = pk2(a[6], a[7]);
                *(v4u*)(act + (size_t)row * DFF + u.pn * 128 + wc * 32 + 8 * fq) = w; }
    }
};
struct EpiDown : EpiBase {
    static constexpr bool PERM = true, KRESCALE = false;
    const float* xr; float* xo; bf16* xg; const float* g2; const float* gg1n; float* ssqp; int last;
    __device__ __forceinline__ void prep(const pg8::Unit&, int) const {}
    __device__ __forceinline__ void operator()(const pg8::f32x4 (&acc)[2][2][4][2], const pg8::Unit& u, int wr, int wc, int fr, int fq, int) const {
        const int row0 = u.pm * 256 + wr * 64 + fr, j = modidx(u.pm * 256), lane = fq * 16 + fr;
        const int cb = u.pn * 256 + wc * 32 + 8 * fq;
#pragma unroll
        for (int ai = 0; ai < 2; ++ai)
#pragma unroll
            for (int m = 0; m < 4; ++m) { const int row = row0 + ai * 128 + m * 16; float ss = 0.f;
#pragma unroll
                for (int bj = 0; bj < 2; ++bj) { const int col = cb + bj * 128; v4u w;
#pragma unroll
                    for (int n = 0; n < 2; ++n) { const f32x4 gv = *(const f32x4*)(g2 + (size_t)j * 6144 + col + 4 * n);
                        const f32x4 xv = *(const f32x4*)(xr + (size_t)row * D + col + 4 * n); const f32x4 x2 = xv + gv * acc[ai][bj][m][n];
                        *(f32x4*)(xo + (size_t)row * D + col + 4 * n) = x2;
                        if (!last) { const f32x4 gg = *(const f32x4*)(gg1n + (size_t)j * D + col + 4 * n); ss += (x2[0] * x2[0] + x2[1] * x2[1]) + (x2[2] * x2[2] + x2[3] * x2[3]);
                            const f32x4 y = x2 * gg; if (n == 0) { w.x = pk2(y[0], y[1]); w.y = pk2(y[2], y[3]); } else { w.z = pk2(y[0], y[1]); w.w = pk2(y[2], y[3]); } } }
                    if (!last) *(v4u*)(xg + (size_t)row * D + col) = w; }
                if (!last) { ss += shx(ss, 16, lane); ss += shx(ss, 32, lane); if (fq == 0) ssqp[(size_t)(u.pn * 4 + wc) * M + row] = ss; } }
    }
};

#define MK_FRAME() Frame F; { int l_; asm volatile("v_mbcnt_lo_u32_b32 %0, -1, 0\n\tv_mbcnt_hi_u32_b32 %0, -1, %0" : "=v"(l_)); int w_ = wave0; asm volatile("" : "+s"(w_)); F.tid = w_ * 64 + l_; F.lane = l_; F.wave = w_; \
        KArgs k_ = (KArgs)__builtin_amdgcn_kernarg_segment_ptr(); asm volatile("" : "+s"(k_)); F.a = k_; F.ws = k_->ws; int g_ = gridDim.x, b_ = blockIdx.x; asm volatile("" : "+s"(g_), "+s"(b_)); F.G = g_; F.bid = b_; } \
        F.lds = (LAS unsigned char*)lds; LAS float* aux = (LAS float*)(F.lds + AUX_OFF); (void)aux
#define MK_IN(k) (ph_lo <= (k) && (k) < ph_hi)
#define MK_BAR(k) do { if (use_bar && (k) + 1 < ph_hi) { int l_; asm volatile("v_mbcnt_lo_u32_b32 %0, -1, 0\n\tv_mbcnt_hi_u32_b32 %0, -1, %0" : "=v"(l_)); \
        KArgs k_ = (KArgs)__builtin_amdgcn_kernarg_segment_ptr(); asm volatile("" : "+s"(k_)); xcd_barrier((unsigned*)(k_->ws + WS_CTL) + CW_BAR + k_->li * XCD_BAR_WORDS, xcc, (volatile LAS unsigned*)((LAS unsigned char*)lds + MISC_OFF) + 8, wave0 == 0 && l_ == 0); } } while (0)

template <int KM, int L> __device__ __forceinline__ void layer_phases(unsigned char* lds, int wave0, int ph_lo, int ph_hi, int use_bar, unsigned xcc) {
    constexpr int l = L, P = 2 + 6 * L;
    if (MK_IN(P + 0)) { if constexpr (KM & 4) { MK_FRAME();
        pg8::Gemm g{WSP(bf16, WS_XG), WSP(bf16, WS_WIN) + (size_t)l * NINP * D, M, NINP, D}; pg8::StaticOrder S; S.init(M, NINP, F.G, F.bid);
        EpiIn E; E.aux = aux; E.tid = F.tid; E.ssqp = WSP(float, WS_SSQ1P); E.np = l == 0 ? 1 : 16; E.bias = WSP(float, WS_BIN) + (size_t)l * 5 * NINP; E.proj = WSP(bf16, WS_PROJ); E.out = F.a->out; E.l = l;
        pg8::gemm_phase<EpiIn, pg8::StaticOrder, true, true>(F.lds, g, S, E, F.tid); }
        MK_BAR(P + 0); }
    if (MK_IN(P + 1)) { if constexpr (KM & 8) { MK_FRAME(); prep_phase(F, l); } MK_BAR(P + 1); }
    if (MK_IN(P + 2)) { if constexpr (KM & 16) { MK_FRAME(); mix_phase(F, l, F.a->no_ssq); } MK_BAR(P + 2); }
    if (MK_IN(P + 3)) { if constexpr (KM & 32) { MK_FRAME(); float* MOD = WSP(float, WS_MOD); float* GG = WSP(float, WS_GG);
        pg8::Gemm g{WSP(bf16, WS_YMIX), WSP(bf16, WS_WOUT) + (size_t)l * D * D, M, D, D}; pg8::StaticOrder S; S.init(M, D, F.G, F.bid);
        EpiOut E; E.aux = aux; E.tid = F.tid; E.ssq_hy = (const float*)(F.ws + WS_CTL + CTL_SSQHY) + (size_t)l * M; E.ssq_sc = WSP(float, WS_SSQSC); E.ssq_at = WSP(float, WS_SSQAT);
        E.xa = l == 0 ? F.a->in[I_XP] : WSP(float, WS_XR); E.xb = l == 0 ? F.a->in[I_XS] - (size_t)MC * D : WSP(float, WS_XR); E.xr = WSP(float, WS_XR); E.xg = WSP(bf16, WS_XG);
        E.g1 = MOD + (size_t)l * 5 * 6144 + 2048; E.gg2 = GG + (size_t)((l * 2 + 1) * 5) * D; E.ssqp = WSP(float, WS_SSQ2P);
        pg8::gemm_phase<EpiOut, pg8::StaticOrder, true, true>(F.lds, g, S, E, F.tid); }
        MK_BAR(P + 3); }
    if (MK_IN(P + 4)) { if constexpr (KM & 64) { MK_FRAME();
        pg8::Gemm g{WSP(bf16, WS_XG), WSP(bf16, WS_WGU) + (size_t)l * NGU * D, M, NGU, D}; pg8::StaticOrder S; S.init(M, NGU, F.G, F.bid);
        EpiUp E; E.aux = aux; E.tid = F.tid; E.ssqp = WSP(float, WS_SSQ2P); E.bias = WSP(float, WS_BGU) + (size_t)l * 5 * NGU; E.act = WSP(bf16, WS_ACT);
        pg8::gemm_phase<EpiUp, pg8::StaticOrder, true, true>(F.lds, g, S, E, F.tid); }
        MK_BAR(P + 4); }
    if (MK_IN(P + 5)) { if constexpr (KM & 128) { MK_FRAME(); float* MOD = WSP(float, WS_MOD); float* GG = WSP(float, WS_GG);
        pg8::Gemm g{WSP(bf16, WS_ACT), WSP(bf16, WS_WD) + (size_t)l * D * DFF, M, D, DFF}; pg8::StaticOrder S; S.init(M, D, F.G, F.bid);
        EpiDown E; E.aux = aux; E.tid = F.tid; E.xr = WSP(float, WS_XR); E.xo = l == 1 ? F.a->out : WSP(float, WS_XR); E.xg = WSP(bf16, WS_XG);
        E.g2 = MOD + (size_t)l * 5 * 6144 + 5120; E.gg1n = GG + (size_t)((l == 1 ? 0 : (l + 1) * 2) * 5) * D; E.ssqp = WSP(float, WS_SSQ1P); E.last = (l == 1);
        pg8::gemm_phase<EpiDown, pg8::StaticOrder, true, true>(F.lds, g, S, E, F.tid); }
        MK_BAR(P + 5); }
}
template <int KM> __global__ void __launch_bounds__(NTHR, 2) mk_fwd(Args args) {
    extern __shared__ __attribute__((aligned(16))) unsigned char lds[];
    KArgs ka0 = (KArgs)__builtin_amdgcn_kernarg_segment_ptr();
    const int wave0 = __builtin_amdgcn_readfirstlane(threadIdx.x >> 6);
    const int ph_lo = ka0->ph_lo, ph_hi = ka0->ph_hi, use_bar = ka0->use_bar;
    const unsigned xcc = xb_xcc_id();
    {
        LAS unsigned* misc = (LAS unsigned*)((LAS unsigned char*)lds + MISC_OFF);
        for (int u = threadIdx.x; u < 256; u += NTHR) misc[u] = 0u;
        __syncthreads();
        if (use_bar && threadIdx.x == 0) (void)xb_add((unsigned*)(ka0->ws + WS_CTL) + CW_BAR + ka0->li * XCD_BAR_WORDS + XB_XCNT(xcc), 1u);
    }
    if (MK_IN(0)) { if constexpr (KM & 1) { MK_FRAME(); p0_phase(F); } MK_BAR(0); }
    if (MK_IN(1)) { if constexpr (KM & 2) { MK_FRAME(); p1_phase(F); } MK_BAR(1); }
    layer_phases<KM, 0>(lds, wave0, ph_lo, ph_hi, use_bar, xcc);
    layer_phases<KM, 1>(lds, wave0, ph_lo, ph_hi, use_bar, xcc);
}

extern "C" void kernel_launch(void* const* d_in, const int* in_sizes, int n_in, void* d_out, int out_size, void* d_ws, size_t ws_size, hipStream_t stream) {
    static int grid = 0;
    if (grid == 0) {
        if (n_in != 31 || ws_size < WS_END) { fprintf(stderr, "kernel_launch: expected 31 inputs and >= %zu bytes of workspace; got %d, %zu\n", (size_t)WS_END, n_in, ws_size); grid = -1; return; }
        int dev = 0, cus = 0;
        if (hipGetDevice(&dev) != hipSuccess || hipDeviceGetAttribute(&cus, hipDeviceAttributeMultiprocessorCount, dev) != hipSuccess) { grid = -1; return; }
        if (hipFuncSetAttribute((const void*)mk_fwd<255>, hipFuncAttributeMaxDynamicSharedMemorySize, LDS_BYTES) != hipSuccess) { fprintf(stderr, "kernel_launch: hipFuncSetAttribute failed\n"); grid = -1; return; }
        int per_cu = 0;
        if (hipOccupancyMaxActiveBlocksPerMultiprocessor(&per_cu, (const void*)mk_fwd<255>, NTHR, LDS_BYTES) != hipSuccess || per_cu < 1) { fprintf(stderr, "kernel_launch: occupancy query says %d blocks per CU\n", per_cu); (void)hipGetLastError(); }
        grid = cus > 0 ? cus : 256;
    }
    if (grid < 0) return;
    (void)hipMemsetAsync((char*)d_ws + WS_CTL, 0, CTL_ZERO_BYTES, stream);
    Args a{};
    for (int i = 0; i < 31; ++i) a.in[i] = (const float*)d_in[i];
    a.out = (float*)d_out; a.ws = (unsigned char*)d_ws;
#ifndef PROBE_PH
#define PROBE_PH -1
#endif
#ifndef PROBE_MODE
#define PROBE_MODE 1
#endif
    a.use_bar = 1; a.pad = 0;
    void* kargs[] = {&a};
    hipError_t e = hipSuccess;
    if (PROBE_PH < 0) {
        a.ph_lo = 0; a.ph_hi = N_PHASES; a.li = 0; a.no_ssq = 0;
        e = hipLaunchCooperativeKernel((const void*)mk_fwd<255>, dim3(grid), dim3(NTHR), kargs, LDS_BYTES, stream);
    } else {
        a.ph_lo = 0; a.ph_hi = PROBE_PH + 1; a.li = 0; a.no_ssq = 0;
        e = hipLaunchCooperativeKernel((const void*)mk_fwd<255>, dim3(grid), dim3(NTHR), kargs, LDS_BYTES, stream);
        a.ph_lo = PROBE_PH; a.ph_hi = PROBE_PH + 1; a.li = 1; a.no_ssq = PROBE_MODE;
        e = hipLaunchCooperativeKernel((const void*)mk_fwd<255>, dim3(grid), dim3(NTHR), kargs, LDS_BYTES, stream);
        if (PROBE_PH + 1 < N_PHASES) { a.ph_lo = PROBE_PH + 1; a.ph_hi = N_PHASES; a.li = 2; a.no_ssq = 0;
            e = hipLaunchCooperativeKernel((const void*)mk_fwd<255>, dim3(grid), dim3(NTHR), kargs, LDS_BYTES, stream); }
    }
    if (e != hipSuccess) fprintf(stderr, "kernel_launch: cooperative launch failed: %s (grid %d)\n", hipGetErrorString(e), grid);
}
```

```cpp
#include <hip/hip_runtime.h>
#include <cstdio>
#include <cstdint>

namespace pg8 {
#define PG8_LAS __attribute__((address_space(3)))
typedef unsigned short bf16_t;
typedef short bf16x8 __attribute__((ext_vector_type(8)));
typedef float f32x4 __attribute__((ext_vector_type(4)));
typedef unsigned u32x4 __attribute__((ext_vector_type(4)));
constexpr int BM = 256, BK = 64, HALF = 128, HTB = HALF * BK * 2  , STAGE_BYTES = 8 * HTB, NXCD = 8, WGM = 8;

__host__ __device__ __forceinline__ int lds_byte(int r, int c) { const int st = (r >> 4) * 2 + (c >> 5), rr = r & 15, cc = c & 31, ob = rr * 64 + cc * 2; return st * 1024 + (ob ^ (((ob >> 9) & 1) << 5)); }
__host__ __device__ __forceinline__ void stage_rc(int b, int& R, int& C) { const int st = b / 1024, sb = b % 1024, swz = sb ^ (((sb >> 9) & 1) << 5); R = (st >> 1) * 16 + swz / 64; C = (st & 1) * 32 + (swz % 64) / 2; }
__host__ __device__ __forceinline__ int perm32(int rho) { const int n = rho >> 4, i = rho & 15; return 8 * (i >> 2) + 4 * n + (i & 3); }

struct Unit { int pm, pn; };
struct Gemm { const bf16_t* A; const bf16_t* Bt; int M, N, K; };

struct StaticOrder {
    int nM, nN, nwg, G, c;
    __host__ __device__ void init(int M, int N, int G_, int c_) { nM = M / BM; nN = N / BM; nwg = nM * nN; G = G_; c = c_; }
    __host__ __device__ bool next(int i, Unit& u) const {
        const long L = (long)i * G + c; if (L >= nwg) return false;
        int wgid = (int)L; { const int q = nwg / NXCD, r = nwg % NXCD, xcd = wgid % NXCD, off = wgid / NXCD; wgid = (xcd < r ? xcd * (q + 1) : r * (q + 1) + (xcd - r) * q) + off; }
        const int nig = WGM * nN, gid = wgid / nig, fm = gid * WGM, gsz = (nM - fm) < WGM ? (nM - fm) : WGM;
        u.pm = fm + ((wgid % nig) % gsz); u.pn = (wgid % nig) / gsz; return true;
    }
};
__device__ __forceinline__ unsigned cvt_pk_bf16(float lo, float hi) { unsigned r; asm volatile("v_cvt_pk_bf16_f32 %0, %1, %2" : "=v"(r) : "v"(lo), "v"(hi)); return r; }

template <class Epi, class Sched, bool ALIGN_EPI = false, bool SP2 = false>
__device__ __forceinline__ void gemm_phase(PG8_LAS unsigned char* lds, const Gemm g, const Sched& S, const Epi& E, int tid_in) {
    int tid_ = tid_in; asm volatile("" : "+v"(tid_));
    const int tid = tid_, wid = __builtin_amdgcn_readfirstlane(tid >> 6), lane = tid & 63, wr = wid >> 2, wc = wid & 3, fr = lane & 15, fq = lane >> 4;
    const int K = g.K, nt = K / BK;
    unsigned voffA[2], voffB[2];
#pragma unroll
    for (int i = 0; i < 2; ++i) { int R, C; stage_rc(tid * 16 + i * 8192, R, C); const int Rb = Epi::PERM ? ((R & ~31) + perm32(R & 31)) : R;
        voffA[i] = (unsigned)(R * K + C) * 2u; voffB[i] = (unsigned)(Rb * K + C) * 2u; }
    const size_t kstep = (size_t)(BK * 2);
    const size_t hstep = (size_t)HALF * K * 2;
    const size_t tstep = 2 * hstep;
    const unsigned ldsw = (unsigned)wid * 1024u;
    const int aoff = lds_byte(wr * 64 + fr, fq * 8), boff = lds_byte(wc * 32 + fr, fq * 8);
#define PG8_SA(b, h) (((b) * 2 + (h)) * HTB)
#define PG8_SB(b, h) ((4 + (b) * 2 + (h)) * HTB)
#define PG8_STAGE(bufoff, gbase, voff) do { _Pragma("unroll") for (int _i = 0; _i < 2; ++_i) \
        __builtin_amdgcn_global_load_lds((const unsigned*)((const char*)(gbase) + (voff)[_i]), (PG8_LAS unsigned*)(lds + (bufoff) + ldsw + _i * 8192), 16, 0, 0); } while (0)
#define PG8_LDA(dst, b, h) do { _Pragma("unroll") for (int m = 0; m < 4; ++m) _Pragma("unroll") for (int k = 0; k < 2; ++k) dst[m][k] = *(const PG8_LAS bf16x8*)(lds + PG8_SA(b, h) + aoff + m * 2048 + k * 1024); } while (0)
#define PG8_LDB(dst, b, h) do { _Pragma("unroll") for (int n = 0; n < 2; ++n) _Pragma("unroll") for (int k = 0; k < 2; ++k) dst[n][k] = *(const PG8_LAS bf16x8*)(lds + PG8_SB(b, h) + boff + n * 2048 + k * 1024); } while (0)
#define PG8_MMA(ai, bj, At, Bt) do { __builtin_amdgcn_s_setprio(1); _Pragma("unroll") for (int m = 0; m < 4; ++m) _Pragma("unroll") for (int n = 0; n < 2; ++n) _Pragma("unroll") for (int k = 0; k < 2; ++k) \
        acc[ai][bj][m][n] = __builtin_amdgcn_mfma_f32_16x16x32_bf16(Bt[n][k], At[m][k], acc[ai][bj][m][n], 0, 0, 0); __builtin_amdgcn_s_setprio(0); } while (0)
#define PG8_WAIT_V(n) asm volatile("s_waitcnt vmcnt(" #n ")" ::: "memory")
#define PG8_WAIT_L(n) asm volatile("s_waitcnt lgkmcnt(" #n ")" ::: "memory")
#define PG8_BAR __builtin_amdgcn_s_barrier()
#define PG8_SCHED __builtin_amdgcn_sched_barrier(0)
    Unit cur, nxt; int ui = 0;
    if (!S.next(0, cur)) return;
    f32x4 acc[2][2][4][2];
#pragma unroll
    for (int a = 0; a < 2; ++a)
#pragma unroll
        for (int b = 0; b < 2; ++b)
#pragma unroll
            for (int m = 0; m < 4; ++m)
#pragma unroll
                for (int n = 0; n < 2; ++n) acc[a][b][m][n] = (f32x4){0.f, 0.f, 0.f, 0.f};
    bf16x8 At[4][2], B0[2][2], B1[2][2];
    const char* cA = (const char*)g.A + (size_t)cur.pm * tstep; const char* cB = (const char*)g.Bt + (size_t)cur.pn * tstep;
    E.prep(cur, 0);
    if constexpr (SP2) {
        PG8_STAGE(PG8_SB(0, 0), cB, voffB); PG8_STAGE(PG8_SB(0, 1), cB + hstep, voffB); PG8_STAGE(PG8_SA(0, 0), cA, voffA); PG8_STAGE(PG8_SA(0, 1), cA + hstep, voffA);
        if (wr == 1) PG8_BAR;
        PG8_WAIT_V(2); PG8_BAR;
        PG8_STAGE(PG8_SB(1, 0), cB + kstep, voffB); PG8_STAGE(PG8_SA(1, 0), cA + kstep, voffA); PG8_STAGE(PG8_SB(1, 1), cB + hstep + kstep, voffB);
        PG8_WAIT_V(6); PG8_BAR;
    } else {
        PG8_STAGE(PG8_SB(0, 0), cB, voffB); PG8_STAGE(PG8_SA(0, 0), cA, voffA); PG8_STAGE(PG8_SB(0, 1), cB + hstep, voffB); PG8_STAGE(PG8_SA(0, 1), cA + hstep, voffA);
        if (wr == 1) PG8_BAR;
        PG8_WAIT_V(4); PG8_BAR;
        PG8_STAGE(PG8_SB(1, 0), cB + kstep, voffB); PG8_STAGE(PG8_SA(1, 0), cA + kstep, voffA); PG8_STAGE(PG8_SB(1, 1), cB + hstep + kstep, voffB);
        PG8_WAIT_V(6); PG8_BAR;
    }
    for (;;) {
        const bool has_next = S.next(ui + 1, nxt);
        const char* nA = has_next ? (const char*)g.A + (size_t)nxt.pm * tstep : cA; const char* nB = has_next ? (const char*)g.Bt + (size_t)nxt.pn * tstep : cB;
        for (int t = 0; t < nt; t += 2) {
            const bool last = (t == nt - 2);
            const char* a1 = cA + (size_t)(t + 1) * kstep;
            const char* a2 = last ? nA : cA + (size_t)(t + 2) * kstep; const char* b2 = last ? nB : cB + (size_t)(t + 2) * kstep;
            const char* a3 = a2 + kstep; const char* b3 = b2 + kstep;
            if (last && has_next) E.prep(nxt, (ui + 1) & 1);
            if constexpr (Epi::KRESCALE) { if (t == 4) E.rescale(acc, 0, ui & 1, wr, fr); else if (t == 8) E.rescale(acc, 1, ui & 1, wr, fr); }
            if constexpr (SP2) {
            PG8_LDB(B0, 0, 0); PG8_LDB(B1, 0, 1); PG8_SCHED; PG8_LDA(At, 0, 0); PG8_STAGE(PG8_SA(1, 1), a1 + hstep, voffA);
            PG8_WAIT_V(8); PG8_WAIT_L(0); PG8_BAR; PG8_MMA(0, 0, At, B0); PG8_MMA(0, 1, At, B1); PG8_BAR; PG8_SCHED;
            PG8_LDA(At, 0, 1); PG8_STAGE(PG8_SB(0, 0), b2, voffB); PG8_STAGE(PG8_SB(0, 1), b2 + hstep, voffB); PG8_STAGE(PG8_SA(0, 0), a2, voffA);
            PG8_WAIT_V(8); PG8_WAIT_L(0); PG8_BAR; PG8_MMA(1, 0, At, B0); PG8_MMA(1, 1, At, B1); PG8_BAR; PG8_SCHED;
            PG8_LDB(B0, 1, 0); PG8_LDB(B1, 1, 1); PG8_SCHED; PG8_LDA(At, 1, 0); PG8_STAGE(PG8_SA(0, 1), a2 + hstep, voffA);
            PG8_WAIT_V(8); PG8_WAIT_L(0); PG8_BAR; PG8_MMA(0, 0, At, B0); PG8_MMA(0, 1, At, B1); PG8_BAR; PG8_SCHED;
            PG8_LDA(At, 1, 1); PG8_STAGE(PG8_SB(1, 0), b3, voffB); PG8_STAGE(PG8_SB(1, 1), b3 + hstep, voffB); PG8_STAGE(PG8_SA(1, 0), a3, voffA);
            PG8_WAIT_V(8); PG8_WAIT_L(0); PG8_BAR; PG8_MMA(1, 0, At, B0); PG8_MMA(1, 1, At, B1); PG8_BAR; PG8_SCHED;
            } else {
            PG8_LDB(B0, 0, 0); PG8_SCHED; PG8_LDA(At, 0, 0); PG8_STAGE(PG8_SA(1, 1), a1 + hstep, voffA);
            PG8_WAIT_L(8); PG8_BAR; PG8_WAIT_L(0); PG8_MMA(0, 0, At, B0); PG8_BAR; PG8_SCHED;
            PG8_LDB(B1, 0, 1); PG8_STAGE(PG8_SB(0, 0), b2, voffB);
            PG8_BAR; PG8_WAIT_L(0); PG8_MMA(0, 1, At, B1); PG8_BAR;
            PG8_LDA(At, 0, 1); PG8_STAGE(PG8_SA(0, 0), a2, voffA);
            PG8_BAR; PG8_WAIT_L(0); PG8_MMA(1, 0, At, B0); PG8_BAR; PG8_SCHED;
            PG8_STAGE(PG8_SB(0, 1), b2 + hstep, voffB);
            PG8_WAIT_V(6); PG8_BAR; PG8_MMA(1, 1, At, B1); PG8_BAR;
            PG8_LDB(B0, 1, 0); PG8_SCHED; PG8_LDA(At, 1, 0); PG8_STAGE(PG8_SA(0, 1), a2 + hstep, voffA);
            PG8_WAIT_L(8); PG8_BAR; PG8_WAIT_L(0); PG8_MMA(0, 0, At, B0); PG8_BAR; PG8_SCHED;
            PG8_LDB(B1, 1, 1); PG8_STAGE(PG8_SB(1, 0), b3, voffB);
            PG8_BAR; PG8_WAIT_L(0); PG8_MMA(0, 1, At, B1); PG8_BAR;
            PG8_LDA(At, 1, 1); PG8_STAGE(PG8_SA(1, 0), a3, voffA);
            PG8_BAR; PG8_WAIT_L(0); PG8_MMA(1, 0, At, B0); PG8_BAR; PG8_SCHED;
            PG8_STAGE(PG8_SB(1, 1), b3 + hstep, voffB);
            PG8_WAIT_V(6); PG8_BAR; PG8_MMA(1, 1, At, B1); PG8_BAR;
            }
        }
        if constexpr (ALIGN_EPI) { if (wr == 0) PG8_BAR; }
        E(acc, cur, wr, wc, fr, fq, ui & 1);
        if (!has_next) break;
#pragma unroll
        for (int a = 0; a < 2; ++a)
#pragma unroll
            for (int b = 0; b < 2; ++b)
#pragma unroll
                for (int m = 0; m < 4; ++m)
#pragma unroll
                    for (int n = 0; n < 2; ++n) acc[a][b][m][n] = (f32x4){0.f, 0.f, 0.f, 0.f};
        cur = nxt; cA = nA; cB = nB; ++ui;
        if constexpr (ALIGN_EPI) { if (wr == 1) PG8_BAR; }
    }
    PG8_WAIT_V(0);
    if constexpr (!ALIGN_EPI) { if (wr == 0) PG8_BAR; }
    PG8_BAR;
#undef PG8_SA
#undef PG8_SB
#undef PG8_STAGE
#undef PG8_LDA
#undef PG8_LDB
#undef PG8_MMA
#undef PG8_WAIT_V
#undef PG8_WAIT_L
#undef PG8_BAR
#undef PG8_SCHED
}
}

#define GAS __attribute__((address_space(1)))
#define LAS __attribute__((address_space(3)))
typedef unsigned short bf16;
typedef unsigned v4u __attribute__((ext_vector_type(4)));
typedef unsigned v2u __attribute__((ext_vector_type(2)));
typedef float f32x4 __attribute__((ext_vector_type(4)));
typedef float f32x2 __attribute__((ext_vector_type(2)));
typedef short bf16x8 __attribute__((ext_vector_type(8)));
typedef short bf16x4 __attribute__((ext_vector_type(4)));

constexpr int NWAVES = 8, NTHR = 512;
constexpr int M = 8192, MC = 4096, D = 1024, NIN = 1952, NINP = 2048, DFF = 2816, NGU = 5632;
constexpr int O_SC = 768, O_CQ = 1536, O_CKV = 1792, O_KPE = 1920;
constexpr int NH = 8, QKD = 96, VD = 64, QL = 256, KVL = 128, ROPE = 32;
constexpr float EPS = 1e-6f;
constexpr float QSCALE = 0.10206207261596575f * 1.4426950408889634f;
constexpr int XL0 = 2 * 256 + 32, XL1 = 2 * 1024 + 32;
constexpr int FILT_LAYER = 256 * (XL0 + XL1);
constexpr int OUT_CKV = M * D, OUT_KPE = OUT_CKV + 16 * 2 * 256 * 128;
constexpr int N_PHASES = 14;

constexpr size_t MiB = 1u << 20;
constexpr size_t WS_CTL = 0, CTL_ZERO_BYTES = 1 * MiB;
constexpr size_t CTL_QCTR = 128 * 1024;
constexpr size_t CTL_SSQHY = 256 * 1024;
constexpr size_t WS_MOD = 384 * 1024;
constexpr size_t WS_GG = 1 * MiB;
constexpr size_t WS_BIN = WS_GG + 2 * 2 * 5 * 1024 * 4;
constexpr size_t WS_BGU = WS_BIN + 2 * 5 * 2048 * 4;
constexpr size_t WS_SSQ1P = 2 * MiB;
constexpr size_t WS_SSQ2P = WS_SSQ1P + 16 * M * 4;
constexpr size_t WS_SSQSC = WS_SSQ2P + 16 * M * 4;
constexpr size_t WS_SSQAT = WS_SSQSC + M * 4;
constexpr size_t WS_ROPE = WS_SSQAT + 8 * M * 4;
constexpr size_t WS_FILT = 4 * MiB;
constexpr size_t WS_WIN = 8 * MiB;
constexpr size_t WS_WOUT = WS_WIN + 2ull * NINP * D * 2;
constexpr size_t WS_WGU = WS_WOUT + 2ull * D * D * 2;
constexpr size_t WS_WD = WS_WGU + 2ull * NGU * D * 2;
constexpr size_t WS_WUQ = WS_WD + 2ull * D * DFF * 2;
constexpr size_t WS_WUKV = WS_WUQ + 2ull * 768 * 256 * 2;
constexpr size_t WS_XG = 58 * MiB;
constexpr size_t WS_XR = WS_XG + (size_t)M * D * 2;
constexpr size_t WS_PROJ = WS_XR + (size_t)M * D * 4;
constexpr size_t WS_Q = WS_PROJ + (size_t)M * NINP * 2;
constexpr size_t WS_ACT = WS_PROJ;
constexpr size_t WS_KC = WS_Q + (size_t)M * 768 * 2;
constexpr size_t WS_VTC = WS_KC + 16ull * 256 * 768 * 2;
constexpr size_t WS_KL = WS_VTC + 16ull * 8 * 64 * 256 * 2;
constexpr size_t WS_VTL = WS_KL + 2ull * 4 * 1280 * 768 * 2;
constexpr size_t WS_YMIX = WS_VTL + 2ull * 4 * 8 * 64 * 1280 * 2;
constexpr size_t WS_END = WS_YMIX + (size_t)M * D * 2;
static_assert(WS_MOD + 2 * 5 * 6144 * 4 <= CTL_ZERO_BYTES && CTL_SSQHY + 2 * M * 4 <= WS_MOD && WS_BGU + 2 * 5 * 5632 * 4 <= WS_SSQ1P && WS_ROPE + 1024 * 32 * 4 <= WS_FILT && WS_FILT + 2ull * FILT_LAYER * 2 <= WS_WIN && WS_WUKV + 2ull * 1024 * 128 * 2 <= WS_XG, "ws map");
static_assert((size_t)M * DFF * 2 == (size_t)M * NINP * 2 + (size_t)M * 768 * 2, "ACT overlays PROJ|Q exactly");
static_assert(WS_END <= 256 * MiB, "ws fits 256 MiB");
constexpr int CW_BAR = 4096;

constexpr int RING_BYTES = 131072;
constexpr int MISC_OFF = RING_BYTES;
constexpr int AUX_OFF = RING_BYTES + 1024;
constexpr int LDS_BYTES = 155648;
static_assert(AUX_OFF + 5 * 1024 * 4 <= LDS_BYTES, "LDS map");

#define LDS_WAIT() asm volatile("s_waitcnt lgkmcnt(0)" ::: "memory")
#define VM_WAIT() asm volatile("s_waitcnt vmcnt(0)" ::: "memory")
__device__ __forceinline__ unsigned f2bf(float f) { unsigned u = __builtin_bit_cast(unsigned, f); return (u + 0x7fffu + ((u >> 16) & 1u)) >> 16; }
__device__ __forceinline__ unsigned pk2(float lo, float hi) { return f2bf(lo) | (f2bf(hi) << 16); }
typedef __bf16 bf16x2_t __attribute__((ext_vector_type(2)));
__device__ __forceinline__ unsigned cvtpk(float lo, float hi) { f32x2 v = {lo, hi}; bf16x2_t b = __builtin_convertvector(v, bf16x2_t); return __builtin_bit_cast(unsigned, b); }
__device__ __forceinline__ float bf2f(unsigned short b) { return __builtin_bit_cast(float, (unsigned)b << 16); }
__device__ __forceinline__ float bflo(unsigned w) { return __builtin_bit_cast(float, w << 16); }
__device__ __forceinline__ float bfhi(unsigned w) { return __builtin_bit_cast(float, w & 0xffff0000u); }
__device__ __forceinline__ float shx(float v, int mask, int lane) { return __builtin_bit_cast(float, __builtin_amdgcn_ds_bpermute((lane ^ mask) << 2, __builtin_bit_cast(int, v))); }
__device__ __forceinline__ float rdl(float v, int src) { return __builtin_bit_cast(float, __builtin_amdgcn_readlane(__builtin_bit_cast(int, v), src)); }
__device__ __forceinline__ float wave_sum(float v, int lane) {
#pragma unroll
    for (int o = 1; o < 64; o <<= 1) v += shx(v, o, lane);
    return v;
}
__device__ __forceinline__ int modidx(int row) { return row < MC ? 0 : 1 + ((row - MC) >> 10); }


#define XB_TMO      128
#define XB_XCNT(j)  (256  + 64 * (j))
#define XB_XSUB(j)  (1280 + 64 * (j))
#define XB_XGEN(j)  (2304 + 64 * (j))
#define XB_TOP      3328
#define XB_TOPGEN   3392
#define XCD_BAR_WORDS 3456
#define XB_SPIN_CAP (1u << 18)
__device__ __forceinline__ unsigned xb_ld(unsigned* p)              { return __hip_atomic_load(p, __ATOMIC_RELAXED, __HIP_MEMORY_SCOPE_AGENT); }
__device__ __forceinline__ unsigned xb_add(unsigned* p, unsigned v) { return __hip_atomic_fetch_add(p, v, __ATOMIC_RELAXED, __HIP_MEMORY_SCOPE_AGENT); }
__device__ __forceinline__ unsigned xb_xcc_id() { return (unsigned)__builtin_amdgcn_s_getreg((3 << 11) | 20) & 0xFu; }
#define XB_SPIN(cond, bar) do { unsigned _sp = 0; while (cond) { __builtin_amdgcn_s_sleep(1); \
    if ((++_sp & 255u) == 0u) { if (xb_ld(&(bar)[XB_TMO])) break; if (_sp > XB_SPIN_CAP) { atomicAdd(&(bar)[XB_TMO], 1u); break; } } } } while (0)
__device__ __forceinline__ void xcd_barrier_complete(unsigned* bar, unsigned x, unsigned& nloc, unsigned& nx) {
    const unsigned G = gridDim.x * gridDim.y * gridDim.z;
    unsigned sum, cnt, mine, sp = 0u;
    for (;;) {
        sum = 0u; cnt = 0u; mine = 0u;
#pragma unroll
        for (unsigned j = 0; j < 16; ++j) { const unsigned c = xb_ld(&bar[XB_XCNT(j)]); sum += c; cnt += (c > 0u) ? 1u : 0u; mine = (j == x) ? c : mine; }
        if (sum == G) break;
        __builtin_amdgcn_s_sleep(1);
        if ((++sp & 255u) == 0u) { if (xb_ld(&bar[XB_TMO])) break; if (sp > XB_SPIN_CAP) { atomicAdd(&bar[XB_TMO], 1u); break; } }
    }
    nloc = mine > 0u ? mine : 1u; nx = cnt > 0u ? cnt : 1u;
}
__device__ __forceinline__ void xcd_barrier(unsigned* bar, unsigned x, volatile LAS unsigned* st, bool leader) {
    asm volatile("s_waitcnt vmcnt(0)" ::: "memory");
    __syncthreads();
    if (leader) {
        __builtin_amdgcn_s_waitcnt(0);
        unsigned nloc = st[0], nx = st[1];
        if (nloc == 0u) { xcd_barrier_complete(bar, x, nloc, nx); st[0] = nloc; st[1] = nx; }
        const unsigned old = xb_add(&bar[XB_XSUB(x)], 1u);
        const unsigned gen = old / nloc;
        if (old + 1u == (gen + 1u) * nloc) {
            __builtin_amdgcn_fence(__ATOMIC_RELEASE, "agent");
            asm volatile("s_waitcnt vmcnt(0)" ::: "memory");
            const unsigned og = xb_add(&bar[XB_TOP], 1u);
            const unsigned tg = og / nx;
            if (og + 1u == (tg + 1u) * nx) xb_add(&bar[XB_TOPGEN], 1u);
            else XB_SPIN(xb_ld(&bar[XB_TOPGEN]) == tg, bar);
            __builtin_amdgcn_fence(__ATOMIC_ACQUIRE, "agent");
            xb_add(&bar[XB_XGEN(x)], 1u);
            asm volatile("s_waitcnt vmcnt(0)" ::: "memory");
        } else {
            XB_SPIN(xb_ld(&bar[XB_XGEN(x)]) == gen, bar);
            __builtin_amdgcn_fence(__ATOMIC_ACQUIRE, "agent");
            asm volatile("s_waitcnt vmcnt(0)" ::: "memory");
        }
    }
    __syncthreads();
}

struct Args { const float* in[31]; float* out; unsigned char* ws; int ph_lo, ph_hi, use_bar, li, no_ssq, pad; };
enum { I_XP = 0, I_XS, I_CCKV, I_CKPE, I_C, I_CCTX, I_WMOD, I_BMOD, I_GN1, I_WIN, I_HYCONV, I_HYW1, I_HYB1, I_HYFREQ, I_HYW2, I_HYB2, I_HYW3, I_HYBIAS, I_SCCONV,
       I_GQ, I_WUQ, I_GKV, I_WUKV, I_GQH, I_GKH, I_GGRP, I_WOUT, I_GN2, I_WG, I_WU, I_WD };

typedef const __attribute__((address_space(4))) Args* KArgs;
struct Frame {
    LAS unsigned char* lds;
    int tid, lane, wave, G, bid;
    KArgs a;
    unsigned char* ws;
};
#define WSP(T, off) ((T*)(F.ws + (off)))

__device__ __forceinline__ void tr_item(const float* W, int N, int k0, int n0, bf16* WT, int ldk, int dst_row0, const float* kscale, LAS float* scr, int lane) {
#pragma unroll
    for (int i = 0; i < 32; ++i) { const int kk = 2 * i + (lane >> 5); float v = W[(size_t)(k0 + kk) * N + n0 + (lane & 31)]; if (kscale) v *= kscale[k0 + kk]; scr[kk * 33 + (lane & 31)] = v; }
    LDS_WAIT(); asm volatile("" ::: "memory");
    const int c = lane & 7;
#pragma unroll
    for (int j = 0; j < 4; ++j) { const int n = (lane >> 3) + 8 * j; const LAS float* s = scr + (8 * c) * 33 + n;
        v4u o; o.x = pk2(s[0 * 33], s[1 * 33]); o.y = pk2(s[2 * 33], s[3 * 33]); o.z = pk2(s[4 * 33], s[5 * 33]); o.w = pk2(s[6 * 33], s[7 * 33]);
        *(v4u*)(WT + (size_t)(dst_row0 + n) * ldk + k0 + 8 * c) = o; }
    LDS_WAIT(); asm volatile("" ::: "memory");
}
constexpr int T_IN = 16 * 61, T_OUT = 16 * 32, T_G = 16 * 88, T_D = 44 * 32, T_UQ = 4 * 24, T_UKV = 2 * 32;
constexpr int T_LAYER = T_IN + T_OUT + 2 * T_G + T_D + T_UQ + T_UKV;
constexpr int IT_MOD = 192 * 8, IT_FILT = 2 * 1280, IT_ROPE = 256;
constexpr int P0_ITEMS = IT_MOD + IT_FILT + IT_ROPE + 2 * T_LAYER;

__device__ __forceinline__ void p0_mod_item(Frame& F, int it, const LAS float* sv) {
    const int kc = it & 7, nbl = it >> 3, l = nbl / 96, n0 = (nbl % 96) * 64 + F.lane, k0 = kc * 128;
    const float* W = F.a->in[I_WMOD] + (size_t)l * D * 6144 + n0;
    float acc[5] = {0.f, 0.f, 0.f, 0.f, 0.f};
    for (int k = k0; k < k0 + 128; k += 16) {
        float w[16];
#pragma unroll
        for (int u = 0; u < 16; ++u) w[u] = W[(size_t)(k + u) * 6144];
#pragma unroll
        for (int u = 0; u < 16; ++u)
#pragma unroll
            for (int j = 0; j < 5; ++j) acc[j] += sv[j * 1024 + k + u] * w[u];
    }
    const float b = kc == 0 ? F.a->in[I_BMOD][l * 6144 + n0] : 0.f;
    float* mod = WSP(float, WS_MOD) + (size_t)l * 5 * 6144 + n0;
#pragma unroll
    for (int j = 0; j < 5; ++j) if (F.a->no_ssq == 0) atomicAdd(mod + j * 6144, acc[j] + b);
}
__device__ __forceinline__ void p0_filt_item(Frame& F, int it) {
    const int l = it / 1280, r = it % 1280, sel = r >= 256, m = sel ? r - 256 : r, L = sel ? 1024 : 256, lane = F.lane;
    const float* w1 = F.a->in[I_HYW1] + l * 33 * 64; const float* w2 = F.a->in[I_HYW2] + l * 64 * 64; const float* w3 = F.a->in[I_HYW3] + l * 64 * 512;
    const float zt = (float)m / (float)(L - 1), wang = 6.283185307179586f * (float)m / (float)L;
    float zv = 0.f;
    if (lane == 0) zv = zt;
    else if (lane <= 16) { const float band = 1e-4f + (float)(lane - 1) * ((15.0f - 1e-4f) / 15.0f); zv = cosf(band * wang); }
    else if (lane <= 32) { const float band = 1e-4f + (float)(lane - 17) * ((15.0f - 1e-4f) / 15.0f); zv = -sinf(band * wang); }
    const float fr = F.a->in[I_HYFREQ][l * 64 + lane];
    float s = F.a->in[I_HYB1][l * 64 + lane];
    for (int i = 0; i < 33; ++i) s += rdl(zv, i) * w1[i * 64 + lane];
    const float h1 = sinf(fr * s);
    s = F.a->in[I_HYB2][l * 64 + lane];
    for (int i = 0; i < 64; ++i) s += rdl(h1, i) * w2[i * 64 + lane];
    const float h2 = sinf(fr * s);
    float h3[8] = {0.f, 0.f, 0.f, 0.f, 0.f, 0.f, 0.f, 0.f};
    for (int i = 0; i < 64; ++i) { const float hv = rdl(h2, i);
#pragma unroll
        for (int q = 0; q < 8; ++q) h3[q] += hv * w3[i * 512 + q * 64 + lane]; }
    const int XL = 2 * L + 32;
    bf16* R = WSP(bf16, WS_FILT) + (size_t)l * FILT_LAYER + (sel ? 256 * XL0 : 0);
    const float da = logf(0.01f) / 0.3f, db = logf(0.01f) / 1.5f;
#pragma unroll
    for (int q = 0; q < 4; ++q) { const int c = q * 64 + lane; const float delta = fabsf(da + (float)c * ((db - da) / 255.0f)); const float win = expf(-zt * delta) + 0.05f;
        R[(size_t)c * XL + (L + 32 - m)] = (bf16)f2bf(h3[q] * win + (m == 0 ? F.a->in[I_HYBIAS][l * 256 + c] : 0.f));
        if (m >= 1) R[(size_t)c * XL + (L + 32 + m)] = (bf16)f2bf(h3[q + 4] * win);
        if (m == 0) for (int i = 0; i <= 32; ++i) R[(size_t)c * XL + i] = 0; }
}
__device__ __forceinline__ void p0_phase(Frame& F) {
    LAS float* sv = (LAS float*)(F.lds + AUX_OFF);
    for (int i = F.tid; i < 5 * 1024; i += NTHR) { const int j = i >> 10, k = i & 1023; const float c = (j == 0) ? F.a->in[I_CCTX][k] : F.a->in[I_C][(j - 1) * 1024 + k]; sv[i] = c / (1.f + expf(-c)); }
    __syncthreads();
    LAS float* scr = (LAS float*)(F.lds + F.wave * 16384);
    const int gw = F.wave * F.G + F.bid, NGW = F.G * NWAVES;
    const int pm = F.a->no_ssq;
    for (int it = gw; it < P0_ITEMS; it += NGW) {
        int r = it;
        if (r < IT_MOD) { if (pm != 2) p0_mod_item(F, r, sv); continue; } r -= IT_MOD;
        if (r < IT_FILT) { if (pm != 3) p0_filt_item(F, r); continue; } r -= IT_FILT;
        if (r < IT_ROPE) { const int t = r * 4 + (F.lane >> 4), e16 = F.lane & 15; const float pos = (float)((e16 < 8) ? (t >> 6) : (t & 63));
            const float x = pos * exp2f(-(float)(e16 & 7) * (13.287712379549449f / 8.0f));
            const float k = rintf(x * 0.15915494309189535f); float rr = fmaf(-k, 6.2831854820251465f, x); rr = fmaf(-k, -1.7484555e-07f, rr);
            float* T = WSP(float, WS_ROPE) + (size_t)t * 32; T[e16] = cosf(rr); T[16 + e16] = sinf(rr); continue; } r -= IT_ROPE;
        if (pm == 4) continue;
        const int l = r / T_LAYER; r -= l * T_LAYER;
        if (r < T_IN) { const int kb = r / 61, nb = r % 61; tr_item(F.a->in[I_WIN] + (size_t)l * D * NIN, NIN, kb * 64, nb * 32, WSP(bf16, WS_WIN) + (size_t)l * NINP * D, D, nb * 32, nullptr, scr, F.lane); continue; } r -= T_IN;
        if (r < T_OUT) { const int kb = r / 32, nb = r % 32; tr_item(F.a->in[I_WOUT] + (size_t)l * D * D, D, kb * 64, nb * 32, WSP(bf16, WS_WOUT) + (size_t)l * D * D, D, nb * 32, F.a->in[I_GGRP] + l * D, scr, F.lane); continue; } r -= T_OUT;
        if (r < 2 * T_G) { const int up = r >= T_G; if (up) r -= T_G; const int kb = r / 88, nb = r % 88, u0 = nb * 32;
            tr_item(F.a->in[up ? I_WU : I_WG] + (size_t)l * D * DFF, DFF, kb * 64, u0, WSP(bf16, WS_WGU) + (size_t)l * NGU * D, D, (u0 >> 7) * 256 + up * 128 + (u0 & 127), nullptr, scr, F.lane); continue; } r -= 2 * T_G;
        if (r < T_D) { const int kb = r / 32, nb = r % 32; tr_item(F.a->in[I_WD] + (size_t)l * DFF * D, D, kb * 64, nb * 32, WSP(bf16, WS_WD) + (size_t)l * D * DFF, DFF, nb * 32, nullptr, scr, F.lane); continue; } r -= T_D;
        if (r < T_UQ) { const int kb = r / 24, nb = r % 24; tr_item(F.a->in[I_WUQ] + (size_t)l * QL * 768, 768, kb * 64, nb * 32, WSP(bf16, WS_WUQ) + (size_t)l * 768 * QL, QL, nb * 32, nullptr, scr, F.lane); continue; } r -= T_UQ;
        { const int kb = r / 32, nb = r % 32; tr_item(F.a->in[I_WUKV] + (size_t)l * KVL * 1024, 1024, kb * 64, nb * 32, WSP(bf16, WS_WUKV) + (size_t)l * 1024 * KVL, KVL, nb * 32, nullptr, scr, F.lane); }
    }
}

constexpr int AQ_LD = 264, AKV_LD = 136;
constexpr int QR = 32;
constexpr int QK_AQ = 0, QK_AKV = QK_AQ + QR * AQ_LD * 2, QK_KPE = QK_AKV + QR * AKV_LD * 2, QK_KSS = QK_KPE + QR * 32 * 4, QK_KRS = QK_KSS + QR * 4, QK_W = QK_KRS + 8 * QR * 4, QK_END = QK_W + 1024 * 64;
static_assert(QK_END <= RING_BYTES, "qkv LDS");

template <bool FROM_CACHE>
__device__ __forceinline__ void qkv_unit(Frame& F, int l, int u) {
    LAS bf16* Aq = (LAS bf16*)(F.lds + QK_AQ); LAS bf16* Akv = (LAS bf16*)(F.lds + QK_AKV);
    LAS float* kpe = (LAS float*)(F.lds + QK_KPE); LAS float* kss = (LAS float*)(F.lds + QK_KSS); LAS float* krs = (LAS float*)(F.lds + QK_KRS);
    const int tid = F.tid, lane = F.lane, h = F.wave, f = lane & 15, g = lane >> 4;
    const int row0 = FROM_CACHE ? 0 : u * QR;
    const bool latent = FROM_CACHE ? false : (row0 >= MC);
    int t0, Lk; bf16* Kseg; bf16* Vtseg;
    if (FROM_CACHE) { const int ridx = (u & 31) * QR, b = ridx >> 8; t0 = 1024 + (ridx & 255); Lk = 1280;
        Kseg = WSP(bf16, WS_KL) + ((size_t)(l * 4 + b) * 1280) * 768; Vtseg = WSP(bf16, WS_VTL) + (size_t)(l * 4 + b) * 8 * 64 * 1280; }
    else if (latent) { const int b = (row0 - MC) >> 10; t0 = (row0 - MC) & 1023; Lk = 1280;
        Kseg = WSP(bf16, WS_KL) + ((size_t)(l * 4 + b) * 1280) * 768; Vtseg = WSP(bf16, WS_VTL) + (size_t)(l * 4 + b) * 8 * 64 * 1280; }
    else { const int b = row0 >> 8; t0 = row0 & 255; Lk = 256; Kseg = WSP(bf16, WS_KC) + ((size_t)b * 256) * 768; Vtseg = WSP(bf16, WS_VTC) + (size_t)b * 8 * 64 * 256; }
    {
        const int r = tid >> 4, s = tid & 15;
        if (!FROM_CACHE) {
            const bf16* prow = WSP(bf16, WS_PROJ) + (size_t)(row0 + r) * NINP;
            float v[16]; float ss = 0.f;
#pragma unroll
            for (int i = 0; i < 2; ++i) { const v4u w = *(const v4u*)(prow + O_CQ + s * 16 + i * 8);
                v[i * 8 + 0] = bflo(w.x); v[i * 8 + 1] = bfhi(w.x); v[i * 8 + 2] = bflo(w.y); v[i * 8 + 3] = bfhi(w.y); v[i * 8 + 4] = bflo(w.z); v[i * 8 + 5] = bfhi(w.z); v[i * 8 + 6] = bflo(w.w); v[i * 8 + 7] = bfhi(w.w); }
#pragma unroll
            for (int i = 0; i < 16; ++i) ss += v[i] * v[i];
            ss += shx(ss, 1, lane); ss += shx(ss, 2, lane); ss += shx(ss, 4, lane); ss += shx(ss, 8, lane);
            const float rstd = rsqrtf(ss * (1.0f / QL) + EPS);
            const float* gq = F.a->in[I_GQ] + l * QL + s * 16;
#pragma unroll
            for (int i = 0; i < 2; ++i) { v4u o; o.x = pk2(v[i * 8 + 0] * rstd * gq[i * 8 + 0], v[i * 8 + 1] * rstd * gq[i * 8 + 1]); o.y = pk2(v[i * 8 + 2] * rstd * gq[i * 8 + 2], v[i * 8 + 3] * rstd * gq[i * 8 + 3]);
                o.z = pk2(v[i * 8 + 4] * rstd * gq[i * 8 + 4], v[i * 8 + 5] * rstd * gq[i * 8 + 5]); o.w = pk2(v[i * 8 + 6] * rstd * gq[i * 8 + 6], v[i * 8 + 7] * rstd * gq[i * 8 + 7]);
                *(LAS v4u*)(Aq + r * AQ_LD + s * 16 + i * 8) = o; }
        }
        float c[8], p[2];
        if (FROM_CACHE) { const int ridx = (u & 31) * QR + r, b = ridx >> 8, t = ridx & 255;
            const float* ck = F.a->in[I_CCKV] + ((size_t)((b * 2 + l) * 256 + t)) * 128 + s * 8; const float* kp = F.a->in[I_CKPE] + ((size_t)((b * 2 + l) * 256 + t)) * 32 + s * 2;
#pragma unroll
            for (int i = 0; i < 2; ++i) { const f32x4 w = *(const f32x4*)(ck + i * 4); c[i * 4] = w.x; c[i * 4 + 1] = w.y; c[i * 4 + 2] = w.z; c[i * 4 + 3] = w.w; }
            const f32x2 w = *(const f32x2*)kp; p[0] = w.x; p[1] = w.y;
        } else { const bf16* prow = WSP(bf16, WS_PROJ) + (size_t)(row0 + r) * NINP;
            const v4u w = *(const v4u*)(prow + O_CKV + s * 8);
            c[0] = bflo(w.x); c[1] = bfhi(w.x); c[2] = bflo(w.y); c[3] = bfhi(w.y); c[4] = bflo(w.z); c[5] = bfhi(w.z); c[6] = bflo(w.w); c[7] = bfhi(w.w);
            const unsigned w2 = *(const unsigned*)(prow + O_KPE + s * 2); p[0] = bflo(w2); p[1] = bfhi(w2);
        }
        float ss = 0.f;
#pragma unroll
        for (int i = 0; i < 8; ++i) ss += c[i] * c[i];
        ss += shx(ss, 1, lane); ss += shx(ss, 2, lane); ss += shx(ss, 4, lane); ss += shx(ss, 8, lane);
        const float rstd = rsqrtf(ss * (1.0f / KVL) + EPS);
        const float* gkv = F.a->in[I_GKV] + l * KVL + s * 8;
        { v4u o; o.x = pk2(c[0] * rstd * gkv[0], c[1] * rstd * gkv[1]); o.y = pk2(c[2] * rstd * gkv[2], c[3] * rstd * gkv[3]);
            o.z = pk2(c[4] * rstd * gkv[4], c[5] * rstd * gkv[5]); o.w = pk2(c[6] * rstd * gkv[6], c[7] * rstd * gkv[7]);
            *(LAS v4u*)(Akv + r * AKV_LD + s * 8) = o; }
        float ps = p[0] * p[0] + p[1] * p[1];
        ps += shx(ps, 1, lane); ps += shx(ps, 2, lane); ps += shx(ps, 4, lane); ps += shx(ps, 8, lane);
        *(LAS f32x2*)(kpe + r * 32 + s * 2) = (f32x2){p[0], p[1]};
        if (s == 0) kss[r] = ps;
    }
    __syncthreads();
    LAS unsigned char* Wl = F.lds + QK_W;
    if (!FROM_CACHE) {
        const bf16* Wg = WSP(bf16, WS_WUQ) + (size_t)l * 768 * QL;
        const bf16* wp = Wg + (size_t)(tid >> 2) * QL + (tid & 3) * 8;
        LAS unsigned char* wl = Wl + (tid >> 2) * 64 + (((tid & 3) ^ ((tid >> 4) & 3)) << 4);
        v4u pre[6];
#pragma unroll
        for (int i = 0; i < 6; ++i) pre[i] = *(const v4u*)(wp + (size_t)i * 128 * QL);
        f32x4 acc[2][6];
#pragma unroll
        for (int rt = 0; rt < 2; ++rt)
#pragma unroll
            for (int ct = 0; ct < 6; ++ct) acc[rt][ct] = (f32x4){0.f, 0.f, 0.f, 0.f};
#pragma unroll 1
        for (int kk = 0; kk < 8; ++kk) {
#pragma unroll
            for (int i = 0; i < 6; ++i) *(LAS v4u*)(wl + i * 128 * 64) = pre[i];
            __syncthreads();
            if (kk + 1 < 8) {
#pragma unroll
                for (int i = 0; i < 6; ++i) pre[i] = *(const v4u*)(wp + (size_t)i * 128 * QL + (kk + 1) * 32); }
            bf16x8 a[2], b[6];
#pragma unroll
            for (int rt = 0; rt < 2; ++rt) a[rt] = *(const LAS bf16x8*)(Aq + (rt * 16 + f) * AQ_LD + kk * 32 + g * 8);
#pragma unroll
            for (int ct = 0; ct < 6; ++ct) { const int n = h * QKD + ct * 16 + f; b[ct] = *(const LAS bf16x8*)(Wl + n * 64 + ((g ^ ((n >> 2) & 3)) << 4)); }
#pragma unroll
            for (int rt = 0; rt < 2; ++rt)
#pragma unroll
                for (int ct = 0; ct < 6; ++ct) acc[rt][ct] = __builtin_amdgcn_mfma_f32_16x16x32_bf16(a[rt], b[ct], acc[rt][ct], 0, 0, 0);
            __syncthreads();
        }
        const float* gqh = F.a->in[I_GQH] + l * QKD;
        float gq[6];
#pragma unroll
        for (int ct = 0; ct < 6; ++ct) gq[ct] = gqh[ct * 16 + f];
        const float* RT = WSP(float, WS_ROPE);
        bf16* Qo = WSP(bf16, WS_Q);
#pragma unroll
        for (int rt = 0; rt < 2; ++rt)
#pragma unroll
            for (int i = 0; i < 4; ++i) {
                float ss = 0.f;
#pragma unroll
                for (int ct = 0; ct < 6; ++ct) ss += acc[rt][ct][i] * acc[rt][ct][i];
                ss += shx(ss, 1, lane); ss += shx(ss, 2, lane); ss += shx(ss, 4, lane); ss += shx(ss, 8, lane);
                const float rstd = rsqrtf(ss * (1.0f / QKD) + EPS);
                const int tok = rt * 16 + 4 * g + i, t = t0 + tok;
                float v[6];
#pragma unroll
                for (int ct = 0; ct < 6; ++ct) v[ct] = acc[rt][ct][i] * rstd * gq[ct];
                if (latent) {
#pragma unroll
                    for (int ct = 4; ct < 6; ++ct) { const float partner = shx(v[ct], 8, lane); const float cs = RT[(size_t)t * 32 + (ct - 4) * 8 + (f & 7)], sn = RT[(size_t)t * 32 + 16 + (ct - 4) * 8 + (f & 7)];
                        v[ct] = v[ct] * cs + (f < 8 ? -partner : partner) * sn; }
                }
                bf16* qrow = Qo + (size_t)(row0 + tok) * 768 + h * QKD + f;
#pragma unroll
                for (int ct = 0; ct < 6; ++ct) qrow[ct * 16] = (bf16)f2bf(v[ct] * QSCALE);
            }
    }
    {
        const bf16* Wg = WSP(bf16, WS_WUKV) + (size_t)l * 1024 * KVL;
        const float* gkh = F.a->in[I_GKH] + l * QKD;
        float gk[4];
#pragma unroll
        for (int ct = 0; ct < 4; ++ct) gk[ct] = gkh[ct * 16 + f];
        const bf16* wp = Wg + (size_t)(tid >> 2) * KVL + (tid & 3) * 8;
        LAS unsigned char* wl = Wl + (tid >> 2) * 64 + (((tid & 3) ^ ((tid >> 4) & 3)) << 4);
        v4u pre[8];
#pragma unroll
        for (int i = 0; i < 8; ++i) pre[i] = *(const v4u*)(wp + (size_t)i * 128 * KVL);
        f32x4 acc[2][8];
#pragma unroll
        for (int rt = 0; rt < 2; ++rt)
#pragma unroll
            for (int ct = 0; ct < 8; ++ct) acc[rt][ct] = (f32x4){0.f, 0.f, 0.f, 0.f};
#pragma unroll 1
        for (int kk = 0; kk < 4; ++kk) {
#pragma unroll
            for (int i = 0; i < 8; ++i) *(LAS v4u*)(wl + i * 128 * 64) = pre[i];
            __syncthreads();
            if (kk + 1 < 4) {
#pragma unroll
                for (int i = 0; i < 8; ++i) pre[i] = *(const v4u*)(wp + (size_t)i * 128 * KVL + (kk + 1) * 32); }
            bf16x8 a[2], b[8];
#pragma unroll
            for (int rt = 0; rt < 2; ++rt) a[rt] = *(const LAS bf16x8*)(Akv + (rt * 16 + f) * AKV_LD + kk * 32 + g * 8);
#pragma unroll
            for (int ct = 0; ct < 8; ++ct) { const int n = h * 128 + ct * 16 + f; b[ct] = *(const LAS bf16x8*)(Wl + n * 64 + ((g ^ ((n >> 2) & 3)) << 4)); }
#pragma unroll
            for (int rt = 0; rt < 2; ++rt)
#pragma unroll
                for (int ct = 0; ct < 8; ++ct) acc[rt][ct] = __builtin_amdgcn_mfma_f32_16x16x32_bf16(a[rt], b[ct], acc[rt][ct], 0, 0, 0);
            __syncthreads();
        }
        {
        constexpr int rh = 0;
#pragma unroll
        for (int rt = 0; rt < 2; ++rt) {
#pragma unroll
            for (int i = 0; i < 4; ++i) {
                float ss = 0.f;
#pragma unroll
                for (int ct = 0; ct < 4; ++ct) ss += acc[rt][ct][i] * acc[rt][ct][i];
                ss += shx(ss, 1, lane); ss += shx(ss, 2, lane); ss += shx(ss, 4, lane); ss += shx(ss, 8, lane);
                const int tok = (rh * 2 + rt) * 16 + 4 * g + i;
                const float rstd = rsqrtf((ss + kss[tok]) * (1.0f / QKD) + EPS);
                if (f == 0) krs[h * QR + tok] = rstd;
                bf16* krow = Kseg + (size_t)(t0 + tok) * 768 + h * QKD + f;
#pragma unroll
                for (int ct = 0; ct < 4; ++ct) krow[ct * 16] = (bf16)f2bf(acc[rt][ct][i] * rstd * gk[ct]);
            }
#pragma unroll
            for (int ct = 4; ct < 8; ++ct) { const int d = (ct - 4) * 16 + f;
                v2u o; o.x = pk2(acc[rt][ct][0], acc[rt][ct][1]); o.y = pk2(acc[rt][ct][2], acc[rt][ct][3]);
                *(v2u*)(Vtseg + ((size_t)h * 64 + d) * Lk + t0 + (rh * 2 + rt) * 16 + 4 * g) = o; }
        }
        }
        LDS_WAIT(); asm volatile("" ::: "memory");
        {
            const int tok = lane & 31, ax = lane >> 5, t = t0 + tok; const float rs = krs[h * QR + tok];
            float v[16];
#pragma unroll
            for (int i = 0; i < 4; ++i) { const f32x4 w = *(const LAS f32x4*)(kpe + tok * 32 + ax * 16 + i * 4); v[i * 4] = w.x; v[i * 4 + 1] = w.y; v[i * 4 + 2] = w.z; v[i * 4 + 3] = w.w; }
#pragma unroll
            for (int i = 0; i < 16; ++i) v[i] *= rs * gkh[64 + ax * 16 + i];
            if (latent) { const float* RT = WSP(float, WS_ROPE) + (size_t)t * 32 + ax * 8;
#pragma unroll
                for (int e = 0; e < 8; ++e) { const float cs = RT[e], sn = RT[16 + e]; const float A = v[e], B = v[8 + e]; v[e] = A * cs - B * sn; v[8 + e] = B * cs + A * sn; } }
            bf16* krow = Kseg + (size_t)t * 768 + h * QKD + 64 + ax * 16;
#pragma unroll
            for (int i = 0; i < 2; ++i) { v4u o; o.x = pk2(v[i * 8], v[i * 8 + 1]); o.y = pk2(v[i * 8 + 2], v[i * 8 + 3]); o.z = pk2(v[i * 8 + 4], v[i * 8 + 5]); o.w = pk2(v[i * 8 + 6], v[i * 8 + 7]); *(v4u*)(krow + i * 8) = o; }
        }
    }
    __syncthreads();
}

constexpr int P1_XROWS = M, P1_GG = 20, P1_BIAS = 2 * (NIN / 8 + NGU / 8);
constexpr int P1_ITEMS = P1_XROWS + P1_GG + P1_BIAS;
__device__ __forceinline__ void p1_phase(Frame& F) {
    const int gw = F.wave * F.G + F.bid, NGW = F.G * NWAVES, lane = F.lane;
    const float* MOD = WSP(float, WS_MOD);
    for (int it = gw; it < P1_ITEMS; it += NGW) {
        int r = it;
        if (r < P1_XROWS) {
            const float* xr = (r < MC) ? F.a->in[I_XP] + (size_t)r * D : F.a->in[I_XS] + (size_t)(r - MC) * D;
            const int j = modidx(r); const float* sc1 = MOD + (size_t)j * 6144 + 1024; const float* gn = F.a->in[I_GN1];
            f32x4 v[4]; float s = 0.f;
#pragma unroll
            for (int q = 0; q < 4; ++q) { v[q] = *(const f32x4*)(xr + 256 * q + 4 * lane); s += (v[q].x * v[q].x + v[q].y * v[q].y) + (v[q].z * v[q].z + v[q].w * v[q].w); }
            s = wave_sum(s, lane);
            bf16* o = WSP(bf16, WS_XG) + (size_t)r * D;
#pragma unroll
            for (int q = 0; q < 4; ++q) { const int c = 256 * q + 4 * lane; const f32x4 g = *(const f32x4*)(gn + c); const f32x4 sc = *(const f32x4*)(sc1 + c);
                v2u w; w.x = pk2(v[q].x * g.x * (1.f + sc.x), v[q].y * g.y * (1.f + sc.y)); w.y = pk2(v[q].z * g.z * (1.f + sc.z), v[q].w * g.w * (1.f + sc.w)); *(v2u*)(o + c) = w; }
            if (lane == 0) WSP(float, WS_SSQ1P)[r] = s;
            continue;
        }
        r -= P1_XROWS;
        if (r < P1_GG) { const int l = r / 10, kind = (r % 10) / 5, j = r % 5;
            const float* gn = F.a->in[kind ? I_GN2 : I_GN1] + l * D; const float* sc = MOD + ((size_t)l * 5 + j) * 6144 + (kind ? 4096 : 1024);
            float* o = WSP(float, WS_GG) + ((size_t)(l * 2 + kind) * 5 + j) * D;
#pragma unroll
            for (int q = 0; q < 4; ++q) { const int c = 256 * q + 4 * lane; const f32x4 g = *(const f32x4*)(gn + c); const f32x4 s4 = *(const f32x4*)(sc + c); *(f32x4*)(o + c) = (f32x4){g.x * (1.f + s4.x), g.y * (1.f + s4.y), g.z * (1.f + s4.z), g.w * (1.f + s4.w)}; }
            continue;
        }
        r -= P1_GG;
        {
            const int per = NIN / 8 + NGU / 8, l = r / per; int q = r % per; const bool gu = q >= NIN / 8; if (gu) q -= NIN / 8;
            const bf16* Wt = gu ? WSP(bf16, WS_WGU) + (size_t)l * NGU * D : WSP(bf16, WS_WIN) + (size_t)l * NINP * D;
            float* bo = gu ? WSP(float, WS_BGU) + (size_t)l * 5 * NGU : WSP(float, WS_BIN) + (size_t)l * 5 * NINP; const int ldb = gu ? NGU : NINP;
            const float* shb = MOD + (size_t)l * 5 * 6144 + (gu ? 3072 : 0);
            float sh[5][16];
#pragma unroll
            for (int j = 0; j < 5; ++j)
#pragma unroll
                for (int hh = 0; hh < 2; ++hh)
#pragma unroll
                    for (int e = 0; e < 2; ++e) { const f32x4 w = *(const f32x4*)(shb + (size_t)j * 6144 + hh * 512 + lane * 8 + e * 4); sh[j][hh * 8 + e * 4] = w.x; sh[j][hh * 8 + e * 4 + 1] = w.y; sh[j][hh * 8 + e * 4 + 2] = w.z; sh[j][hh * 8 + e * 4 + 3] = w.w; }
            for (int n8 = 0; n8 < 8; ++n8) { const int n = q * 8 + n8; const bf16* wr = Wt + (size_t)n * D;
                float w[16];
#pragma unroll
                for (int hh = 0; hh < 2; ++hh) { const v4u x = *(const v4u*)(wr + hh * 512 + lane * 8); w[hh * 8] = bflo(x.x); w[hh * 8 + 1] = bfhi(x.x); w[hh * 8 + 2] = bflo(x.y); w[hh * 8 + 3] = bfhi(x.y); w[hh * 8 + 4] = bflo(x.z); w[hh * 8 + 5] = bfhi(x.z); w[hh * 8 + 6] = bflo(x.w); w[hh * 8 + 7] = bfhi(x.w); }
#pragma unroll
                for (int j = 0; j < 5; ++j) { float s = 0.f;
#pragma unroll
                    for (int e = 0; e < 16; ++e) s += w[e] * sh[j][e];
                    s = wave_sum(s, lane); if (lane == 0) bo[(size_t)j * ldb + n] = s; }
            }
        }
    }
    for (int u = F.bid; u < 64; u += F.G) qkv_unit<true>(F, u >> 5, u);
}

__device__ __forceinline__ void prep_phase(Frame& F, int l) {
    for (int u = F.bid; u < M / QR; u += F.G) qkv_unit<false>(F, l, u);
}

typedef float f32x16 __attribute__((ext_vector_type(16)));
constexpr int AT_KLD = 208, AT_VLD = 136;
constexpr int AT_KT = 64 * AT_KLD, AT_VT = 64 * AT_VLD, AT_BUF = AT_KT + AT_VT;
static_assert(2 * AT_BUF <= RING_BYTES, "attention LDS");
__device__ __forceinline__ void attn_unit(Frame& F, int l, bool latent, int seg, int h, int qb) {
    int tid_ = F.tid; asm volatile("" : "+v"(tid_));
    const int tid = tid_, lane = tid & 63, r32 = lane & 31, hh = lane >> 5;
    const int Lk = latent ? 1280 : 256, NT = Lk / 64;
    const int qrow0 = (latent ? MC + seg * 1024 : seg * 256) + qb * 256 + F.wave * 32;
    const bf16* Kb = latent ? WSP(bf16, WS_KL) + ((size_t)(l * 4 + seg) * 1280) * 768 + h * QKD : WSP(bf16, WS_KC) + ((size_t)seg * 256) * 768 + h * QKD;
    const bf16* Vt = latent ? WSP(bf16, WS_VTL) + ((size_t)(l * 4 + seg) * 8 + h) * 64 * 1280 : WSP(bf16, WS_VTC) + ((size_t)seg * 8 + h) * 64 * 256;
    bf16x8 qf[6];
    { const bf16* Qp = WSP(bf16, WS_Q) + (size_t)(qrow0 + r32) * 768 + h * QKD + hh * 8;
#pragma unroll
      for (int kk = 0; kk < 6; ++kk) qf[kk] = *(const bf16x8*)(Qp + kk * 16); }
    const int kr0 = tid / 12, kc0 = tid % 12, kr1 = (tid + 512) / 12, kc1 = (tid + 512) % 12, vr = tid >> 3, vc = tid & 7;
    const bf16* ksrc0 = Kb + (size_t)kr0 * 768 + kc0 * 8; const bf16* ksrc1 = Kb + (size_t)kr1 * 768 + kc1 * 8; const bf16* vsrc = Vt + (size_t)vr * Lk + vc * 8;
    const int kdst0 = kr0 * AT_KLD + kc0 * 16, kdst1 = kr1 * AT_KLD + kc1 * 16, vdst = AT_KT + vr * AT_VLD + vc * 16;
    const bool k2 = tid < 256;
    v4u sk0, sk1 = (v4u){0u, 0u, 0u, 0u}, sv;
#define AT_LOAD(t) do { sk0 = *(const v4u*)(ksrc0 + (size_t)(t) * 64 * 768); if (k2) sk1 = *(const v4u*)(ksrc1 + (size_t)(t) * 64 * 768); sv = *(const v4u*)(vsrc + (t) * 64); } while (0)
#define AT_WRITE(buf) do { LAS unsigned char* b_ = F.lds + (buf) * AT_BUF; *(LAS v4u*)(b_ + kdst0) = sk0; if (k2) *(LAS v4u*)(b_ + kdst1) = sk1; \
        *(LAS v2u*)(b_ + vdst) = (v2u){sv.x, sv.y}; *(LAS v2u*)(b_ + vdst + 8) = (v2u){sv.z, sv.w}; } while (0)
    AT_LOAD(0); AT_WRITE(0);
    __syncthreads();
    float mrun = -1e30f, lsum = 0.f;
    f32x16 o0, o1;
#pragma unroll
    for (int r = 0; r < 16; ++r) { o0[r] = 0.f; o1[r] = 0.f; }
    const int koff = r32 * AT_KLD + hh * 16, voff = AT_KT + r32 * AT_VLD + hh * 8;
    for (int t = 0; t < NT; ++t) {
        if (t + 1 < NT) AT_LOAD(t + 1);
        const LAS unsigned char* B = F.lds + (t & 1) * AT_BUF;
        f32x16 s0, s1;
#pragma unroll
        for (int r = 0; r < 16; ++r) { s0[r] = 0.f; s1[r] = 0.f; }
#pragma unroll
        for (int kk = 0; kk < 6; ++kk) {
            const bf16x8 a0 = *(const LAS bf16x8*)(B + koff + kk * 32), a1 = *(const LAS bf16x8*)(B + koff + 32 * AT_KLD + kk * 32);
            s0 = __builtin_amdgcn_mfma_f32_32x32x16_bf16(a0, qf[kk], s0, 0, 0, 0); s1 = __builtin_amdgcn_mfma_f32_32x32x16_bf16(a1, qf[kk], s1, 0, 0, 0);
        }
        float mx = fmaxf(s0[0], s1[0]);
#pragma unroll
        for (int r = 1; r < 16; ++r) mx = fmaxf(mx, fmaxf(s0[r], s1[r]));
        mx = fmaxf(mx, shx(mx, 32, lane));
        const float mnew = fmaxf(mrun, mx), alpha = __builtin_amdgcn_exp2f(mrun - mnew); mrun = mnew;
        float ps = 0.f;
#pragma unroll
        for (int r = 0; r < 16; ++r) { s0[r] = __builtin_amdgcn_exp2f(s0[r] - mnew); s1[r] = __builtin_amdgcn_exp2f(s1[r] - mnew); ps += s0[r] + s1[r]; }
        lsum = lsum * alpha + ps;
#pragma unroll
        for (int r = 0; r < 16; ++r) { o0[r] *= alpha; o1[r] *= alpha; }
#pragma unroll
        for (int gs = 0; gs < 4; ++gs) {
            v4u pw;
            if (gs == 0) { pw.x = cvtpk(s0[0], s0[1]); pw.y = cvtpk(s0[2], s0[3]); pw.z = cvtpk(s0[4], s0[5]); pw.w = cvtpk(s0[6], s0[7]); }
            else if (gs == 1) { pw.x = cvtpk(s0[8], s0[9]); pw.y = cvtpk(s0[10], s0[11]); pw.z = cvtpk(s0[12], s0[13]); pw.w = cvtpk(s0[14], s0[15]); }
            else if (gs == 2) { pw.x = cvtpk(s1[0], s1[1]); pw.y = cvtpk(s1[2], s1[3]); pw.z = cvtpk(s1[4], s1[5]); pw.w = cvtpk(s1[6], s1[7]); }
            else { pw.x = cvtpk(s1[8], s1[9]); pw.y = cvtpk(s1[10], s1[11]); pw.z = cvtpk(s1[12], s1[13]); pw.w = cvtpk(s1[14], s1[15]); }
            const bf16x8 pB = __builtin_bit_cast(bf16x8, pw);
            const v2u a0 = *(const LAS v2u*)(B + voff + gs * 32), a1 = *(const LAS v2u*)(B + voff + gs * 32 + 16);
            const v2u b0 = *(const LAS v2u*)(B + voff + 32 * AT_VLD + gs * 32), b1 = *(const LAS v2u*)(B + voff + 32 * AT_VLD + gs * 32 + 16);
            o0 = __builtin_amdgcn_mfma_f32_32x32x16_bf16(__builtin_bit_cast(bf16x8, (v4u){a0.x, a0.y, a1.x, a1.y}), pB, o0, 0, 0, 0);
            o1 = __builtin_amdgcn_mfma_f32_32x32x16_bf16(__builtin_bit_cast(bf16x8, (v4u){b0.x, b0.y, b1.x, b1.y}), pB, o1, 0, 0, 0);
        }
        if (t + 1 < NT) AT_WRITE((t + 1) & 1);
        __syncthreads();
    }
#undef AT_LOAD
#undef AT_WRITE
    lsum += shx(lsum, 32, lane);
    const float inv = 1.0f / lsum; float ss = 0.f;
    bf16* yo = WSP(bf16, WS_YMIX) + (size_t)(qrow0 + r32) * D + 512 + h * 64 + 4 * hh;
#pragma unroll
    for (int rg = 0; rg < 4; ++rg) {
        v2u w0, w1; w0.x = pk2(o0[4 * rg] * inv, o0[4 * rg + 1] * inv); w0.y = pk2(o0[4 * rg + 2] * inv, o0[4 * rg + 3] * inv);
        w1.x = pk2(o1[4 * rg] * inv, o1[4 * rg + 1] * inv); w1.y = pk2(o1[4 * rg + 2] * inv, o1[4 * rg + 3] * inv);
        *(v2u*)(yo + 8 * rg) = w0; *(v2u*)(yo + 32 + 8 * rg) = w1;
        const float a0 = bflo(w0.x), a1 = bfhi(w0.x), a2 = bflo(w0.y), a3 = bfhi(w0.y), b0 = bflo(w1.x), b1 = bfhi(w1.x), b2 = bflo(w1.y), b3 = bfhi(w1.y);
        ss += (a0 * a0 + a1 * a1) + (a2 * a2 + a3 * a3) + (b0 * b0 + b1 * b1) + (b2 * b2 + b3 * b3);
    }
    ss += shx(ss, 32, lane);
    if (hh == 0) WSP(float, WS_SSQAT)[(size_t)h * M + qrow0 + r32] = ss;
}
constexpr int HY_ZC_L = 1024 + 72, HY_ZC_C = 256 + 72;
constexpr int HY_ZC = 0;
constexpr int HY_RSTRIDE_L = 4160, HY_RSTRIDE_C = 1088;
static_assert(8 * 4 * HY_ZC_L * 2 + 8 * HY_RSTRIDE_L + 8 * 1024 * 2 <= RING_BYTES && 8 * 16 * HY_ZC_C * 2 + 8 * HY_RSTRIDE_C + 8 * 1024 * 2 <= RING_BYTES, "hyena LDS");
typedef short v4i16_t __attribute__((ext_vector_type(4)));
__device__ __forceinline__ bf16x4 ds_tr16(const LAS unsigned char* p) { return __builtin_bit_cast(bf16x4, __builtin_amdgcn_ds_read_tr16_b64_v4i16((LAS v4i16_t*)p)); }
__device__ __forceinline__ bf16x8 cat8(bf16x4 lo, bf16x4 hi) { return (bf16x8){lo[0], lo[1], lo[2], lo[3], hi[0], hi[1], hi[2], hi[3]}; }
template <bool LATENT>
__device__ __forceinline__ void hyena_unit(Frame& F, int l, int sq, int cgp, bool do_ssq) {
    int tid_ = F.tid; asm volatile("" : "+v"(tid_));
    const int tid = tid_, lane = tid & 63, w = F.wave, c0 = cgp * 8;
    constexpr int L = LATENT ? 1024 : 256, XL = 2 * L + 32, ZCE = LATENT ? HY_ZC_L : HY_ZC_C, NB = L / 32 + 1;
    constexpr int CH_STRIDE = (LATENT ? 4 : 16) * ZCE;
    constexpr int RST = LATENT ? HY_RSTRIDE_L : HY_RSTRIDE_C, HY_R = HY_ZC + 8 * CH_STRIDE * 2, HY_Y = HY_R + 8 * RST;
    const int base_row = LATENT ? MC + sq * 1024 : sq * 1024;
    LAS unsigned short* Zc = (LAS unsigned short*)(F.lds + HY_ZC); LAS unsigned char* Rl = F.lds + HY_R; LAS unsigned short* Y8 = (LAS unsigned short*)(F.lds + HY_Y);
    const bf16* P = WSP(bf16, WS_PROJ); const float* cw = F.a->in[I_HYCONV] + l * 3 * 768;
    for (int i = tid; i < (8 * CH_STRIDE * 2) / 16; i += NTHR) *(LAS v4u*)(F.lds + HY_ZC + i * 16) = (v4u){0u, 0u, 0u, 0u};
    { const bf16* Rg = WSP(bf16, WS_FILT) + (size_t)l * FILT_LAYER + (LATENT ? 256 * XL0 : 0) + (size_t)c0 * XL;
      for (int i = tid; i < 8 * (XL / 8); i += NTHR) { const int ch = i / (XL / 8), j = i % (XL / 8); *(LAS v4u*)(Rl + ch * RST + j * 16) = *(const v4u*)(Rg + (size_t)ch * XL + j * 8); } }
    __syncthreads();
    {
#pragma unroll 1
        for (int it = 0; it < 2; ++it) { const int p = tid + 512 * it, t = p & (L - 1), sg = LATENT ? 0 : (p >> 8); const bf16* pr = P + (size_t)(base_row + p) * NINP + c0;
            float x1[8], vv[8];
#pragma unroll
            for (int e = 0; e < 8; ++e) { x1[e] = 0.f; vv[e] = 0.f; }
#pragma unroll
            for (int dr = -1; dr <= 1; ++dr) { if (t + dr < 0 || t + dr >= L) continue;
                const v4u xa = *(const v4u*)(pr + dr * NINP + 256), xb = *(const v4u*)(pr + dr * NINP + 512);
                const f32x4 a0 = *(const f32x4*)(cw + (dr + 1) * 768 + 256 + c0), a1 = *(const f32x4*)(cw + (dr + 1) * 768 + 256 + c0 + 4), b0 = *(const f32x4*)(cw + (dr + 1) * 768 + 512 + c0), b1 = *(const f32x4*)(cw + (dr + 1) * 768 + 512 + c0 + 4);
                x1[0] += a0.x * bflo(xa.x); x1[1] += a0.y * bfhi(xa.x); x1[2] += a0.z * bflo(xa.y); x1[3] += a0.w * bfhi(xa.y);
                x1[4] += a1.x * bflo(xa.z); x1[5] += a1.y * bfhi(xa.z); x1[6] += a1.z * bflo(xa.w); x1[7] += a1.w * bfhi(xa.w);
                vv[0] += b0.x * bflo(xb.x); vv[1] += b0.y * bfhi(xb.x); vv[2] += b0.z * bflo(xb.y); vv[3] += b0.w * bfhi(xb.y);
                vv[4] += b1.x * bflo(xb.z); vv[5] += b1.y * bfhi(xb.z); vv[6] += b1.z * bflo(xb.w); vv[7] += b1.w * bfhi(xb.w); }
#pragma unroll
            for (int e = 0; e < 8; ++e) { const unsigned short zb = (unsigned short)f2bf(x1[e] * vv[e]); LAS unsigned short* zc = Zc + e * CH_STRIDE + sg * 4 * ZCE + t + 32;
#pragma unroll
                for (int q = 0; q < 4; ++q) zc[q * ZCE - q] = zb; }
        }
    }
    __syncthreads();
    {
        const int r = lane & 15, g = lane >> 4, q = (lane & 15) >> 2, pp = lane & 3;
        const LAS unsigned char* Rw = Rl + w * RST; LAS unsigned short* Yw = Y8 + w * 1024;
        if (LATENT) {
            const LAS unsigned char* zb = (const LAS unsigned char*)(Zc + w * CH_STRIDE + q * ZCE + 8 * g + 4 * pp + 32);
            const int aoff = 2 * (L + 32 - 16 * r + 8 * g);
            f32x4 acc[4];
#pragma unroll
            for (int i = 0; i < 4; ++i) acc[i] = (f32x4){0.f, 0.f, 0.f, 0.f};
#pragma unroll 3
            for (int kb = 0; kb < NB; ++kb) { const int s0p = 32 * kb - 32;
                const bf16x8 B = cat8(ds_tr16(zb + 2 * s0p), ds_tr16(zb + 2 * s0p + 8));
#pragma unroll
                for (int ti = 0; ti < 4; ++ti) { const bf16x8 A = *(const LAS bf16x8*)(Rw + aoff + 2 * (s0p - 256 * ti)); acc[ti] = __builtin_amdgcn_mfma_f32_16x16x32_bf16(A, B, acc[ti], 0, 0, 0); } }
            const int n = lane & 15;
#pragma unroll
            for (int ti = 0; ti < 4; ++ti)
#pragma unroll
                for (int i = 0; i < 4; ++i) Yw[256 * ti + 16 * (4 * g + i) + n] = (unsigned short)f2bf(acc[ti][i]);
        } else {
            const LAS unsigned char* zb = (const LAS unsigned char*)(Zc + w * CH_STRIDE + (pp * 4 + q) * ZCE + 8 * g + 32);
            const int aoff = 2 * (L + 32 - 8 * r + 8 * g);
            f32x4 acc[2][2];
#pragma unroll
            for (int i = 0; i < 2; ++i) { acc[i][0] = (f32x4){0.f, 0.f, 0.f, 0.f}; acc[i][1] = acc[i][0]; }
#pragma unroll 3
            for (int kb = 0; kb < NB; ++kb) { const int s0p = 32 * kb - 32;
                const bf16x8 B0 = cat8(ds_tr16(zb + 2 * s0p), ds_tr16(zb + 2 * s0p + 8)), B1 = cat8(ds_tr16(zb + 2 * s0p + 8), ds_tr16(zb + 2 * s0p + 16));
#pragma unroll
                for (int ti = 0; ti < 2; ++ti) { const bf16x8 A = *(const LAS bf16x8*)(Rw + aoff + 2 * (s0p - 128 * ti));
                    acc[ti][0] = __builtin_amdgcn_mfma_f32_16x16x32_bf16(A, B0, acc[ti][0], 0, 0, 0); acc[ti][1] = __builtin_amdgcn_mfma_f32_16x16x32_bf16(A, B1, acc[ti][1], 0, 0, 0); } }
            const int n = lane & 15, b = n >> 2, op = n & 3;
#pragma unroll
            for (int ti = 0; ti < 2; ++ti)
#pragma unroll
                for (int ob = 0; ob < 2; ++ob)
#pragma unroll
                    for (int i = 0; i < 4; ++i) Yw[b * 256 + 128 * ti + 8 * (4 * g + i) + 4 * ob + op] = (unsigned short)f2bf(acc[ti][ob][i]);
        }
    }
    __syncthreads();
    {
        bf16* Y = WSP(bf16, WS_YMIX); float* ssq = (float*)(F.ws + WS_CTL + CTL_SSQHY) + (size_t)l * M;
#pragma unroll 1
        for (int it = 0; it < 2; ++it) { const int p = tid + 512 * it, t = p & (L - 1), row = base_row + p; const bf16* pr = P + (size_t)row * NINP + c0;
            float x0[8];
#pragma unroll
            for (int e = 0; e < 8; ++e) x0[e] = 0.f;
#pragma unroll
            for (int dr = -1; dr <= 1; ++dr) { if (t + dr < 0 || t + dr >= L) continue;
                const v4u xa = *(const v4u*)(pr + dr * NINP); const f32x4 a0 = *(const f32x4*)(cw + (dr + 1) * 768 + c0), a1 = *(const f32x4*)(cw + (dr + 1) * 768 + c0 + 4);
                x0[0] += a0.x * bflo(xa.x); x0[1] += a0.y * bfhi(xa.x); x0[2] += a0.z * bflo(xa.y); x0[3] += a0.w * bfhi(xa.y);
                x0[4] += a1.x * bflo(xa.z); x0[5] += a1.y * bfhi(xa.z); x0[6] += a1.z * bflo(xa.w); x0[7] += a1.w * bfhi(xa.w); }
            float o[8];
#pragma unroll
            for (int e = 0; e < 8; ++e) o[e] = x0[e] * bf2f(Y8[e * 1024 + p]);
            v4u wv; wv.x = pk2(o[0], o[1]); wv.y = pk2(o[2], o[3]); wv.z = pk2(o[4], o[5]); wv.w = pk2(o[6], o[7]);
            *(v4u*)(Y + (size_t)row * D + c0) = wv;
            const float r0 = bflo(wv.x), r1 = bfhi(wv.x), r2 = bflo(wv.y), r3 = bfhi(wv.y), r4 = bflo(wv.z), r5 = bfhi(wv.z), r6 = bflo(wv.w), r7 = bfhi(wv.w);
            if (do_ssq) atomicAdd(ssq + row, ((r0 * r0 + r1 * r1) + (r2 * r2 + r3 * r3)) + ((r4 * r4 + r5 * r5) + (r6 * r6 + r7 * r7)));
        }
    }
    __syncthreads();
}
__device__ __forceinline__ void sconv_row(Frame& F, int l, int row) {
    const int c4 = F.lane * 4; const bool latent = row >= MC; const int L = latent ? 1024 : 256, t = latent ? ((row - MC) & 1023) : (row & 255);
    const bf16* pr = WSP(bf16, WS_PROJ) + (size_t)row * NINP + O_SC + c4; const float* cw = F.a->in[I_SCCONV] + l * 3 * 256 + c4;
    float conv[4] = {0.f, 0.f, 0.f, 0.f};
#pragma unroll
    for (int dr = -1; dr <= 1; ++dr) { if (t + dr < 0 || t + dr >= L) continue;
        const v2u cg_ = *(const v2u*)(pr + dr * NINP + 256), hx = *(const v2u*)(pr + dr * NINP + 512); const f32x4 w = *(const f32x4*)(cw + (dr + 1) * 256);
        conv[0] += w.x * bflo(cg_.x) * bflo(hx.x); conv[1] += w.y * bfhi(cg_.x) * bfhi(hx.x); conv[2] += w.z * bflo(cg_.y) * bflo(hx.y); conv[3] += w.w * bfhi(cg_.y) * bfhi(hx.y); }
    const v2u bg = *(const v2u*)pr;
    v2u o; o.x = pk2(bflo(bg.x) * conv[0], bfhi(bg.x) * conv[1]); o.y = pk2(bflo(bg.y) * conv[2], bfhi(bg.y) * conv[3]);
    *(v2u*)(WSP(bf16, WS_YMIX) + (size_t)row * D + 256 + c4) = o;
    const float r0 = bflo(o.x), r1 = bfhi(o.x), r2 = bflo(o.y), r3 = bfhi(o.y);
    const float s = wave_sum((r0 * r0 + r1 * r1) + (r2 * r2 + r3 * r3), F.lane); if (F.lane == 0) WSP(float, WS_SSQSC)[row] = s;
}
constexpr int MX_ATL = 128, MX_HYL = 128, MX_ATC = 128, MX_HYC = 128, MX_SC = M / 64, MX_UNITS = MX_ATL + MX_HYL + MX_ATC + MX_HYC + MX_SC;
__device__ __forceinline__ void mix_phase(Frame& F, int l, int mode) {
    const bool do_ssq = mode == 0;
    unsigned* ctr = (unsigned*)(F.ws + WS_CTL + CTL_QCTR) + (l * 4 + F.a->li) * 64;
    volatile LAS unsigned* slot = (volatile LAS unsigned*)(F.lds + MISC_OFF) + 16;
    for (;;) {
        if (F.tid == 0) slot[0] = __hip_atomic_fetch_add(ctr, 1u, __ATOMIC_RELAXED, __HIP_MEMORY_SCOPE_AGENT);
        __syncthreads();
        const int u = (int)slot[0];
        __syncthreads();
        if (u >= MX_UNITS) break;
        int r = u;
        if (r < MX_HYL) { if (mode != 2) hyena_unit<true>(F, l, r >> 5, r & 31, do_ssq); continue; } r -= MX_HYL;
        if (r < MX_HYC) { if (mode != 2) hyena_unit<false>(F, l, r >> 5, r & 31, do_ssq); continue; } r -= MX_HYC;
        if (r < MX_ATL) { if (mode != 3) attn_unit(F, l, true, r >> 5, (r >> 2) & 7, r & 3); continue; } r -= MX_ATL;
        if (r < MX_ATC) { if (mode != 3) attn_unit(F, l, false, r >> 3, r & 7, 0); continue; } r -= MX_ATC;
        if (mode < 2) {
#pragma unroll 1
            for (int i = 0; i < 8; ++i) sconv_row(F, l, r * 64 + i * 8 + F.wave); }
    }
}

#define AUXT(par, k) (aux + ((par) * 3 + (k)) * 256)
struct EpiBase {
    LAS float* aux; int tid;
    __device__ __forceinline__ void rescale(pg8::f32x4 (&acc)[2][2][4][2], int which, int par, int wr, int fr) const {
        const LAS float* T = AUXT(par, 1 + which);
#pragma unroll
        for (int ai = 0; ai < 2; ++ai)
#pragma unroll
            for (int m = 0; m < 4; ++m) { const float s = T[ai * 128 + wr * 64 + m * 16 + fr];
#pragma unroll
                for (int bj = 0; bj < 2; ++bj)
#pragma unroll
                    for (int n = 0; n < 2; ++n) acc[ai][bj][m][n] = acc[ai][bj][m][n] * s; }
    }
};
struct EpiIn : EpiBase {
    static constexpr bool PERM = true, KRESCALE = false;
    const float* ssqp; int np; const float* bias; bf16* proj; float* out; int l;
    __device__ __forceinline__ void prep(const pg8::Unit& u, int par) const {
        if (tid < 256) { const int row = u.pm * 256 + tid; float s = 0.f;
#pragma unroll 1
            for (int p = 0; p < np; ++p) s += ssqp[(size_t)p * M + row]; AUXT(par, 0)[tid] = rsqrtf(s * (1.0f / D) + EPS); }
    }
    __device__ __forceinline__ void operator()(const pg8::f32x4 (&acc)[2][2][4][2], const pg8::Unit& u, int wr, int wc, int fr, int fq, int par) const {
        const int row0 = u.pm * 256 + wr * 64 + fr, j = modidx(u.pm * 256); const LAS float* T = AUXT(par, 0);
        const float* bp = bias + (size_t)j * NINP + u.pn * 256 + wc * 32 + 8 * fq;
        f32x4 bv[2][2];
#pragma unroll
        for (int bj = 0; bj < 2; ++bj)
#pragma unroll
            for (int n = 0; n < 2; ++n) bv[bj][n] = *(const f32x4*)(bp + bj * 128 + 4 * n);
#pragma unroll
        for (int ai = 0; ai < 2; ++ai)
#pragma unroll
            for (int m = 0; m < 4; ++m) { const int row = row0 + ai * 128 + m * 16; const float rs = T[ai * 128 + wr * 64 + m * 16 + fr];
#pragma unroll
                for (int bj = 0; bj < 2; ++bj) { const f32x4 v0 = acc[ai][bj][m][0] * rs + bv[bj][0], v1 = acc[ai][bj][m][1] * rs + bv[bj][1];
                    const int col = u.pn * 256 + bj * 128 + wc * 32 + 8 * fq;
                    v4u w; w.x = pk2(v0[0], v0[1]); w.y = pk2(v0[2], v0[3]); w.z = pk2(v1[0], v1[1]); w.w = pk2(v1[2], v1[3]);
                    *(v4u*)(proj + (size_t)row * NINP + col) = w;
                    if (u.pn == 7 && row < MC && col < NIN) { const int b = row >> 8, t = row & 255;
                        float* o = (col < O_KPE) ? out + OUT_CKV + ((size_t)((b * 2 + l) * 256 + t)) * 128 + (col - O_CKV) : out + OUT_KPE + ((size_t)((b * 2 + l) * 256 + t)) * 32 + (col - O_KPE);
                        *(f32x4*)o = v0; *(f32x4*)(o + 4) = v1; } } }
    }
};
struct EpiOut : EpiBase {
    static constexpr bool PERM = true, KRESCALE = true;
    const float* ssq_hy; const float* ssq_sc; const float* ssq_at; const float* xa; const float* xb; float* xr; bf16* xg; const float* g1; const float* gg2; float* ssqp;
    __device__ __forceinline__ void prep(const pg8::Unit& u, int par) const {
        if (tid < 256) { const int row = u.pm * 256 + tid; float sa = 0.f;
#pragma unroll 1
            for (int h = 0; h < 8; ++h) sa += ssq_at[(size_t)h * M + row];
            const float rh = rsqrtf(ssq_hy[row] * (1.0f / 256) + EPS), rs = rsqrtf(ssq_sc[row] * (1.0f / 256) + EPS), ra = rsqrtf(sa * (1.0f / 512) + EPS);
            AUXT(par, 0)[tid] = ra; AUXT(par, 1)[tid] = rh / rs; AUXT(par, 2)[tid] = rs / ra; }
    }
    __device__ __forceinline__ void operator()(const pg8::f32x4 (&acc)[2][2][4][2], const pg8::Unit& u, int wr, int wc, int fr, int fq, int par) const {
        const int row0 = u.pm * 256 + wr * 64 + fr, j = modidx(u.pm * 256); const LAS float* T = AUXT(par, 0);
        const float* xin = (u.pm * 256 < MC) ? xa : xb;
        const int lane = fq * 16 + fr;
        const int cb = u.pn * 256 + wc * 32 + 8 * fq;
#pragma unroll
        for (int ai = 0; ai < 2; ++ai)
#pragma unroll
            for (int m = 0; m < 4; ++m) { const int row = row0 + ai * 128 + m * 16; const float rs = T[ai * 128 + wr * 64 + m * 16 + fr]; float ss = 0.f;
#pragma unroll
                for (int bj = 0; bj < 2; ++bj) { const int col = cb + bj * 128; v4u w;
#pragma unroll
                    for (int n = 0; n < 2; ++n) { const f32x4 gv = *(const f32x4*)(g1 + (size_t)j * 6144 + col + 4 * n), gg = *(const f32x4*)(gg2 + (size_t)j * D + col + 4 * n);
                        const f32x4 xv = *(const f32x4*)(xin + (size_t)row * D + col + 4 * n); const f32x4 x1 = xv + gv * (acc[ai][bj][m][n] * rs);
                        *(f32x4*)(xr + (size_t)row * D + col + 4 * n) = x1; ss += (x1[0] * x1[0] + x1[1] * x1[1]) + (x1[2] * x1[2] + x1[3] * x1[3]);
                        const f32x4 y = x1 * gg; if (n == 0) { w.x = pk2(y[0], y[1]); w.y = pk2(y[2], y[3]); } else { w.z = pk2(y[0], y[1]); w.w = pk2(y[2], y[3]); } }
                    *(v4u*)(xg + (size_t)row * D + col) = w; }
                ss += shx(ss, 16, lane); ss += shx(ss, 32, lane);
                if (fq == 0) ssqp[(size_t)(u.pn * 4 + wc) * M + row] = ss; }
    }
};
struct EpiUp : EpiBase {
    static constexpr bool PERM = true, KRESCALE = false;
    const float* ssqp; const float* bias; bf16* act;
    __device__ __forceinline__ void prep(const pg8::Unit& u, int par) const {
        if (tid < 256) { const int row = u.pm * 256 + tid; float s = 0.f;
#pragma unroll 1
            for (int p = 0; p < 16; ++p) s += ssqp[(size_t)p * M + row];
            AUXT(par, 0)[tid] = rsqrtf(s * (1.0f / D) + EPS); }
    }
    __device__ __forceinline__ void operator()(const pg8::f32x4 (&acc)[2][2][4][2], const pg8::Unit& u, int wr, int wc, int fr, int fq, int par) const {
        const int row0 = u.pm * 256 + wr * 64 + fr, j = modidx(u.pm * 256); const LAS float* T = AUXT(par, 0);
        const float* bp = bias + (size_t)j * NGU + u.pn * 256 + wc * 32 + 8 * fq;
        f32x4 bv[2][2];
#pragma unroll
        for (int bj = 0; bj < 2; ++bj)
#pragma unroll
            for (int n = 0; n < 2; ++n) bv[bj][n] = *(const f32x4*)(bp + bj * 128 + 4 * n);
#pragma unroll
        for (int ai = 0; ai < 2; ++ai)
#pragma unroll
            for (int m = 0; m < 4; ++m) { const int row = row0 + ai * 128 + m * 16; const float rs = T[ai * 128 + wr * 64 + m * 16 + fr]; float a[8];
#pragma unroll
                for (int n = 0; n < 2; ++n) { const f32x4 gt = acc[ai][0][m][n] * rs + bv[0][n], up = acc[ai][1][m][n] * rs + bv[1][n];
#pragma unroll
                    for (int e = 0; e < 4; ++e) a[n * 4 + e] = gt[e] / (1.0f + __expf(-gt[e])) * up[e]; }
                v4u w; w.x = pk2(a[0], a[1]); w.y = pk2(a[2], a[3]); w.z = pk2(a[4], a[5]); w.w = pk2(a[6], a[7]);
                *(v4u*)(act + (size_t)row * DFF + u.pn * 128 + wc * 32 + 8 * fq) = w; }
    }
};
struct EpiDown : EpiBase {
    static constexpr bool PERM = true, KRESCALE = false;
    const float* xr; float* xo; bf16* xg; const float* g2; const float* gg1n; float* ssqp; int last;
    __device__ __forceinline__ void prep(const pg8::Unit&, int) const {}
    __device__ __forceinline__ void operator()(const pg8::f32x4 (&acc)[2][2][4][2], const pg8::Unit& u, int wr, int wc, int fr, int fq, int) const {
        const int row0 = u.pm * 256 + wr * 64 + fr, j = modidx(u.pm * 256), lane = fq * 16 + fr;
        const int cb = u.pn * 256 + wc * 32 + 8 * fq;
#pragma unroll
        for (int ai = 0; ai < 2; ++ai)
#pragma unroll
            for (int m = 0; m < 4; ++m) { const int row = row0 + ai * 128 + m * 16; float ss = 0.f;
#pragma unroll
                for (int bj = 0; bj < 2; ++bj) { const int col = cb + bj * 128; v4u w;
#pragma unroll
                    for (int n = 0; n < 2; ++n) { const f32x4 gv = *(const f32x4*)(g2 + (size_t)j * 6144 + col + 4 * n);
                        const f32x4 xv = *(const f32x4*)(xr + (size_t)row * D + col + 4 * n); const f32x4 x2 = xv + gv * acc[ai][bj][m][n];
                        *(f32x4*)(xo + (size_t)row * D + col + 4 * n) = x2;
                        if (!last) { const f32x4 gg = *(const f32x4*)(gg1n + (size_t)j * D + col + 4 * n); ss += (x2[0] * x2[0] + x2[1] * x2[1]) + (x2[2] * x2[2] + x2[3] * x2[3]);
                            const f32x4 y = x2 * gg; if (n == 0) { w.x = pk2(y[0], y[1]); w.y = pk2(y[2], y[3]); } else { w.z = pk2(y[0], y[1]); w.w = pk2(y[2], y[3]); } } }
                    if (!last) *(v4u*)(xg + (size_t)row * D + col) = w; }
                if (!last) { ss += shx(ss, 16, lane); ss += shx(ss, 32, lane); if (fq == 0) ssqp[(size_t)(u.pn * 4 + wc) * M + row] = ss; } }
    }
};

#define MK_FRAME() Frame F; { int l_; asm volatile("v_mbcnt_lo_u32_b32 %0, -1, 0\n\tv_mbcnt_hi_u32_b32 %0, -1, %0" : "=v"(l_)); int w_ = wave0; asm volatile("" : "+s"(w_)); F.tid = w_ * 64 + l_; F.lane = l_; F.wave = w_; \
        KArgs k_ = (KArgs)__builtin_amdgcn_kernarg_segment_ptr(); asm volatile("" : "+s"(k_)); F.a = k_; F.ws = k_->ws; int g_ = gridDim.x, b_ = blockIdx.x; asm volatile("" : "+s"(g_), "+s"(b_)); F.G = g_; F.bid = b_; } \
        F.lds = (LAS unsigned char*)lds; LAS float* aux = (LAS float*)(F.lds + AUX_OFF); (void)aux
#define MK_IN(k) (ph_lo <= (k) && (k) < ph_hi)
#define MK_BAR(k) do { if (use_bar && (k) + 1 < ph_hi) { int l_; asm volatile("v_mbcnt_lo_u32_b32 %0, -1, 0\n\tv_mbcnt_hi_u32_b32 %0, -1, %0" : "=v"(l_)); \
        KArgs k_ = (KArgs)__builtin_amdgcn_kernarg_segment_ptr(); asm volatile("" : "+s"(k_)); xcd_barrier((unsigned*)(k_->ws + WS_CTL) + CW_BAR + k_->li * XCD_BAR_WORDS, xcc, (volatile LAS unsigned*)((LAS unsigned char*)lds + MISC_OFF) + 8, wave0 == 0 && l_ == 0); } } while (0)

template <int KM, int L> __device__ __forceinline__ void layer_phases(unsigned char* lds, int wave0, int ph_lo, int ph_hi, int use_bar, unsigned xcc) {
    constexpr int l = L, P = 2 + 6 * L;
    if (MK_IN(P + 0)) { if constexpr (KM & 4) { MK_FRAME();
        pg8::Gemm g{WSP(bf16, WS_XG), WSP(bf16, WS_WIN) + (size_t)l * NINP * D, M, NINP, D}; pg8::StaticOrder S; S.init(M, NINP, F.G, F.bid);
        EpiIn E; E.aux = aux; E.tid = F.tid; E.ssqp = WSP(float, WS_SSQ1P); E.np = l == 0 ? 1 : 16; E.bias = WSP(float, WS_BIN) + (size_t)l * 5 * NINP; E.proj = WSP(bf16, WS_PROJ); E.out = F.a->out; E.l = l;
        pg8::gemm_phase<EpiIn, pg8::StaticOrder, true, true>(F.lds, g, S, E, F.tid); }
        MK_BAR(P + 0); }
    if (MK_IN(P + 1)) { if constexpr (KM & 8) { MK_FRAME(); prep_phase(F, l); } MK_BAR(P + 1); }
    if (MK_IN(P + 2)) { if constexpr (KM & 16) { MK_FRAME(); mix_phase(F, l, F.a->no_ssq); } MK_BAR(P + 2); }
    if (MK_IN(P + 3)) { if constexpr (KM & 32) { MK_FRAME(); float* MOD = WSP(float, WS_MOD); float* GG = WSP(float, WS_GG);
        pg8::Gemm g{WSP(bf16, WS_YMIX), WSP(bf16, WS_WOUT) + (size_t)l * D * D, M, D, D}; pg8::StaticOrder S; S.init(M, D, F.G, F.bid);
        EpiOut E; E.aux = aux; E.tid = F.tid; E.ssq_hy = (const float*)(F.ws + WS_CTL + CTL_SSQHY) + (size_t)l * M; E.ssq_sc = WSP(float, WS_SSQSC); E.ssq_at = WSP(float, WS_SSQAT);
        E.xa = l == 0 ? F.a->in[I_XP] : WSP(float, WS_XR); E.xb = l == 0 ? F.a->in[I_XS] - (size_t)MC * D : WSP(float, WS_XR); E.xr = WSP(float, WS_XR); E.xg = WSP(bf16, WS_XG);
        E.g1 = MOD + (size_t)l * 5 * 6144 + 2048; E.gg2 = GG + (size_t)((l * 2 + 1) * 5) * D; E.ssqp = WSP(float, WS_SSQ2P);
        pg8::gemm_phase<EpiOut, pg8::StaticOrder, true, true>(F.lds, g, S, E, F.tid); }
        MK_BAR(P + 3); }
    if (MK_IN(P + 4)) { if constexpr (KM & 64) { MK_FRAME();
        pg8::Gemm g{WSP(bf16, WS_XG), WSP(bf16, WS_WGU) + (size_t)l * NGU * D, M, NGU, D}; pg8::StaticOrder S; S.init(M, NGU, F.G, F.bid);
        EpiUp E; E.aux = aux; E.tid = F.tid; E.ssqp = WSP(float, WS_SSQ2P); E.bias = WSP(float, WS_BGU) + (size_t)l * 5 * NGU; E.act = WSP(bf16, WS_ACT);
        pg8::gemm_phase<EpiUp, pg8::StaticOrder, true, true>(F.lds, g, S, E, F.tid); }
        MK_BAR(P + 4); }
    if (MK_IN(P + 5)) { if constexpr (KM & 128) { MK_FRAME(); float* MOD = WSP(float, WS_MOD); float* GG = WSP(float, WS_GG);
        pg8::Gemm g{WSP(bf16, WS_ACT), WSP(bf16, WS_WD) + (size_t)l * D * DFF, M, D, DFF}; pg8::StaticOrder S; S.init(M, D, F.G, F.bid);
        EpiDown E; E.aux = aux; E.tid = F.tid; E.xr = WSP(float, WS_XR); E.xo = l == 1 ? F.a->out : WSP(float, WS_XR); E.xg = WSP(bf16, WS_XG);
        E.g2 = MOD + (size_t)l * 5 * 6144 + 5120; E.gg1n = GG + (size_t)((l == 1 ? 0 : (l + 1) * 2) * 5) * D; E.ssqp = WSP(float, WS_SSQ1P); E.last = (l == 1);
        pg8::gemm_phase<EpiDown, pg8::StaticOrder, true, true>(F.lds, g, S, E, F.tid); }
        MK_BAR(P + 5); }
}
template <int KM> __global__ void __launch_bounds__(NTHR, 2) mk_fwd(Args args) {
    extern __shared__ __attribute__((aligned(16))) unsigned char lds[];
    KArgs ka0 = (KArgs)__builtin_amdgcn_kernarg_segment_ptr();
    const int wave0 = __builtin_amdgcn_readfirstlane(threadIdx.x >> 6);
    const int ph_lo = ka0->ph_lo, ph_hi = ka0->ph_hi, use_bar = ka0->use_bar;
    const unsigned xcc = xb_xcc_id();
    {
        LAS unsigned* misc = (LAS unsigned*)((LAS unsigned char*)lds + MISC_OFF);
        for (int u = threadIdx.x; u < 256; u += NTHR) misc[u] = 0u;
        __syncthreads();
        if (use_bar && threadIdx.x == 0) (void)xb_add((unsigned*)(ka0->ws + WS_CTL) + CW_BAR + ka0->li * XCD_BAR_WORDS + XB_XCNT(xcc), 1u);
    }
    if (MK_IN(0)) { if constexpr (KM & 1) { MK_FRAME(); p0_phase(F); } MK_BAR(0); }
    if (MK_IN(1)) { if constexpr (KM & 2) { MK_FRAME(); p1_phase(F); } MK_BAR(1); }
    layer_phases<KM, 0>(lds, wave0, ph_lo, ph_hi, use_bar, xcc);
    layer_phases<KM, 1>(lds, wave0, ph_lo, ph_hi, use_bar, xcc);
}

extern "C" void kernel_launch(void* const* d_in, const int* in_sizes, int n_in, void* d_out, int out_size, void* d_ws, size_t ws_size, hipStream_t stream) {
    static int grid = 0;
    if (grid == 0) {
        if (n_in != 31 || ws_size < WS_END) { fprintf(stderr, "kernel_launch: expected 31 inputs and >= %zu bytes of workspace; got %d, %zu\n", (size_t)WS_END, n_in, ws_size); grid = -1; return; }
        int dev = 0, cus = 0;
        if (hipGetDevice(&dev) != hipSuccess || hipDeviceGetAttribute(&cus, hipDeviceAttributeMultiprocessorCount, dev) != hipSuccess) { grid = -1; return; }
        if (hipFuncSetAttribute((const void*)mk_fwd<255>, hipFuncAttributeMaxDynamicSharedMemorySize, LDS_BYTES) != hipSuccess) { fprintf(stderr, "kernel_launch: hipFuncSetAttribute failed\n"); grid = -1; return; }
        int per_cu = 0;
        if (hipOccupancyMaxActiveBlocksPerMultiprocessor(&per_cu, (const void*)mk_fwd<255>, NTHR, LDS_BYTES) != hipSuccess || per_cu < 1) { fprintf(stderr, "kernel_launch: occupancy query says %d blocks per CU\n", per_cu); (void)hipGetLastError(); }
        grid = cus > 0 ? cus : 256;
    }
    if (grid < 0) return;
    (void)hipMemsetAsync((char*)d_ws + WS_CTL, 0, CTL_ZERO_BYTES, stream);
    Args a{};
    for (int i = 0; i < 31; ++i) a.in[i] = (const float*)d_in[i];
    a.out = (float*)d_out; a.ws = (unsigned char*)d_ws;
#ifndef PROBE_PH
#define PROBE_PH -1
#endif
#ifndef PROBE_MODE
#define PROBE_MODE 1
#endif
    a.use_bar = 1; a.pad = 0;
    void* kargs[] = {&a};
    hipError_t e = hipSuccess;
    if (PROBE_PH < 0) {
        a.ph_lo = 0; a.ph_hi = N_PHASES; a.li = 0; a.no_ssq = 0;
        e = hipLaunchCooperativeKernel((const void*)mk_fwd<255>, dim3(grid), dim3(NTHR), kargs, LDS_BYTES, stream);
    } else {
        a.ph_lo = 0; a.ph_hi = PROBE_PH + 1; a.li = 0; a.no_ssq = 0;
        e = hipLaunchCooperativeKernel((const void*)mk_fwd<255>, dim3(grid), dim3(NTHR), kargs, LDS_BYTES, stream);
        a.ph_lo = PROBE_PH; a.ph_hi = PROBE_PH + 1; a.li = 1; a.no_ssq = PROBE_MODE;
        e = hipLaunchCooperativeKernel((const void*)mk_fwd<255>, dim3(grid), dim3(NTHR), kargs, LDS_BYTES, stream);
        if (PROBE_PH + 1 < N_PHASES) { a.ph_lo = PROBE_PH + 1; a.ph_hi = N_PHASES; a.li = 2; a.no_ssq = 0;
            e = hipLaunchCooperativeKernel((const void*)mk_fwd<255>, dim3(grid), dim3(NTHR), kargs, LDS_BYTES, stream); }
    }
    if (e != hipSuccess) fprintf(stderr, "kernel_launch: cooperative launch failed: %s (grid %d)\n", hipGetErrorString(e), grid);
}
```

```cpp
#include <hip/hip_runtime.h>
#include <cstdio>
#include <cstdint>

namespace pg8 {
#define PG8_LAS __attribute__((address_space(3)))
typedef unsigned short bf16_t;
typedef short bf16x8 __attribute__((ext_vector_type(8)));
typedef float f32x4 __attribute__((ext_vector_type(4)));
typedef unsigned u32x4 __attribute__((ext_vector_type(4)));
constexpr int BM = 256, BK = 64, HALF = 128, HTB = HALF * BK * 2  , STAGE_BYTES = 8 * HTB, NXCD = 8, WGM = 8;

__host__ __device__ __forceinline__ int lds_byte(int r, int c) { const int st = (r >> 4) * 2 + (c >> 5), rr = r & 15, cc = c & 31, ob = rr * 64 + cc * 2; return st * 1024 + (ob ^ (((ob >> 9) & 1) << 5)); }
__host__ __device__ __forceinline__ void stage_rc(int b, int& R, int& C) { const int st = b / 1024, sb = b % 1024, swz = sb ^ (((sb >> 9) & 1) << 5); R = (st >> 1) * 16 + swz / 64; C = (st & 1) * 32 + (swz % 64) / 2; }
__host__ __device__ __forceinline__ int perm32(int rho) { const int n = rho >> 4, i = rho & 15; return 8 * (i >> 2) + 4 * n + (i & 3); }

struct Unit { int pm, pn; };
struct Gemm { const bf16_t* A; const bf16_t* Bt; int M, N, K; };

struct StaticOrder {
    int nM, nN, nwg, G, c;
    __host__ __device__ void init(int M, int N, int G_, int c_) { nM = M / BM; nN = N / BM; nwg = nM * nN; G = G_; c = c_; }
    __host__ __device__ bool next(int i, Unit& u) const {
        const long L = (long)i * G + c; if (L >= nwg) return false;
        int wgid = (int)L; { const int q = nwg / NXCD, r = nwg % NXCD, xcd = wgid % NXCD, off = wgid / NXCD; wgid = (xcd < r ? xcd * (q + 1) : r * (q + 1) + (xcd - r) * q) + off; }
        const int nig = WGM * nN, gid = wgid / nig, fm = gid * WGM, gsz = (nM - fm) < WGM ? (nM - fm) : WGM;
        u.pm = fm + ((wgid % nig) % gsz); u.pn = (wgid % nig) / gsz; return true;
    }
};
__device__ __forceinline__ unsigned cvt_pk_bf16(float lo, float hi) { unsigned r; asm volatile("v_cvt_pk_bf16_f32 %0, %1, %2" : "=v"(r) : "v"(lo), "v"(hi)); return r; }

template <class Epi, class Sched, bool ALIGN_EPI = false, bool SP2 = false>
__device__ __forceinline__ void gemm_phase(PG8_LAS unsigned char* lds, const Gemm g, const Sched& S, const Epi& E, int tid_in) {
    int tid_ = tid_in; asm volatile("" : "+v"(tid_));
    const int tid = tid_, wid = __builtin_amdgcn_readfirstlane(tid >> 6), lane = tid & 63, wr = wid >> 2, wc = wid & 3, fr = lane & 15, fq = lane >> 4;
    const int K = g.K, nt = K / BK;
    unsigned voffA[2], voffB[2];
#pragma unroll
    for (int i = 0; i < 2; ++i) { int R, C; stage_rc(tid * 16 + i * 8192, R, C); const int Rb = Epi::PERM ? ((R & ~31) + perm32(R & 31)) : R;
        voffA[i] = (unsigned)(R * K + C) * 2u; voffB[i] = (unsigned)(Rb * K + C) * 2u; }
    const size_t kstep = (size_t)(BK * 2);
    const size_t hstep = (size_t)HALF * K * 2;
    const size_t tstep = 2 * hstep;
    const unsigned ldsw = (unsigned)wid * 1024u;
    const int aoff = lds_byte(wr * 64 + fr, fq * 8), boff = lds_byte(wc * 32 + fr, fq * 8);
#define PG8_SA(b, h) (((b) * 2 + (h)) * HTB)
#define PG8_SB(b, h) ((4 + (b) * 2 + (h)) * HTB)
#define PG8_STAGE(bufoff, gbase, voff) do { _Pragma("unroll") for (int _i = 0; _i < 2; ++_i) \
        __builtin_amdgcn_global_load_lds((const unsigned*)((const char*)(gbase) + (voff)[_i]), (PG8_LAS unsigned*)(lds + (bufoff) + ldsw + _i * 8192), 16, 0, 0); } while (0)
#define PG8_LDA(dst, b, h) do { _Pragma("unroll") for (int m = 0; m < 4; ++m) _Pragma("unroll") for (int k = 0; k < 2; ++k) dst[m][k] = *(const PG8_LAS bf16x8*)(lds + PG8_SA(b, h) + aoff + m * 2048 + k * 1024); } while (0)
#define PG8_LDB(dst, b, h) do { _Pragma("unroll") for (int n = 0; n < 2; ++n) _Pragma("unroll") for (int k = 0; k < 2; ++k) dst[n][k] = *(const PG8_LAS bf16x8*)(lds + PG8_SB(b, h) + boff + n * 2048 + k * 1024); } while (0)
#define PG8_MMA(ai, bj, At, Bt) do { __builtin_amdgcn_s_setprio(1); _Pragma("unroll") for (int m = 0; m < 4; ++m) _Pragma("unroll") for (int n = 0; n < 2; ++n) _Pragma("unroll") for (int k = 0; k < 2; ++k) \
        acc[ai][bj][m][n] = __builtin_amdgcn_mfma_f32_16x16x32_bf16(Bt[n][k], At[m][k], acc[ai][bj][m][n], 0, 0, 0); __builtin_amdgcn_s_setprio(0); } while (0)
#define PG8_WAIT_V(n) asm volatile("s_waitcnt vmcnt(" #n ")" ::: "memory")
#define PG8_WAIT_L(n) asm volatile("s_waitcnt lgkmcnt(" #n ")" ::: "memory")
#define PG8_BAR __builtin_amdgcn_s_barrier()
#define PG8_SCHED __builtin_amdgcn_sched_barrier(0)
    Unit cur, nxt; int ui = 0;
    if (!S.next(0, cur)) return;
    f32x4 acc[2][2][4][2];
#pragma unroll
    for (int a = 0; a < 2; ++a)
#pragma unroll
        for (int b = 0; b < 2; ++b)
#pragma unroll
            for (int m = 0; m < 4; ++m)
#pragma unroll
                for (int n = 0; n < 2; ++n) acc[a][b][m][n] = (f32x4){0.f, 0.f, 0.f, 0.f};
    bf16x8 At[4][2], B0[2][2], B1[2][2];
    const char* cA = (const char*)g.A + (size_t)cur.pm * tstep; const char* cB = (const char*)g.Bt + (size_t)cur.pn * tstep;
    const typename Epi::Pre pre0 = E.prep_load(cur);
    if constexpr (SP2) {
        PG8_STAGE(PG8_SB(0, 0), cB, voffB); PG8_STAGE(PG8_SB(0, 1), cB + hstep, voffB); PG8_STAGE(PG8_SA(0, 0), cA, voffA); PG8_STAGE(PG8_SA(0, 1), cA + hstep, voffA);
        if (wr == 1) PG8_BAR;
        PG8_WAIT_V(2); PG8_BAR;
        PG8_STAGE(PG8_SB(1, 0), cB + kstep, voffB); PG8_STAGE(PG8_SA(1, 0), cA + kstep, voffA); PG8_STAGE(PG8_SB(1, 1), cB + hstep + kstep, voffB);
        PG8_WAIT_V(6); PG8_BAR;
    } else {
        PG8_STAGE(PG8_SB(0, 0), cB, voffB); PG8_STAGE(PG8_SA(0, 0), cA, voffA); PG8_STAGE(PG8_SB(0, 1), cB + hstep, voffB); PG8_STAGE(PG8_SA(0, 1), cA + hstep, voffA);
        if (wr == 1) PG8_BAR;
        PG8_WAIT_V(4); PG8_BAR;
        PG8_STAGE(PG8_SB(1, 0), cB + kstep, voffB); PG8_STAGE(PG8_SA(1, 0), cA + kstep, voffA); PG8_STAGE(PG8_SB(1, 1), cB + hstep + kstep, voffB);
        PG8_WAIT_V(6); PG8_BAR;
    }
    E.prep_finish(pre0, 0);
    for (;;) {
        const bool has_next = S.next(ui + 1, nxt);
        const char* nA = has_next ? (const char*)g.A + (size_t)nxt.pm * tstep : cA; const char* nB = has_next ? (const char*)g.Bt + (size_t)nxt.pn * tstep : cB;
        for (int t = 0; t < nt; t += 2) {
            const bool last = (t == nt - 2);
            const char* a1 = cA + (size_t)(t + 1) * kstep;
            const char* a2 = last ? nA : cA + (size_t)(t + 2) * kstep; const char* b2 = last ? nB : cB + (size_t)(t + 2) * kstep;
            const char* a3 = a2 + kstep; const char* b3 = b2 + kstep;
            if constexpr (Epi::KRESCALE) { if (t == 4) E.rescale(acc, 0, ui & 1, wr, fr); else if (t == 8) E.rescale(acc, 1, ui & 1, wr, fr); }
            if constexpr (SP2) {
            PG8_LDB(B0, 0, 0); PG8_LDB(B1, 0, 1); PG8_SCHED; PG8_LDA(At, 0, 0); PG8_STAGE(PG8_SA(1, 1), a1 + hstep, voffA);
            PG8_WAIT_V(8); PG8_WAIT_L(0); PG8_BAR; PG8_MMA(0, 0, At, B0); PG8_MMA(0, 1, At, B1); PG8_BAR; PG8_SCHED;
            PG8_LDA(At, 0, 1); PG8_STAGE(PG8_SB(0, 0), b2, voffB); PG8_STAGE(PG8_SB(0, 1), b2 + hstep, voffB); PG8_STAGE(PG8_SA(0, 0), a2, voffA);
            PG8_WAIT_V(8); PG8_WAIT_L(0); PG8_BAR; PG8_MMA(1, 0, At, B0); PG8_MMA(1, 1, At, B1); PG8_BAR; PG8_SCHED;
            PG8_LDB(B0, 1, 0); PG8_LDB(B1, 1, 1); PG8_SCHED; PG8_LDA(At, 1, 0); PG8_STAGE(PG8_SA(0, 1), a2 + hstep, voffA);
            PG8_WAIT_V(8); PG8_WAIT_L(0); PG8_BAR; PG8_MMA(0, 0, At, B0); PG8_MMA(0, 1, At, B1); PG8_BAR; PG8_SCHED;
            PG8_LDA(At, 1, 1); PG8_STAGE(PG8_SB(1, 0), b3, voffB); PG8_STAGE(PG8_SB(1, 1), b3 + hstep, voffB); PG8_STAGE(PG8_SA(1, 0), a3, voffA);
            PG8_WAIT_V(8); PG8_WAIT_L(0); PG8_BAR; PG8_MMA(1, 0, At, B0); PG8_MMA(1, 1, At, B1); PG8_BAR; PG8_SCHED;
            } else {
            PG8_LDB(B0, 0, 0); PG8_SCHED; PG8_LDA(At, 0, 0); PG8_STAGE(PG8_SA(1, 1), a1 + hstep, voffA);
            PG8_WAIT_L(8); PG8_BAR; PG8_WAIT_L(0); PG8_MMA(0, 0, At, B0); PG8_BAR; PG8_SCHED;
            PG8_LDB(B1, 0, 1); PG8_STAGE(PG8_SB(0, 0), b2, voffB);
            PG8_BAR; PG8_WAIT_L(0); PG8_MMA(0, 1, At, B1); PG8_BAR;
            PG8_LDA(At, 0, 1); PG8_STAGE(PG8_SA(0, 0), a2, voffA);
            PG8_BAR; PG8_WAIT_L(0); PG8_MMA(1, 0, At, B0); PG8_BAR; PG8_SCHED;
            PG8_STAGE(PG8_SB(0, 1), b2 + hstep, voffB);
            PG8_WAIT_V(6); PG8_BAR; PG8_MMA(1, 1, At, B1); PG8_BAR;
            PG8_LDB(B0, 1, 0); PG8_SCHED; PG8_LDA(At, 1, 0); PG8_STAGE(PG8_SA(0, 1), a2 + hstep, voffA);
            PG8_WAIT_L(8); PG8_BAR; PG8_WAIT_L(0); PG8_MMA(0, 0, At, B0); PG8_BAR; PG8_SCHED;
            PG8_LDB(B1, 1, 1); PG8_STAGE(PG8_SB(1, 0), b3, voffB);
            PG8_BAR; PG8_WAIT_L(0); PG8_MMA(0, 1, At, B1); PG8_BAR;
            PG8_LDA(At, 1, 1); PG8_STAGE(PG8_SA(1, 0), a3, voffA);
            PG8_BAR; PG8_WAIT_L(0); PG8_MMA(1, 0, At, B0); PG8_BAR; PG8_SCHED;
            PG8_STAGE(PG8_SB(1, 1), b3 + hstep, voffB);
            PG8_WAIT_V(6); PG8_BAR; PG8_MMA(1, 1, At, B1); PG8_BAR;
            }
        }
        if constexpr (ALIGN_EPI) { if (wr == 0) PG8_BAR; }
        if (has_next) { const typename Epi::Pre pren = E.prep_load(nxt); E(acc, cur, wr, wc, fr, fq, ui & 1); E.prep_finish(pren, (ui + 1) & 1); }
        else E(acc, cur, wr, wc, fr, fq, ui & 1);
        if (!has_next) break;
#pragma unroll
        for (int a = 0; a < 2; ++a)
#pragma unroll
            for (int b = 0; b < 2; ++b)
#pragma unroll
                for (int m = 0; m < 4; ++m)
#pragma unroll
                    for (int n = 0; n < 2; ++n) acc[a][b][m][n] = (f32x4){0.f, 0.f, 0.f, 0.f};
        cur = nxt; cA = nA; cB = nB; ++ui;
        if constexpr (ALIGN_EPI) { if (wr == 1) PG8_BAR; }
    }
    PG8_WAIT_V(0);
    if constexpr (!ALIGN_EPI) { if (wr == 0) PG8_BAR; }
    PG8_BAR;
#undef PG8_SA
#undef PG8_SB
#undef PG8_STAGE
#undef PG8_LDA
#undef PG8_LDB
#undef PG8_MMA
#undef PG8_WAIT_V
#undef PG8_WAIT_L
#undef PG8_BAR
#undef PG8_SCHED
}

template <class Epi>
__device__ __forceinline__ void gemm_phase_h(PG8_LAS unsigned char* lds, const Gemm g, int pm, int pn, const Epi& E, int tid_in) {
    int tid_ = tid_in; asm volatile("" : "+v"(tid_));
    const int tid = tid_, wid = __builtin_amdgcn_readfirstlane(tid >> 6), lane = tid & 63, wr = wid >> 2, wc = wid & 3, fr = lane & 15, fq = lane >> 4;
    const int K = g.K, nt = K / BK;
    unsigned voffA[2], voffB[2];
#pragma unroll
    for (int i = 0; i < 2; ++i) { int R, C; stage_rc(tid * 16 + i * 8192, R, C); const int Rb = Epi::PERM ? ((R & ~31) + perm32(R & 31)) : R;
        voffA[i] = (unsigned)(R * K + C) * 2u; voffB[i] = (unsigned)(Rb * K + C) * 2u; }
    const size_t kstep = (size_t)(BK * 2), hstep = (size_t)HALF * K * 2;
    const unsigned ldsw = (unsigned)wid * 1024u;
    const int aoff = lds_byte(wr * 64 + fr, fq * 8), boff = lds_byte(wc * 32 + fr, fq * 8);
#define H_SA(b) ((b) * 49152)
#define H_SB(b, h) ((b) * 49152 + 16384 * (1 + (h)))
#define H_STAGE(bufoff, gbase, voff) do { _Pragma("unroll") for (int _i = 0; _i < 2; ++_i) \
        __builtin_amdgcn_global_load_lds((const unsigned*)((const char*)(gbase) + (voff)[_i]), (PG8_LAS unsigned*)(lds + (bufoff) + ldsw + _i * 8192), 16, 0, 0); } while (0)
#define H_LDA(dst, b) do { _Pragma("unroll") for (int m = 0; m < 4; ++m) _Pragma("unroll") for (int k = 0; k < 2; ++k) dst[m][k] = *(const PG8_LAS bf16x8*)(lds + H_SA(b) + aoff + m * 2048 + k * 1024); } while (0)
#define H_LDB(dst, b, h) do { _Pragma("unroll") for (int n = 0; n < 2; ++n) _Pragma("unroll") for (int k = 0; k < 2; ++k) dst[n][k] = *(const PG8_LAS bf16x8*)(lds + H_SB(b, h) + boff + n * 2048 + k * 1024); } while (0)
#define H_MMA(bj, At, Bt) do { __builtin_amdgcn_s_setprio(1); _Pragma("unroll") for (int m = 0; m < 4; ++m) _Pragma("unroll") for (int n = 0; n < 2; ++n) _Pragma("unroll") for (int k = 0; k < 2; ++k) \
        acc[0][bj][m][n] = __builtin_amdgcn_mfma_f32_16x16x32_bf16(Bt[n][k], At[m][k], acc[0][bj][m][n], 0, 0, 0); __builtin_amdgcn_s_setprio(0); } while (0)
#define H_WAIT_V(n) asm volatile("s_waitcnt vmcnt(" #n ")" ::: "memory")
#define H_WAIT_L(n) asm volatile("s_waitcnt lgkmcnt(" #n ")" ::: "memory")
#define H_BAR __builtin_amdgcn_s_barrier()
#define H_SCHED __builtin_amdgcn_sched_barrier(0)
    Unit cur; cur.pm = pm; cur.pn = pn;
    f32x4 acc[1][2][4][2];
#pragma unroll
    for (int b = 0; b < 2; ++b)
#pragma unroll
        for (int m = 0; m < 4; ++m)
#pragma unroll
            for (int n = 0; n < 2; ++n) acc[0][b][m][n] = (f32x4){0.f, 0.f, 0.f, 0.f};
    bf16x8 At[4][2], B0[2][2], B1[2][2];
    const char* cA = (const char*)g.A + (size_t)pm * hstep; const char* cB = (const char*)g.Bt + (size_t)pn * 2 * hstep;
    const typename Epi::Pre pre0 = E.prep_load(cur);
    H_STAGE(H_SB(0, 0), cB, voffB); H_STAGE(H_SB(0, 1), cB + hstep, voffB); H_STAGE(H_SA(0), cA, voffA);
    if (wr == 1) H_BAR;
    H_WAIT_V(0); H_BAR;
    H_STAGE(H_SB(1, 0), cB + kstep, voffB); H_STAGE(H_SB(1, 1), cB + hstep + kstep, voffB); H_STAGE(H_SA(1), cA + kstep, voffA);
    H_BAR;
    E.prep_finish(pre0, 0);
    int b = 0;
    for (int t = 0; t < nt; ++t) {
        const int t2 = (t + 2 < nt) ? t + 2 : t + 2 - nt;
        const int b2 = (b == 0) ? 2 : b - 1;
        const char* a2 = cA + (size_t)t2 * kstep; const char* bb2 = cB + (size_t)t2 * kstep;
        if constexpr (Epi::KRESCALE) { if (t == 4) E.rescale(acc, 0, 0, wr, fr); else if (t == 8) E.rescale(acc, 1, 0, wr, fr); }
        if (b == 0) { H_LDB(B0, 0, 0); H_LDB(B1, 0, 1); H_SCHED; H_LDA(At, 0); }
        else if (b == 1) { H_LDB(B0, 1, 0); H_LDB(B1, 1, 1); H_SCHED; H_LDA(At, 1); }
        else { H_LDB(B0, 2, 0); H_LDB(B1, 2, 1); H_SCHED; H_LDA(At, 2); }
        if (b2 == 0) { H_STAGE(H_SB(0, 0), bb2, voffB); H_STAGE(H_SB(0, 1), bb2 + hstep, voffB); H_STAGE(H_SA(0), a2, voffA); }
        else if (b2 == 1) { H_STAGE(H_SB(1, 0), bb2, voffB); H_STAGE(H_SB(1, 1), bb2 + hstep, voffB); H_STAGE(H_SA(1), a2, voffA); }
        else { H_STAGE(H_SB(2, 0), bb2, voffB); H_STAGE(H_SB(2, 1), bb2 + hstep, voffB); H_STAGE(H_SA(2), a2, voffA); }
        H_WAIT_V(6); H_WAIT_L(0); H_BAR; H_MMA(0, At, B0); H_MMA(1, At, B1); H_BAR; H_SCHED;
        b = (b == 2) ? 0 : b + 1;
    }
    if (wr == 0) H_BAR;
    E(acc, cur, wr, wc, fr, fq, 0);
    H_WAIT_V(0);
    H_BAR;
#undef H_SA
#undef H_SB
#undef H_STAGE
#undef H_LDA
#undef H_LDB
#undef H_MMA
#undef H_WAIT_V
#undef H_WAIT_L
#undef H_BAR
#undef H_SCHED
}
}

#define GAS __attribute__((address_space(1)))
#define LAS __attribute__((address_space(3)))
typedef unsigned short bf16;
typedef unsigned v4u __attribute__((ext_vector_type(4)));
typedef unsigned v2u __attribute__((ext_vector_type(2)));
typedef float f32x4 __attribute__((ext_vector_type(4)));
typedef float f32x2 __attribute__((ext_vector_type(2)));
typedef short bf16x8 __attribute__((ext_vector_type(8)));
typedef short bf16x4 __attribute__((ext_vector_type(4)));

constexpr int NWAVES = 8, NTHR = 512;
constexpr int M = 8192, MC = 4096, D = 1024, NIN = 1952, NINP = 2048, DFF = 2816, NGU = 5632;
constexpr int O_SC = 768, O_CQ = 1536, O_CKV = 1792, O_KPE = 1920;
constexpr int NH = 8, QKD = 96, VD = 64, QL = 256, KVL = 128, ROPE = 32;
constexpr float EPS = 1e-6f;
constexpr float QSCALE = 0.10206207261596575f * 1.4426950408889634f;
constexpr int XL0 = 2 * 256 + 32, XL1 = 2 * 1024 + 32;
constexpr int FILT_LAYER = 256 * (XL0 + XL1);
constexpr int OUT_CKV = M * D, OUT_KPE = OUT_CKV + 16 * 2 * 256 * 128;
constexpr int N_PHASES = 14;

constexpr size_t MiB = 1u << 20;
constexpr size_t WS_CTL = 0, CTL_ZERO_BYTES = 1 * MiB;
constexpr size_t CTL_QCTR = 128 * 1024;
constexpr size_t CTL_SSQHY = 256 * 1024;
constexpr size_t WS_MOD = 384 * 1024;
constexpr size_t WS_GG = 1 * MiB;
constexpr size_t WS_BIN = WS_GG + 2 * 2 * 5 * 1024 * 4;
constexpr size_t WS_BGU = WS_BIN + 2 * 5 * 2048 * 4;
constexpr size_t WS_SSQ1P = 2 * MiB;
constexpr size_t WS_SSQ2P = WS_SSQ1P + 16 * M * 4;
constexpr size_t WS_SSQSC = WS_SSQ2P + 16 * M * 4;
constexpr size_t WS_SSQAT = WS_SSQSC + M * 4;
constexpr size_t WS_ROPE = WS_SSQAT + 8 * M * 4;
constexpr size_t WS_FILT = 4 * MiB;
constexpr size_t WS_WIN = 8 * MiB;
constexpr size_t WS_WOUT = WS_WIN + 2ull * NINP * D * 2;
constexpr size_t WS_WGU = WS_WOUT + 2ull * D * D * 2;
constexpr size_t WS_WD = WS_WGU + 2ull * NGU * D * 2;
constexpr size_t WS_WUQ = WS_WD + 2ull * D * DFF * 2;
constexpr size_t WS_WUKV = WS_WUQ + 2ull * 768 * 256 * 2;
constexpr size_t WS_XG = 58 * MiB;
constexpr size_t WS_XR = WS_XG + (size_t)M * D * 2;
constexpr size_t WS_PROJ = WS_XR + (size_t)M * D * 4;
constexpr size_t WS_Q = WS_PROJ + (size_t)M * NINP * 2;
constexpr size_t WS_ACT = WS_PROJ;
constexpr size_t WS_KC = WS_Q + (size_t)M * 768 * 2;
constexpr size_t WS_VTC = WS_KC + 16ull * 256 * 768 * 2;
constexpr size_t WS_KL = WS_VTC + 16ull * 8 * 64 * 256 * 2;
constexpr size_t WS_VTL = WS_KL + 2ull * 4 * 1280 * 768 * 2;
constexpr size_t WS_YMIX = WS_VTL + 2ull * 4 * 8 * 64 * 1280 * 2;
constexpr size_t WS_END = WS_YMIX + (size_t)M * D * 2;
static_assert(WS_MOD + 2 * 5 * 6144 * 4 <= CTL_ZERO_BYTES && CTL_SSQHY + 2 * M * 4 <= WS_MOD && WS_BGU + 2 * 5 * 5632 * 4 <= WS_SSQ1P && WS_ROPE + 1024 * 32 * 4 <= WS_FILT && WS_FILT + 2ull * FILT_LAYER * 2 <= WS_WIN && WS_WUKV + 2ull * 1024 * 128 * 2 <= WS_XG, "ws map");
static_assert((size_t)M * DFF * 2 == (size_t)M * NINP * 2 + (size_t)M * 768 * 2, "ACT overlays PROJ|Q exactly");
static_assert(WS_END <= 256 * MiB, "ws fits 256 MiB");
constexpr int CW_BAR = 4096;

constexpr int RING_BYTES = 147456;
constexpr int MISC_OFF = RING_BYTES;
constexpr int AUX_OFF = RING_BYTES + 1024;
constexpr int LDS_BYTES = 155648;
static_assert(AUX_OFF + 2 * 3 * 256 * 4 <= LDS_BYTES, "LDS map");
constexpr int P0_SCR = 8704, P0_SV = 8 * P0_SCR;
static_assert(P0_SV + 5 * 1024 * 4 <= RING_BYTES, "P0 LDS");

#define LDS_WAIT() asm volatile("s_waitcnt lgkmcnt(0)" ::: "memory")
#define VM_WAIT() asm volatile("s_waitcnt vmcnt(0)" ::: "memory")
typedef __bf16 bf16x2_t __attribute__((ext_vector_type(2)));
__device__ __forceinline__ unsigned pk2(float lo, float hi) { f32x2 v = {lo, hi}; bf16x2_t b = __builtin_convertvector(v, bf16x2_t); return __builtin_bit_cast(unsigned, b); }
__device__ __forceinline__ unsigned f2bf(float f) { return pk2(f, 0.f) & 0xffffu; }
__device__ __forceinline__ unsigned cvtpk(float lo, float hi) { return pk2(lo, hi); }
__device__ __forceinline__ float bf2f(unsigned short b) { return __builtin_bit_cast(float, (unsigned)b << 16); }
__device__ __forceinline__ float bflo(unsigned w) { return __builtin_bit_cast(float, w << 16); }
__device__ __forceinline__ float bfhi(unsigned w) { return __builtin_bit_cast(float, w & 0xffff0000u); }
__device__ __forceinline__ float shx(float v, int mask, int lane) { return __builtin_bit_cast(float, __builtin_amdgcn_ds_bpermute((lane ^ mask) << 2, __builtin_bit_cast(int, v))); }
__device__ __forceinline__ float max3f(float a, float b, float c) { float r; asm("v_max3_f32 %0, %1, %2, %3" : "=v"(r) : "v"(a), "v"(b), "v"(c)); return r; }
__device__ __forceinline__ float max32(float v) { auto rr = __builtin_amdgcn_permlane32_swap(__float_as_uint(v), __float_as_uint(v), false, false); return fmaxf(__uint_as_float(rr[0]), __uint_as_float(rr[1])); }
__device__ __forceinline__ float sum32(float v) { auto rr = __builtin_amdgcn_permlane32_swap(__float_as_uint(v), __float_as_uint(v), false, false); return __uint_as_float(rr[0]) + __uint_as_float(rr[1]); }
__device__ __forceinline__ float rdl(float v, int src) { return __builtin_bit_cast(float, __builtin_amdgcn_readlane(__builtin_bit_cast(int, v), src)); }
__device__ __forceinline__ float wave_sum(float v, int lane) {
#pragma unroll
    for (int o = 1; o < 64; o <<= 1) v += shx(v, o, lane);
    return v;
}
__device__ __forceinline__ int modidx(int row) { return row < MC ? 0 : 1 + ((row - MC) >> 10); }


#define XB_TMO      128
#define XB_XCNT(j)  (256  + 64 * (j))
#define XB_XSUB(j)  (1280 + 64 * (j))
#define XB_XGEN(j)  (2304 + 64 * (j))
#define XB_TOP      3328
#define XB_TOPGEN   3392
#define XCD_BAR_WORDS 5504
#define XB_SPIN_CAP (1u << 18)
__device__ __forceinline__ unsigned xb_ld(unsigned* p)              { return __hip_atomic_load(p, __ATOMIC_RELAXED, __HIP_MEMORY_SCOPE_AGENT); }
__device__ __forceinline__ unsigned xb_add(unsigned* p, unsigned v) { return __hip_atomic_fetch_add(p, v, __ATOMIC_RELAXED, __HIP_MEMORY_SCOPE_AGENT); }
__device__ __forceinline__ unsigned xb_xcc_id() { return (unsigned)__builtin_amdgcn_s_getreg((3 << 11) | 20) & 0xFu; }
#define XB_SPIN(cond, bar) do { unsigned _sp = 0; while (cond) { __builtin_amdgcn_s_sleep(1); \
    if ((++_sp & 255u) == 0u) { if (xb_ld(&(bar)[XB_TMO])) break; if (_sp > XB_SPIN_CAP) { atomicAdd(&(bar)[XB_TMO], 1u); break; } } } } while (0)
__device__ __forceinline__ void xcd_barrier_complete(unsigned* bar, unsigned x, unsigned& nloc, unsigned& nx, unsigned& idx) {
    const unsigned G = gridDim.x * gridDim.y * gridDim.z;
    unsigned sum, cnt, mine, below, sp = 0u;
    for (;;) {
        sum = 0u; cnt = 0u; mine = 0u; below = 0u;
#pragma unroll
        for (unsigned j = 0; j < 16; ++j) { const unsigned c = xb_ld(&bar[XB_XCNT(j)]); sum += c; cnt += (c > 0u) ? 1u : 0u; mine = (j == x) ? c : mine; below += (c > 0u && j < x) ? 1u : 0u; }
        if (sum == G) break;
        __builtin_amdgcn_s_sleep(1);
        if ((++sp & 255u) == 0u) { if (xb_ld(&bar[XB_TMO])) break; if (sp > XB_SPIN_CAP) { atomicAdd(&bar[XB_TMO], 1u); break; } }
    }
    nloc = mine > 0u ? mine : 1u; nx = cnt > 0u ? cnt : 1u; idx = below;
}
__device__ __forceinline__ void xcd_barrier(unsigned* bar, unsigned x, volatile LAS unsigned* st, bool leader) {
    asm volatile("s_waitcnt vmcnt(0)" ::: "memory");
    __syncthreads();
    if (leader) {
        __builtin_amdgcn_s_waitcnt(0);
        unsigned nloc = st[0], nx = st[1];
        if (nloc == 0u) { unsigned idx; xcd_barrier_complete(bar, x, nloc, nx, idx); st[0] = nloc; st[1] = nx; st[2] = idx; }
        const unsigned old = xb_add(&bar[XB_XSUB(x)], 1u);
        const unsigned gen = old / nloc;
        if (old + 1u == (gen + 1u) * nloc) {
            __builtin_amdgcn_fence(__ATOMIC_RELEASE, "agent");
            asm volatile("s_waitcnt vmcnt(0)" ::: "memory");
            const unsigned og = xb_add(&bar[XB_TOP], 1u);
            const unsigned tg = og / nx;
            if (og + 1u == (tg + 1u) * nx) xb_add(&bar[XB_TOPGEN], 1u);
            else XB_SPIN(xb_ld(&bar[XB_TOPGEN]) == tg, bar);
            __builtin_amdgcn_fence(__ATOMIC_ACQUIRE, "agent");
            xb_add(&bar[XB_XGEN(x)], 1u);
            asm volatile("s_waitcnt vmcnt(0)" ::: "memory");
        } else {
            XB_SPIN(xb_ld(&bar[XB_XGEN(x)]) == gen, bar);
            __builtin_amdgcn_fence(__ATOMIC_ACQUIRE, "agent");
            asm volatile("s_waitcnt vmcnt(0)" ::: "memory");
        }
    }
    __syncthreads();
}

#define XB_LSUB(j)  (3456 + 64 * (j))
#define XB_LGEN(j)  (4480 + 64 * (j))
__device__ __forceinline__ void xcd_local_barrier(unsigned* bar, unsigned x, volatile LAS unsigned* st, bool leader) {
    asm volatile("s_waitcnt vmcnt(0)" ::: "memory");
    __syncthreads();
    if (leader) {
        __builtin_amdgcn_s_waitcnt(0);
        unsigned nloc = st[0];
        if (nloc == 0u) { unsigned nx, idx; xcd_barrier_complete(bar, x, nloc, nx, idx); st[0] = nloc; st[1] = nx; st[2] = idx; }
        asm volatile("buffer_inv sc1" ::: "memory");
        const unsigned old = xb_add(&bar[XB_LSUB(x)], 1u);
        const unsigned gen = old / nloc;
        if (old + 1u == (gen + 1u) * nloc) xb_add(&bar[XB_LGEN(x)], 1u);
        else XB_SPIN(xb_ld(&bar[XB_LGEN(x)]) == gen, bar);
        asm volatile("s_waitcnt vmcnt(0)" ::: "memory");
    }
    __syncthreads();
}

struct Args { const float* in[31]; float* out; unsigned char* ws; int ph_lo, ph_hi, use_bar, li, no_ssq, pad; };
enum { I_XP = 0, I_XS, I_CCKV, I_CKPE, I_C, I_CCTX, I_WMOD, I_BMOD, I_GN1, I_WIN, I_HYCONV, I_HYW1, I_HYB1, I_HYFREQ, I_HYW2, I_HYB2, I_HYW3, I_HYBIAS, I_SCCONV,
       I_GQ, I_WUQ, I_GKV, I_WUKV, I_GQH, I_GKH, I_GGRP, I_WOUT, I_GN2, I_WG, I_WU, I_WD };

typedef const __attribute__((address_space(4))) Args* KArgs;
struct Frame {
    LAS unsigned char* lds;
    int tid, lane, wave, G, bid;
    int rank, nloc, idx, nx;
    KArgs a;
    unsigned char* ws;
};
#define WSP(T, off) ((T*)(F.ws + (off)))

struct XGeom { int rank, nloc, idx, nx; __device__ __forceinline__ int nrb() const { return (8 - idx + nx - 1) / nx; } };
struct XOrder256 {
    XGeom x; int npn;
    __device__ __forceinline__ bool next(int i, pg8::Unit& u) const { const int per = 4 * npn, q = i * x.nloc + x.rank; if (q >= per * x.nrb()) return false;
        const int rb = x.idx + (q / per) * x.nx, qq = q % per; u.pm = 4 * rb + (qq & 3); u.pn = qq >> 2; return true; }
};


struct TrItem { const float* W; const float* kscale; bf16* WT; int N, k0, n0, ldk, dst_row0; };
__device__ __forceinline__ void tr_load(const TrItem& it, float (&v)[32], int lane) {
#pragma unroll
    for (int i = 0; i < 32; ++i) { const int kk = 2 * i + (lane >> 5); v[i] = it.W[(size_t)(it.k0 + kk) * it.N + it.n0 + (lane & 31)]; }
}
__device__ __forceinline__ void tr_finish(const TrItem& it, float (&v)[32], LAS float* scr, int lane) {
    if (it.kscale) {
#pragma unroll
        for (int i = 0; i < 32; ++i) v[i] *= it.kscale[it.k0 + 2 * i + (lane >> 5)]; }
#pragma unroll
    for (int i = 0; i < 32; ++i) { const int kk = 2 * i + (lane >> 5); scr[kk * 33 + (lane & 31)] = v[i]; }
    LDS_WAIT(); asm volatile("" ::: "memory");
    const int c = lane & 7;
#pragma unroll
    for (int j = 0; j < 4; ++j) { const int n = (lane >> 3) + 8 * j; const LAS float* s = scr + (8 * c) * 33 + n;
        v4u o; o.x = pk2(s[0 * 33], s[1 * 33]); o.y = pk2(s[2 * 33], s[3 * 33]); o.z = pk2(s[4 * 33], s[5 * 33]); o.w = pk2(s[6 * 33], s[7 * 33]);
        *(v4u*)(it.WT + (size_t)(it.dst_row0 + n) * it.ldk + it.k0 + 8 * c) = o; }
    LDS_WAIT(); asm volatile("" ::: "memory");
}
constexpr int T_IN = 16 * 61, T_OUT = 16 * 32, T_G = 16 * 88, T_D = 44 * 32, T_UQ = 4 * 24, T_UKV = 2 * 32;
constexpr int T_LAYER = T_IN + T_OUT + 2 * T_G + T_D + T_UQ + T_UKV;
constexpr int IT_MOD = 192 * 16, IT_FILT = 2 * 1280, IT_ROPE = 256;
constexpr int P0_ITEMS = IT_MOD + IT_FILT + IT_ROPE + 2 * T_LAYER;

__device__ __forceinline__ void p0_mod_item(Frame& F, int it, const LAS float* sv) {
    const int kc = it & 15, nbl = it >> 4, l = nbl / 96, n0 = (nbl % 96) * 64 + F.lane, k0 = kc * 64;
    const float* W = F.a->in[I_WMOD] + (size_t)l * D * 6144 + n0 + (size_t)k0 * 6144;
    float acc[5] = {0.f, 0.f, 0.f, 0.f, 0.f};
#pragma unroll 1
    for (int h = 0; h < 2; ++h) {
        float w[32];
#pragma unroll
        for (int u = 0; u < 32; ++u) w[u] = W[(size_t)(h * 32 + u) * 6144];
#pragma unroll
        for (int u = 0; u < 32; ++u)
#pragma unroll
            for (int j = 0; j < 5; ++j) acc[j] += sv[j * 1024 + k0 + h * 32 + u] * w[u];
    }
    const float b = kc == 0 ? F.a->in[I_BMOD][l * 6144 + n0] : 0.f;
    float* mod = WSP(float, WS_MOD) + (size_t)l * 5 * 6144 + n0;
#pragma unroll
    for (int j = 0; j < 5; ++j) if (F.a->no_ssq == 0) atomicAdd(mod + j * 6144, acc[j] + b);
}
__device__ __forceinline__ void p0_filt_item(Frame& F, int it) {
    const int l = it / 1280, r = it % 1280, sel = r >= 256, m = sel ? r - 256 : r, L = sel ? 1024 : 256, lane = F.lane;
    const float* w1 = F.a->in[I_HYW1] + l * 33 * 64; const float* w2 = F.a->in[I_HYW2] + l * 64 * 64; const float* w3 = F.a->in[I_HYW3] + l * 64 * 512;
    const float zt = (float)m / (float)(L - 1), wang = 6.283185307179586f * (float)m / (float)L;
    float zv = 0.f;
    if (lane == 0) zv = zt;
    else if (lane <= 16) { const float band = 1e-4f + (float)(lane - 1) * ((15.0f - 1e-4f) / 15.0f); zv = cosf(band * wang); }
    else if (lane <= 32) { const float band = 1e-4f + (float)(lane - 17) * ((15.0f - 1e-4f) / 15.0f); zv = -sinf(band * wang); }
    const float fr = F.a->in[I_HYFREQ][l * 64 + lane];
    float s = F.a->in[I_HYB1][l * 64 + lane];
#pragma unroll
    for (int i = 0; i < 33; ++i) s += rdl(zv, i) * w1[i * 64 + lane];
    const float h1 = sinf(fr * s);
    s = F.a->in[I_HYB2][l * 64 + lane];
#pragma unroll 32
    for (int i = 0; i < 64; ++i) s += rdl(h1, i) * w2[i * 64 + lane];
    const float h2 = sinf(fr * s);
    float h3[8] = {0.f, 0.f, 0.f, 0.f, 0.f, 0.f, 0.f, 0.f};
#pragma unroll 8
    for (int i = 0; i < 64; ++i) { const float hv = rdl(h2, i);
#pragma unroll
        for (int q = 0; q < 8; ++q) h3[q] += hv * w3[i * 512 + q * 64 + lane]; }
    const int XL = 2 * L + 32;
    bf16* R = WSP(bf16, WS_FILT) + (size_t)l * FILT_LAYER + (sel ? 256 * XL0 : 0);
    const float da = logf(0.01f) / 0.3f, db = logf(0.01f) / 1.5f;
#pragma unroll
    for (int q = 0; q < 4; ++q) { const int c = q * 64 + lane; const float delta = fabsf(da + (float)c * ((db - da) / 255.0f)); const float win = expf(-zt * delta) + 0.05f;
        R[(size_t)c * XL + (L + 32 - m)] = (bf16)f2bf(h3[q] * win + (m == 0 ? F.a->in[I_HYBIAS][l * 256 + c] : 0.f));
        if (m >= 1) R[(size_t)c * XL + (L + 32 + m)] = (bf16)f2bf(h3[q + 4] * win);
        if (m == 0) for (int i = 0; i <= 32; ++i) R[(size_t)c * XL + i] = 0; }
}
__device__ __forceinline__ void tr_decode(Frame& F, int item, TrItem& t) {
    constexpr int T0 = IT_MOD + IT_FILT + IT_ROPE;
        int r = item - T0; const int l = r / T_LAYER; r -= l * T_LAYER; t.kscale = nullptr;
        if (r < T_IN) { const int kb = r / 61, nb = r % 61; t.W = F.a->in[I_WIN] + (size_t)l * D * NIN; t.N = NIN; t.k0 = kb * 64; t.n0 = nb * 32; t.WT = WSP(bf16, WS_WIN) + (size_t)l * NINP * D; t.ldk = D; t.dst_row0 = nb * 32; return; } r -= T_IN;
        if (r < T_OUT) { const int kb = r / 32, nb = r % 32; t.W = F.a->in[I_WOUT] + (size_t)l * D * D; t.N = D; t.k0 = kb * 64; t.n0 = nb * 32; t.WT = WSP(bf16, WS_WOUT) + (size_t)l * D * D; t.ldk = D; t.dst_row0 = nb * 32; t.kscale = F.a->in[I_GGRP] + l * D; return; } r -= T_OUT;
        if (r < 2 * T_G) { const int up = r >= T_G; if (up) r -= T_G; const int kb = r / 88, nb = r % 88, u0 = nb * 32;
            t.W = F.a->in[up ? I_WU : I_WG] + (size_t)l * D * DFF; t.N = DFF; t.k0 = kb * 64; t.n0 = u0; t.WT = WSP(bf16, WS_WGU) + (size_t)l * NGU * D; t.ldk = D; t.dst_row0 = (u0 >> 7) * 256 + up * 128 + (u0 & 127); return; } r -= 2 * T_G;
        if (r < T_D) { const int kb = r / 32, nb = r % 32; t.W = F.a->in[I_WD] + (size_t)l * DFF * D; t.N = D; t.k0 = kb * 64; t.n0 = nb * 32; t.WT = WSP(bf16, WS_WD) + (size_t)l * D * DFF; t.ldk = DFF; t.dst_row0 = nb * 32; return; } r -= T_D;
        if (r < T_UQ) { const int kb = r / 24, nb = r % 24; t.W = F.a->in[I_WUQ] + (size_t)l * QL * 768; t.N = 768; t.k0 = kb * 64; t.n0 = nb * 32; t.WT = WSP(bf16, WS_WUQ) + (size_t)l * 768 * QL; t.ldk = QL; t.dst_row0 = nb * 32; return; } r -= T_UQ;
        { const int kb = r / 32, nb = r % 32; t.W = F.a->in[I_WUKV] + (size_t)l * KVL * 1024; t.N = 1024; t.k0 = kb * 64; t.n0 = nb * 32; t.WT = WSP(bf16, WS_WUKV) + (size_t)l * 1024 * KVL; t.ldk = KVL; t.dst_row0 = nb * 32; }
}
__device__ __forceinline__ void p0_phase(Frame& F) {
    LAS float* sv = (LAS float*)(F.lds + P0_SV);
    for (int i = F.tid; i < 5 * 1024; i += NTHR) { const int j = i >> 10, k = i & 1023; const float c = (j == 0) ? F.a->in[I_CCTX][k] : F.a->in[I_C][(j - 1) * 1024 + k]; sv[i] = c / (1.f + expf(-c)); }
    __syncthreads();
    LAS float* scr = (LAS float*)(F.lds + F.wave * P0_SCR);
    const int gw = F.wave * F.G + F.bid, NGW = F.G * NWAVES;
    const int pm = F.a->no_ssq;
    for (int it = gw; it < P0_ITEMS; it += NGW) {
        int r = it;
        if (r < IT_MOD) { if (pm != 2) p0_mod_item(F, r, sv); continue; } r -= IT_MOD;
        if (r < IT_FILT) { if (pm != 3) p0_filt_item(F, r); continue; } r -= IT_FILT;
        if (r < IT_ROPE) { const int t = r * 4 + (F.lane >> 4), e16 = F.lane & 15; const float pos = (float)((e16 < 8) ? (t >> 6) : (t & 63));
            const float x = pos * exp2f(-(float)(e16 & 7) * (13.287712379549449f / 8.0f));
            const float k = rintf(x * 0.15915494309189535f); float rr = fmaf(-k, 6.2831854820251465f, x); rr = fmaf(-k, -1.7484555e-07f, rr);
            float* T = WSP(float, WS_ROPE) + (size_t)t * 32; T[e16] = cosf(rr); T[16 + e16] = sinf(rr); continue; } r -= IT_ROPE;
        break;
    }
    if (pm == 4) return;
    constexpr int T0 = IT_MOD + IT_FILT + IT_ROPE;
    int it = gw; while (it < T0) it += NGW;
    if (it < P0_ITEMS) {
        TrItem cur, nxt; float va[32], vb[32];
        tr_decode(F, it, cur); tr_load(cur, va, F.lane);
        for (;;) {
            const int i1 = it + NGW; const bool h1 = i1 < P0_ITEMS;
            if (h1) { tr_decode(F, i1, nxt); tr_load(nxt, vb, F.lane); }
            tr_finish(cur, va, scr, F.lane);
            if (!h1) break;
            const int i2 = i1 + NGW; const bool h2 = i2 < P0_ITEMS;
            if (h2) { tr_decode(F, i2, cur); tr_load(cur, va, F.lane); }
            tr_finish(nxt, vb, scr, F.lane);
            if (!h2) break;
            it = i2;
        }
    }
}

constexpr int AQ_LD = 264, AKV_LD = 136;
constexpr int QR = 64;
constexpr int QK_AQ = 0, QK_AKV = QK_AQ + QR * AQ_LD * 2, QK_KPE = QK_AKV + QR * AKV_LD * 2, QK_KSS = QK_KPE + QR * 32 * 4, QK_KRS = QK_KSS + QR * 4, QK_W = QK_KRS + 8 * 32 * 4, QK_END = QK_W + 512 * 128;
static_assert(QK_END <= RING_BYTES && (QK_W & 15) == 0, "qkv LDS");

template <bool FROM_CACHE>
__device__ __forceinline__ void qkv_unit(Frame& F, int l, int u) {
    LAS bf16* Aq = (LAS bf16*)(F.lds + QK_AQ); LAS bf16* Akv = (LAS bf16*)(F.lds + QK_AKV);
    LAS float* kpe = (LAS float*)(F.lds + QK_KPE); LAS float* kss = (LAS float*)(F.lds + QK_KSS); LAS float* krs = (LAS float*)(F.lds + QK_KRS);
    const int tid = F.tid, lane = F.lane, w = F.wave, f = lane & 15, g = lane >> 4;
    const int hs = u & 1, hl = w & 3, h = hs * 4 + hl, rhalf = w >> 2;
    const int row0 = FROM_CACHE ? 0 : (u >> 1) * QR;
    const bool latent = FROM_CACHE ? false : (row0 >= MC);
    int t0, Lk; bf16* Kseg; bf16* Vtseg;
    if (FROM_CACHE) { const int ridx = ((u & 31) >> 1) * QR, b = ridx >> 8; t0 = 1024 + (ridx & 255); Lk = 1280;
        Kseg = WSP(bf16, WS_KL) + ((size_t)(l * 4 + b) * 1280) * 768; Vtseg = WSP(bf16, WS_VTL) + (size_t)(l * 4 + b) * 8 * 64 * 1280; }
    else if (latent) { const int b = (row0 - MC) >> 10; t0 = (row0 - MC) & 1023; Lk = 1280;
        Kseg = WSP(bf16, WS_KL) + ((size_t)(l * 4 + b) * 1280) * 768; Vtseg = WSP(bf16, WS_VTL) + (size_t)(l * 4 + b) * 8 * 64 * 1280; }
    else { const int b = row0 >> 8; t0 = row0 & 255; Lk = 256; Kseg = WSP(bf16, WS_KC) + ((size_t)b * 256) * 768; Vtseg = WSP(bf16, WS_VTC) + (size_t)b * 8 * 64 * 256; }
    LAS unsigned char* Wl = F.lds + QK_W;
    LAS unsigned char* wl = Wl + (tid >> 3) * 128 + (((tid & 7) ^ ((tid >> 4) & 7)) << 4);
    v4u pre[8];
    const bf16* wpq = WSP(bf16, WS_WUQ) + (size_t)l * 768 * QL + (size_t)(hs * 384 + (tid >> 3)) * QL + (tid & 7) * 8;
    if (!FROM_CACHE) {
#pragma unroll
        for (int i = 0; i < 6; ++i) pre[i] = *(const v4u*)(wpq + (size_t)i * 64 * QL);
    }
#pragma unroll
    for (int rp = 0; rp < 2; ++rp) {
        const int r = (tid >> 4) + 32 * rp, s = tid & 15;
        if (!FROM_CACHE) {
            const bf16* prow = WSP(bf16, WS_PROJ) + (size_t)(row0 + r) * NINP;
            float v[16]; float ss = 0.f;
#pragma unroll
            for (int i = 0; i < 2; ++i) { const v4u ww = *(const v4u*)(prow + O_CQ + s * 16 + i * 8);
                v[i * 8 + 0] = bflo(ww.x); v[i * 8 + 1] = bfhi(ww.x); v[i * 8 + 2] = bflo(ww.y); v[i * 8 + 3] = bfhi(ww.y); v[i * 8 + 4] = bflo(ww.z); v[i * 8 + 5] = bfhi(ww.z); v[i * 8 + 6] = bflo(ww.w); v[i * 8 + 7] = bfhi(ww.w); }
#pragma unroll
            for (int i = 0; i < 16; ++i) ss += v[i] * v[i];
            ss += shx(ss, 1, lane); ss += shx(ss, 2, lane); ss += shx(ss, 4, lane); ss += shx(ss, 8, lane);
            const float rstd = rsqrtf(ss * (1.0f / QL) + EPS);
            const float* gq = F.a->in[I_GQ] + l * QL + s * 16;
#pragma unroll
            for (int i = 0; i < 2; ++i) { v4u o; o.x = pk2(v[i * 8 + 0] * rstd * gq[i * 8 + 0], v[i * 8 + 1] * rstd * gq[i * 8 + 1]); o.y = pk2(v[i * 8 + 2] * rstd * gq[i * 8 + 2], v[i * 8 + 3] * rstd * gq[i * 8 + 3]);
                o.z = pk2(v[i * 8 + 4] * rstd * gq[i * 8 + 4], v[i * 8 + 5] * rstd * gq[i * 8 + 5]); o.w = pk2(v[i * 8 + 6] * rstd * gq[i * 8 + 6], v[i * 8 + 7] * rstd * gq[i * 8 + 7]);
                *(LAS v4u*)(Aq + r * AQ_LD + s * 16 + i * 8) = o; }
        }
        float c[8], p[2];
        if (FROM_CACHE) { const int ridx = ((u & 31) >> 1) * QR + r, b = ridx >> 8, t = ridx & 255;
            const float* ck = F.a->in[I_CCKV] + ((size_t)((b * 2 + l) * 256 + t)) * 128 + s * 8; const float* kp = F.a->in[I_CKPE] + ((size_t)((b * 2 + l) * 256 + t)) * 32 + s * 2;
#pragma unroll
            for (int i = 0; i < 2; ++i) { const f32x4 ww = *(const f32x4*)(ck + i * 4); c[i * 4] = ww.x; c[i * 4 + 1] = ww.y; c[i * 4 + 2] = ww.z; c[i * 4 + 3] = ww.w; }
            const f32x2 ww = *(const f32x2*)kp; p[0] = ww.x; p[1] = ww.y;
        } else { const bf16* prow = WSP(bf16, WS_PROJ) + (size_t)(row0 + r) * NINP;
            const v4u ww = *(const v4u*)(prow + O_CKV + s * 8);
            c[0] = bflo(ww.x); c[1] = bfhi(ww.x); c[2] = bflo(ww.y); c[3] = bfhi(ww.y); c[4] = bflo(ww.z); c[5] = bfhi(ww.z); c[6] = bflo(ww.w); c[7] = bfhi(ww.w);
            const unsigned w2 = *(const unsigned*)(prow + O_KPE + s * 2); p[0] = bflo(w2); p[1] = bfhi(w2);
        }
        float ss = 0.f;
#pragma unroll
        for (int i = 0; i < 8; ++i) ss += c[i] * c[i];
        ss += shx(ss, 1, lane); ss += shx(ss, 2, lane); ss += shx(ss, 4, lane); ss += shx(ss, 8, lane);
        const float rstd = rsqrtf(ss * (1.0f / KVL) + EPS);
        const float* gkv = F.a->in[I_GKV] + l * KVL + s * 8;
        { v4u o; o.x = pk2(c[0] * rstd * gkv[0], c[1] * rstd * gkv[1]); o.y = pk2(c[2] * rstd * gkv[2], c[3] * rstd * gkv[3]);
            o.z = pk2(c[4] * rstd * gkv[4], c[5] * rstd * gkv[5]); o.w = pk2(c[6] * rstd * gkv[6], c[7] * rstd * gkv[7]);
            *(LAS v4u*)(Akv + r * AKV_LD + s * 8) = o; }
        float ps = p[0] * p[0] + p[1] * p[1];
        ps += shx(ps, 1, lane); ps += shx(ps, 2, lane); ps += shx(ps, 4, lane); ps += shx(ps, 8, lane);
        *(LAS f32x2*)(kpe + r * 32 + s * 2) = (f32x2){p[0], p[1]};
        if (s == 0) kss[r] = ps;
    }
    const bf16* wpk = WSP(bf16, WS_WUKV) + (size_t)l * 1024 * KVL + (size_t)(hs * 512 + (tid >> 3)) * KVL + (tid & 7) * 8;
    if (!FROM_CACHE) {
        f32x4 acc[2][6];
#pragma unroll
        for (int rt = 0; rt < 2; ++rt)
#pragma unroll
            for (int ct = 0; ct < 6; ++ct) acc[rt][ct] = (f32x4){0.f, 0.f, 0.f, 0.f};
#pragma unroll 1
        for (int kk = 0; kk < 4; ++kk) {
#pragma unroll
            for (int i = 0; i < 6; ++i) *(LAS v4u*)(wl + i * 64 * 128) = pre[i];
            __syncthreads();
            if (kk + 1 < 4) {
#pragma unroll
                for (int i = 0; i < 6; ++i) pre[i] = *(const v4u*)(wpq + (size_t)i * 64 * QL + (kk + 1) * 64); }
            else {
#pragma unroll
                for (int i = 0; i < 8; ++i) pre[i] = *(const v4u*)(wpk + (size_t)i * 64 * KVL); }
#pragma unroll
            for (int ks = 0; ks < 2; ++ks) {
                bf16x8 a[2], b[6];
#pragma unroll
                for (int rt = 0; rt < 2; ++rt) a[rt] = *(const LAS bf16x8*)(Aq + (rhalf * 32 + rt * 16 + f) * AQ_LD + kk * 64 + ks * 32 + g * 8);
#pragma unroll
                for (int ct = 0; ct < 6; ++ct) { const int nl = hl * QKD + ct * 16 + f; b[ct] = *(const LAS bf16x8*)(Wl + nl * 128 + (((ks * 4 + g) ^ ((nl >> 1) & 7)) << 4)); }
#pragma unroll
                for (int rt = 0; rt < 2; ++rt)
#pragma unroll
                    for (int ct = 0; ct < 6; ++ct) acc[rt][ct] = __builtin_amdgcn_mfma_f32_16x16x32_bf16(a[rt], b[ct], acc[rt][ct], 0, 0, 0);
            }
            __syncthreads();
        }
        const float* gqh = F.a->in[I_GQH] + l * QKD;
        float gq[6];
#pragma unroll
        for (int ct = 0; ct < 6; ++ct) gq[ct] = gqh[ct * 16 + f];
        const float* RT = WSP(float, WS_ROPE);
        bf16* Qo = WSP(bf16, WS_Q);
#pragma unroll
        for (int rt = 0; rt < 2; ++rt)
#pragma unroll
            for (int i = 0; i < 4; ++i) {
                float ss = 0.f;
#pragma unroll
                for (int ct = 0; ct < 6; ++ct) ss += acc[rt][ct][i] * acc[rt][ct][i];
                ss += shx(ss, 1, lane); ss += shx(ss, 2, lane); ss += shx(ss, 4, lane); ss += shx(ss, 8, lane);
                const float rstd = rsqrtf(ss * (1.0f / QKD) + EPS);
                const int tok = rhalf * 32 + rt * 16 + 4 * g + i, t = t0 + tok;
                float v[6];
#pragma unroll
                for (int ct = 0; ct < 6; ++ct) v[ct] = acc[rt][ct][i] * rstd * gq[ct];
                if (latent) {
#pragma unroll
                    for (int ct = 4; ct < 6; ++ct) { const float partner = shx(v[ct], 8, lane); const float cs = RT[(size_t)t * 32 + (ct - 4) * 8 + (f & 7)], sn = RT[(size_t)t * 32 + 16 + (ct - 4) * 8 + (f & 7)];
                        v[ct] = v[ct] * cs + (f < 8 ? -partner : partner) * sn; }
                }
                bf16* qrow = Qo + (size_t)(row0 + tok) * 768 + h * QKD + f;
#pragma unroll
                for (int ct = 0; ct < 6; ++ct) qrow[ct * 16] = (bf16)f2bf(v[ct] * QSCALE);
            }
    } else {
#pragma unroll
        for (int i = 0; i < 8; ++i) pre[i] = *(const v4u*)(wpk + (size_t)i * 64 * KVL);
    }
    {
        const float* gkh = F.a->in[I_GKH] + l * QKD;
        float gk[4];
#pragma unroll
        for (int ct = 0; ct < 4; ++ct) gk[ct] = gkh[ct * 16 + f];
        f32x4 acc[2][8];
#pragma unroll
        for (int rt = 0; rt < 2; ++rt)
#pragma unroll
            for (int ct = 0; ct < 8; ++ct) acc[rt][ct] = (f32x4){0.f, 0.f, 0.f, 0.f};
#pragma unroll 1
        for (int kk = 0; kk < 2; ++kk) {
#pragma unroll
            for (int i = 0; i < 8; ++i) *(LAS v4u*)(wl + i * 64 * 128) = pre[i];
            __syncthreads();
            if (kk + 1 < 2) {
#pragma unroll
                for (int i = 0; i < 8; ++i) pre[i] = *(const v4u*)(wpk + (size_t)i * 64 * KVL + (kk + 1) * 64); }
#pragma unroll
            for (int ks = 0; ks < 2; ++ks) {
                bf16x8 a[2], b[8];
#pragma unroll
                for (int rt = 0; rt < 2; ++rt) a[rt] = *(const LAS bf16x8*)(Akv + (rhalf * 32 + rt * 16 + f) * AKV_LD + kk * 64 + ks * 32 + g * 8);
#pragma unroll
                for (int ct = 0; ct < 8; ++ct) { const int nl = hl * 128 + ct * 16 + f; b[ct] = *(const LAS bf16x8*)(Wl + nl * 128 + (((ks * 4 + g) ^ ((nl >> 1) & 7)) << 4)); }
#pragma unroll
                for (int rt = 0; rt < 2; ++rt)
#pragma unroll
                    for (int ct = 0; ct < 8; ++ct) acc[rt][ct] = __builtin_amdgcn_mfma_f32_16x16x32_bf16(a[rt], b[ct], acc[rt][ct], 0, 0, 0);
            }
            __syncthreads();
        }
#pragma unroll
        for (int rt = 0; rt < 2; ++rt) {
#pragma unroll
            for (int i = 0; i < 4; ++i) {
                float ss = 0.f;
#pragma unroll
                for (int ct = 0; ct < 4; ++ct) ss += acc[rt][ct][i] * acc[rt][ct][i];
                ss += shx(ss, 1, lane); ss += shx(ss, 2, lane); ss += shx(ss, 4, lane); ss += shx(ss, 8, lane);
                const int tok = rt * 16 + 4 * g + i;
                const float rstd = rsqrtf((ss + kss[rhalf * 32 + tok]) * (1.0f / QKD) + EPS);
                if (f == 0) krs[w * 32 + tok] = rstd;
                bf16* krow = Kseg + (size_t)(t0 + rhalf * 32 + tok) * 768 + h * QKD + f;
#pragma unroll
                for (int ct = 0; ct < 4; ++ct) krow[ct * 16] = (bf16)f2bf(acc[rt][ct][i] * rstd * gk[ct]);
            }
#pragma unroll
            for (int ct = 4; ct < 8; ++ct) { const int d = (ct - 4) * 16 + f;
                v2u o; o.x = pk2(acc[rt][ct][0], acc[rt][ct][1]); o.y = pk2(acc[rt][ct][2], acc[rt][ct][3]);
                *(v2u*)(Vtseg + ((size_t)h * 64 + d) * Lk + t0 + rhalf * 32 + rt * 16 + 4 * g) = o; }
        }
        LDS_WAIT(); asm volatile("" ::: "memory");
        {
            const int tok = lane & 31, ax = lane >> 5, t = t0 + rhalf * 32 + tok; const float rs = krs[w * 32 + tok];
            float v[16];
#pragma unroll
            for (int i = 0; i < 4; ++i) { const f32x4 ww = *(const LAS f32x4*)(kpe + (rhalf * 32 + tok) * 32 + ax * 16 + i * 4); v[i * 4] = ww.x; v[i * 4 + 1] = ww.y; v[i * 4 + 2] = ww.z; v[i * 4 + 3] = ww.w; }
#pragma unroll
            for (int i = 0; i < 16; ++i) v[i] *= rs * gkh[64 + ax * 16 + i];
            if (latent) { const float* RT = WSP(float, WS_ROPE) + (size_t)t * 32 + ax * 8;
#pragma unroll
                for (int e = 0; e < 8; ++e) { const float cs = RT[e], sn = RT[16 + e]; const float A = v[e], B = v[8 + e]; v[e] = A * cs - B * sn; v[8 + e] = B * cs + A * sn; } }
            bf16* krow = Kseg + (size_t)t * 768 + h * QKD + 64 + ax * 16;
#pragma unroll
            for (int i = 0; i < 2; ++i) { v4u o; o.x = pk2(v[i * 8], v[i * 8 + 1]); o.y = pk2(v[i * 8 + 2], v[i * 8 + 3]); o.z = pk2(v[i * 8 + 4], v[i * 8 + 5]); o.w = pk2(v[i * 8 + 6], v[i * 8 + 7]); *(v4u*)(krow + i * 8) = o; }
        }
    }
    __syncthreads();
}

constexpr int P1_XROWS = M, P1_GG = 20, P1_BIAS = 2 * (NIN / 8 + NGU / 8);
constexpr int P1_ITEMS = P1_XROWS + P1_GG + P1_BIAS;
__device__ __forceinline__ void p1_phase(Frame& F) {
    const int gw = F.wave * F.G + F.bid, NGW = F.G * NWAVES, lane = F.lane;
    const float* MOD = WSP(float, WS_MOD);
    for (int it = gw; it < P1_XROWS; it += 2 * NGW) {
        const int ra = it, rb = it + NGW; const bool hb = rb < P1_XROWS; const int rb_ = hb ? rb : ra;
        const float* xa = (ra < MC) ? F.a->in[I_XP] + (size_t)ra * D : F.a->in[I_XS] + (size_t)(ra - MC) * D;
        const float* xb = (rb_ < MC) ? F.a->in[I_XP] + (size_t)rb_ * D : F.a->in[I_XS] + (size_t)(rb_ - MC) * D;
        const float* sca = MOD + (size_t)modidx(ra) * 6144 + 1024; const float* scb = MOD + (size_t)modidx(rb_) * 6144 + 1024; const float* gn = F.a->in[I_GN1];
        f32x4 va[4], vb[4]; float sa = 0.f, sb = 0.f;
#pragma unroll
        for (int q = 0; q < 4; ++q) { va[q] = *(const f32x4*)(xa + 256 * q + 4 * lane); vb[q] = *(const f32x4*)(xb + 256 * q + 4 * lane); }
#pragma unroll
        for (int q = 0; q < 4; ++q) { sa += (va[q].x * va[q].x + va[q].y * va[q].y) + (va[q].z * va[q].z + va[q].w * va[q].w); sb += (vb[q].x * vb[q].x + vb[q].y * vb[q].y) + (vb[q].z * vb[q].z + vb[q].w * vb[q].w); }
        sa = wave_sum(sa, lane); sb = wave_sum(sb, lane);
        bf16* oa = WSP(bf16, WS_XG) + (size_t)ra * D; bf16* ob = WSP(bf16, WS_XG) + (size_t)rb_ * D;
#pragma unroll
        for (int q = 0; q < 4; ++q) { const int c = 256 * q + 4 * lane; const f32x4 g = *(const f32x4*)(gn + c); const f32x4 s1 = *(const f32x4*)(sca + c), s2 = *(const f32x4*)(scb + c);
            v2u w; w.x = pk2(va[q].x * g.x * (1.f + s1.x), va[q].y * g.y * (1.f + s1.y)); w.y = pk2(va[q].z * g.z * (1.f + s1.z), va[q].w * g.w * (1.f + s1.w)); *(v2u*)(oa + c) = w;
            if (hb) { v2u w2; w2.x = pk2(vb[q].x * g.x * (1.f + s2.x), vb[q].y * g.y * (1.f + s2.y)); w2.y = pk2(vb[q].z * g.z * (1.f + s2.z), vb[q].w * g.w * (1.f + s2.w)); *(v2u*)(ob + c) = w2; } }
        if (lane == 0) { WSP(float, WS_SSQ1P)[(size_t)ra * 16] = sa; if (hb) WSP(float, WS_SSQ1P)[(size_t)rb * 16] = sb; }
    }
    for (int it = P1_XROWS + gw; it < P1_ITEMS; it += NGW) {
        int r = it;
        r -= P1_XROWS;
        if (r < P1_GG) { const int l = r / 10, kind = (r % 10) / 5, j = r % 5;
            const float* gn = F.a->in[kind ? I_GN2 : I_GN1] + l * D; const float* sc = MOD + ((size_t)l * 5 + j) * 6144 + (kind ? 4096 : 1024);
            float* o = WSP(float, WS_GG) + ((size_t)(l * 2 + kind) * 5 + j) * D;
#pragma unroll
            for (int q = 0; q < 4; ++q) { const int c = 256 * q + 4 * lane; const f32x4 g = *(const f32x4*)(gn + c); const f32x4 s4 = *(const f32x4*)(sc + c); *(f32x4*)(o + c) = (f32x4){g.x * (1.f + s4.x), g.y * (1.f + s4.y), g.z * (1.f + s4.z), g.w * (1.f + s4.w)}; }
            continue;
        }
        r -= P1_GG;
        {
            const int per = NIN / 8 + NGU / 8, l = r / per; int q = r % per; const bool gu = q >= NIN / 8; if (gu) q -= NIN / 8;
            const bf16* Wt = gu ? WSP(bf16, WS_WGU) + (size_t)l * NGU * D : WSP(bf16, WS_WIN) + (size_t)l * NINP * D;
            float* bo = gu ? WSP(float, WS_BGU) + (size_t)l * 5 * NGU : WSP(float, WS_BIN) + (size_t)l * 5 * NINP; const int ldb = gu ? NGU : NINP;
            const float* shb = MOD + (size_t)l * 5 * 6144 + (gu ? 3072 : 0);
            float sh[5][16];
#pragma unroll
            for (int j = 0; j < 5; ++j)
#pragma unroll
                for (int hh = 0; hh < 2; ++hh)
#pragma unroll
                    for (int e = 0; e < 2; ++e) { const f32x4 w = *(const f32x4*)(shb + (size_t)j * 6144 + hh * 512 + lane * 8 + e * 4); sh[j][hh * 8 + e * 4] = w.x; sh[j][hh * 8 + e * 4 + 1] = w.y; sh[j][hh * 8 + e * 4 + 2] = w.z; sh[j][hh * 8 + e * 4 + 3] = w.w; }
#pragma unroll 1
            for (int nb = 0; nb < 2; ++nb) {
                v4u xw[4][2];
#pragma unroll
                for (int n4 = 0; n4 < 4; ++n4)
#pragma unroll
                    for (int hh = 0; hh < 2; ++hh) xw[n4][hh] = *(const v4u*)(Wt + (size_t)(q * 8 + nb * 4 + n4) * D + hh * 512 + lane * 8);
#pragma unroll
                for (int n4 = 0; n4 < 4; ++n4) { const int n = q * 8 + nb * 4 + n4;
                    float w[16];
#pragma unroll
                    for (int hh = 0; hh < 2; ++hh) { const v4u x = xw[n4][hh]; w[hh * 8] = bflo(x.x); w[hh * 8 + 1] = bfhi(x.x); w[hh * 8 + 2] = bflo(x.y); w[hh * 8 + 3] = bfhi(x.y); w[hh * 8 + 4] = bflo(x.z); w[hh * 8 + 5] = bfhi(x.z); w[hh * 8 + 6] = bflo(x.w); w[hh * 8 + 7] = bfhi(x.w); }
#pragma unroll
                    for (int j = 0; j < 5; ++j) { float s = 0.f;
#pragma unroll
                        for (int e = 0; e < 16; ++e) s += w[e] * sh[j][e];
                        s = wave_sum(s, lane); if (lane == 0) bo[(size_t)j * ldb + n] = s; }
                }
            }
        }
    }
    for (int u = F.bid; u < 64; u += F.G) qkv_unit<true>(F, u >> 5, u);
}

__device__ __forceinline__ void prep_phase(Frame& F, int l) {
    { const XGeom X{F.rank, F.nloc, F.idx, F.nx}; for (int q = X.rank; q < 32 * X.nrb(); q += X.nloc) qkv_unit<false>(F, l, 32 * (X.idx + (q >> 5) * X.nx) + (q & 31)); }
}

typedef float f32x16 __attribute__((ext_vector_type(16)));
constexpr int AT_KLD = 208, AT_VLD = 136;
constexpr int AT_KT = 64 * AT_KLD, AT_VT = 64 * AT_VLD, AT_BUF = AT_KT + AT_VT;
static_assert(2 * AT_BUF <= RING_BYTES, "attention LDS");
__device__ __forceinline__ void attn_unit(Frame& F, int l, bool latent, int seg, int h, int qb) {
    int tid_ = F.tid; asm volatile("" : "+v"(tid_));
    const int tid = tid_, lane = tid & 63, r32 = lane & 31, hh = lane >> 5;
    const int Lk = latent ? 1280 : 256, NT = Lk / 64;
    const int qrow0 = (latent ? MC + seg * 1024 : seg * 256) + qb * 256 + F.wave * 32;
    const bf16* Kb = latent ? WSP(bf16, WS_KL) + ((size_t)(l * 4 + seg) * 1280) * 768 + h * QKD : WSP(bf16, WS_KC) + ((size_t)seg * 256) * 768 + h * QKD;
    const bf16* Vt = latent ? WSP(bf16, WS_VTL) + ((size_t)(l * 4 + seg) * 8 + h) * 64 * 1280 : WSP(bf16, WS_VTC) + ((size_t)seg * 8 + h) * 64 * 256;
    bf16x8 qf[6];
    { const bf16* Qp = WSP(bf16, WS_Q) + (size_t)(qrow0 + r32) * 768 + h * QKD + hh * 8;
#pragma unroll
      for (int kk = 0; kk < 6; ++kk) qf[kk] = *(const bf16x8*)(Qp + kk * 16); }
    const int kr0 = tid / 12, kc0 = tid % 12, kr1 = (tid + 512) / 12, kc1 = (tid + 512) % 12, vr = tid >> 3, vc = tid & 7;
    const bf16* ksrc0 = Kb + (size_t)kr0 * 768 + kc0 * 8; const bf16* ksrc1 = Kb + (size_t)kr1 * 768 + kc1 * 8; const bf16* vsrc = Vt + (size_t)vr * Lk + vc * 8;
    const int kdst0 = kr0 * AT_KLD + kc0 * 16, kdst1 = kr1 * AT_KLD + kc1 * 16, vdst = 2 * AT_KT + vr * AT_VLD + vc * 16;
    const bool k2 = tid < 256;
    v4u sk0, sk1 = (v4u){0u, 0u, 0u, 0u}, sv;
#define AT_LOADK(t) do { sk0 = *(const v4u*)(ksrc0 + (size_t)(t) * 64 * 768); if (k2) sk1 = *(const v4u*)(ksrc1 + (size_t)(t) * 64 * 768); } while (0)
#define AT_LOADV(t) do { sv = *(const v4u*)(vsrc + (t) * 64); } while (0)
#define AT_WRITEK(buf) do { LAS unsigned char* b_ = F.lds + (buf) * AT_KT; *(LAS v4u*)(b_ + kdst0) = sk0; if (k2) *(LAS v4u*)(b_ + kdst1) = sk1; } while (0)
#define AT_WRITEV(buf) do { LAS unsigned char* b_ = F.lds + (buf) * AT_VT; *(LAS v2u*)(b_ + vdst) = (v2u){sv.x, sv.y}; *(LAS v2u*)(b_ + vdst + 8) = (v2u){sv.z, sv.w}; } while (0)
    const int koff = r32 * AT_KLD + hh * 16, voff = 2 * AT_KT + r32 * AT_VLD + hh * 8;
    float mrun = -1e30f, lsum = 0.f;
    f32x16 o0, o1, sa0, sa1, sb0, sb1;
    v4u pw0, pw1, pw2, pw3;
#pragma unroll
    for (int r = 0; r < 16; ++r) { o0[r] = 0.f; o1[r] = 0.f; }
    {
        AT_LOADK(0);
        const v4u t0_ = *(const v4u*)(ksrc0 + (size_t)(1 * 1) * 64 * 768); v4u t1_ = (v4u){0u, 0u, 0u, 0u}; if (k2) t1_ = *(const v4u*)(ksrc1 + (size_t)(1 * 1) * 64 * 768);
        AT_WRITEK(0); sk0 = t0_; sk1 = t1_; AT_WRITEK(1); }
    __syncthreads();
    {   const LAS unsigned char* B = F.lds;
#pragma unroll
        for (int r = 0; r < 16; ++r) { sa0[r] = 0.f; sa1[r] = 0.f; }
#pragma unroll
        for (int kk = 0; kk < 6; ++kk) {
            const bf16x8 a0 = *(const LAS bf16x8*)(B + koff + kk * 32), a1 = *(const LAS bf16x8*)(B + koff + 32 * AT_KLD + kk * 32);
            sa0 = __builtin_amdgcn_mfma_f32_32x32x16_bf16(a0, qf[kk], sa0, 0, 0, 0); sa1 = __builtin_amdgcn_mfma_f32_32x32x16_bf16(a1, qf[kk], sa1, 0, 0, 0);
        } }
    __syncthreads();
#define AT_S(KK, N0, N1) do { const bf16x8 a0_ = *(const LAS bf16x8*)(Kn_ + koff + (KK) * 32), a1_ = *(const LAS bf16x8*)(Kn_ + koff + 32 * AT_KLD + (KK) * 32); \
        if ((KK) == 0) { f32x16 z_; _Pragma("unroll") for (int r = 0; r < 16; ++r) z_[r] = 0.f; \
            N0 = __builtin_amdgcn_mfma_f32_32x32x16_bf16(a0_, qf[0], z_, 0, 0, 0); N1 = __builtin_amdgcn_mfma_f32_32x32x16_bf16(a1_, qf[0], z_, 0, 0, 0); } \
        else { N0 = __builtin_amdgcn_mfma_f32_32x32x16_bf16(a0_, qf[KK], N0, 0, 0, 0); N1 = __builtin_amdgcn_mfma_f32_32x32x16_bf16(a1_, qf[KK], N1, 0, 0, 0); } } while (0)
#define AT_PV(GS, PW) do { const bf16x8 pB_ = __builtin_bit_cast(bf16x8, PW); \
        const v2u a0_ = *(const LAS v2u*)(Vp_ + voff + (GS) * 32), a1_ = *(const LAS v2u*)(Vp_ + voff + (GS) * 32 + 16); \
        const v2u b0_ = *(const LAS v2u*)(Vp_ + voff + 32 * AT_VLD + (GS) * 32), b1_ = *(const LAS v2u*)(Vp_ + voff + 32 * AT_VLD + (GS) * 32 + 16); \
        o0 = __builtin_amdgcn_mfma_f32_32x32x16_bf16(__builtin_bit_cast(bf16x8, (v4u){a0_.x, a0_.y, a1_.x, a1_.y}), pB_, o0, 0, 0, 0); \
        o1 = __builtin_amdgcn_mfma_f32_32x32x16_bf16(__builtin_bit_cast(bf16x8, (v4u){b0_.x, b0_.y, b1_.x, b1_.y}), pB_, o1, 0, 0, 0); } while (0)
#define AT_EXP8(C, R0) do { _Pragma("unroll") for (int r = (R0); r < (R0) + 8; r += 2) { const f32x2 d_ = (f32x2){C[r], C[r + 1]} - mn2_; C[r] = __builtin_amdgcn_exp2f(d_.x); C[r + 1] = __builtin_amdgcn_exp2f(d_.y); ps2_ += (f32x2){C[r], C[r + 1]}; } } while (0)
#define AT_STEP(T, C0, C1, N0, N1, DOS, DOPV, LOADK) do { \
        const int t_ = (T); \
        if (LOADK) AT_LOADK(t_ + 2); \
        AT_LOADV(t_); \
        const LAS unsigned char* Kn_ = F.lds + ((t_ + 1) & 1) * AT_KT; \
        const LAS unsigned char* Vp_ = F.lds + ((t_ + 1) & 1) * AT_VT; \
        if (DOPV) AT_PV(0, pw0); \
        if (DOS) AT_S(0, N0, N1); \
        float mx_ = fmaxf(C0[0], C1[0]); \
        _Pragma("unroll") for (int r = 1; r < 16; ++r) mx_ = max3f(mx_, C0[r], C1[r]); \
        __builtin_amdgcn_sched_barrier(0); \
        if (DOPV) AT_PV(1, pw1); \
        if (DOS) AT_S(1, N0, N1); \
        mx_ = max32(mx_); \
        const float mnew_ = fmaxf(mrun, mx_), alpha_ = __builtin_amdgcn_exp2f(mrun - mnew_); mrun = mnew_; \
        f32x2 ps2_ = (f32x2){0.f, 0.f}; const f32x2 mn2_ = (f32x2){mnew_, mnew_}; \
        AT_EXP8(C0, 0); \
        __builtin_amdgcn_sched_barrier(0); \
        if (DOPV) AT_PV(2, pw2); \
        if (DOS) AT_S(2, N0, N1); \
        AT_EXP8(C0, 8); \
        __builtin_amdgcn_sched_barrier(0); \
        if (DOPV) AT_PV(3, pw3); \
        if (DOS) AT_S(3, N0, N1); \
        AT_EXP8(C1, 0); \
        __builtin_amdgcn_sched_barrier(0); \
        if (DOS) AT_S(4, N0, N1); \
        AT_EXP8(C1, 8); \
        __builtin_amdgcn_sched_barrier(0); \
        if (DOS) AT_S(5, N0, N1); \
        lsum = lsum * alpha_ + (ps2_.x + ps2_.y); \
        _Pragma("unroll") for (int r = 0; r < 16; ++r) { o0[r] *= alpha_; o1[r] *= alpha_; } \
        pw0.x = cvtpk(C0[0], C0[1]); pw0.y = cvtpk(C0[2], C0[3]); pw0.z = cvtpk(C0[4], C0[5]); pw0.w = cvtpk(C0[6], C0[7]); \
        pw1.x = cvtpk(C0[8], C0[9]); pw1.y = cvtpk(C0[10], C0[11]); pw1.z = cvtpk(C0[12], C0[13]); pw1.w = cvtpk(C0[14], C0[15]); \
        pw2.x = cvtpk(C1[0], C1[1]); pw2.y = cvtpk(C1[2], C1[3]); pw2.z = cvtpk(C1[4], C1[5]); pw2.w = cvtpk(C1[6], C1[7]); \
        pw3.x = cvtpk(C1[8], C1[9]); pw3.y = cvtpk(C1[10], C1[11]); pw3.z = cvtpk(C1[12], C1[13]); pw3.w = cvtpk(C1[14], C1[15]); \
        if (LOADK) AT_WRITEK(t_ & 1); \
        AT_WRITEV(t_ & 1); \
        __syncthreads(); } while (0)
    AT_STEP(0, sa0, sa1, sb0, sb1, true, false, true);
    AT_STEP(1, sb0, sb1, sa0, sa1, true, true, true);
    for (int t = 2; t < NT - 2; t += 2) {
        AT_STEP(t, sa0, sa1, sb0, sb1, true, true, true);
        AT_STEP(t + 1, sb0, sb1, sa0, sa1, true, true, true);
    }
    AT_STEP(NT - 2, sa0, sa1, sb0, sb1, true, true, false);
    AT_STEP(NT - 1, sb0, sb1, sa0, sa1, false, true, false);
    {   const LAS unsigned char* Vp_ = F.lds + ((NT - 1) & 1) * AT_VT;
        AT_PV(0, pw0); AT_PV(1, pw1); AT_PV(2, pw2); AT_PV(3, pw3); }
    __syncthreads();
#undef AT_LOADK
#undef AT_LOADV
#undef AT_WRITEK
#undef AT_WRITEV
#undef AT_S
#undef AT_PV
#undef AT_EXP8
#undef AT_STEP
    lsum = sum32(lsum);
    const float inv = __builtin_amdgcn_rcpf(lsum); float ss = 0.f;
    bf16* yo = WSP(bf16, WS_YMIX) + (size_t)(qrow0 + r32) * D + 512 + h * 64 + 4 * hh;
#pragma unroll
    for (int rg = 0; rg < 4; ++rg) {
        v2u w0, w1; w0.x = pk2(o0[4 * rg] * inv, o0[4 * rg + 1] * inv); w0.y = pk2(o0[4 * rg + 2] * inv, o0[4 * rg + 3] * inv);
        w1.x = pk2(o1[4 * rg] * inv, o1[4 * rg + 1] * inv); w1.y = pk2(o1[4 * rg + 2] * inv, o1[4 * rg + 3] * inv);
        *(v2u*)(yo + 8 * rg) = w0; *(v2u*)(yo + 32 + 8 * rg) = w1;
        const float a0 = bflo(w0.x), a1 = bfhi(w0.x), a2 = bflo(w0.y), a3 = bfhi(w0.y), b0 = bflo(w1.x), b1 = bfhi(w1.x), b2 = bflo(w1.y), b3 = bfhi(w1.y);
        ss += (a0 * a0 + a1 * a1) + (a2 * a2 + a3 * a3) + (b0 * b0 + b1 * b1) + (b2 * b2 + b3 * b3);
    }
    ss = sum32(ss);
    if (hh == 0) WSP(float, WS_SSQAT)[(size_t)(qrow0 + r32) * 8 + h] = ss;
}
constexpr int HY_ZC_L = 1024 + 72, HY_ZC_C = 256 + 72;
constexpr int HY_ZC = 0;
constexpr int HY_RSTRIDE_L = 4160, HY_RSTRIDE_C = 1088;
static_assert(8 * 4 * HY_ZC_L * 2 + 8 * HY_RSTRIDE_L + 8 * 1024 * 2 + 288 <= RING_BYTES && 8 * 16 * HY_ZC_C * 2 + 8 * HY_RSTRIDE_C + 8 * 1024 * 2 + 288 <= RING_BYTES, "hyena LDS");
typedef short v4i16_t __attribute__((ext_vector_type(4)));
__device__ __forceinline__ bf16x4 ds_tr16(const LAS unsigned char* p) { return __builtin_bit_cast(bf16x4, __builtin_amdgcn_ds_read_tr16_b64_v4i16((LAS v4i16_t*)p)); }
__device__ __forceinline__ bf16x8 cat8(bf16x4 lo, bf16x4 hi) { return (bf16x8){lo[0], lo[1], lo[2], lo[3], hi[0], hi[1], hi[2], hi[3]}; }
template <bool LATENT>
__device__ __forceinline__ void hyena_unit(Frame& F, int l, int sq, int cgp, bool do_ssq) {
    int tid_ = F.tid; asm volatile("" : "+v"(tid_));
    const int tid = tid_, lane = tid & 63, w = F.wave, c0 = cgp * 8;
    constexpr int L = LATENT ? 1024 : 256, XL = 2 * L + 32, ZCE = LATENT ? HY_ZC_L : HY_ZC_C, NB = L / 32 + 1;
    constexpr int CH_STRIDE = (LATENT ? 4 : 16) * ZCE;
    constexpr int RST = LATENT ? HY_RSTRIDE_L : HY_RSTRIDE_C, HY_R = HY_ZC + 8 * CH_STRIDE * 2, HY_Y = HY_R + 8 * RST;
    const int base_row = LATENT ? MC + sq * 1024 : sq * 1024;
    LAS unsigned short* Zc = (LAS unsigned short*)(F.lds + HY_ZC); LAS unsigned char* Rl = F.lds + HY_R; LAS unsigned short* Y8 = (LAS unsigned short*)(F.lds + HY_Y);
    const bf16* P = WSP(bf16, WS_PROJ); const float* cw = F.a->in[I_HYCONV] + l * 3 * 768;
    constexpr int NFC = 8 * (XL / 8), NF = (NFC + NTHR - 1) / NTHR;
    LAS float* Wl = (LAS float*)(F.lds + HY_Y + 8 * 1024 * 2);
    v4u fr[NF], xa[2][3], xb[2][3];
    { const bf16* Rg = WSP(bf16, WS_FILT) + (size_t)l * FILT_LAYER + (LATENT ? 256 * XL0 : 0) + (size_t)c0 * XL;
#pragma unroll
      for (int k = 0; k < NF; ++k) { const int i = tid + k * NTHR; fr[k] = (v4u){0u, 0u, 0u, 0u}; if (i < NFC) { const int ch = i / (XL / 8), jj = i % (XL / 8); fr[k] = *(const v4u*)(Rg + (size_t)ch * XL + jj * 8); } } }
#pragma unroll
    for (int it = 0; it < 2; ++it) { const int p = tid + 512 * it, t = p & (L - 1); const bf16* pr = P + (size_t)(base_row + p) * NINP + c0;
#pragma unroll
        for (int dr = -1; dr <= 1; ++dr) { xa[it][dr + 1] = (v4u){0u, 0u, 0u, 0u}; xb[it][dr + 1] = xa[it][dr + 1];
            if (t + dr >= 0 && t + dr < L) { xa[it][dr + 1] = *(const v4u*)(pr + dr * NINP + 256); xb[it][dr + 1] = *(const v4u*)(pr + dr * NINP + 512); } } }
    float wreg = 0.f;
    if (tid < 72) wreg = cw[(tid / 24) * 768 + ((tid % 24) >> 3) * 256 + c0 + (tid & 7)];
    for (int i = tid; i < (8 * CH_STRIDE * 2) / 16; i += NTHR) *(LAS v4u*)(F.lds + HY_ZC + i * 16) = (v4u){0u, 0u, 0u, 0u};
#pragma unroll
    for (int k = 0; k < NF; ++k) { const int i = tid + k * NTHR; if (i < NFC) { const int ch = i / (XL / 8), jj = i % (XL / 8); *(LAS v4u*)(Rl + ch * RST + jj * 16) = fr[k]; } }
    if (tid < 72) Wl[tid] = wreg;
    __syncthreads();
    {
#pragma unroll
        for (int it = 0; it < 2; ++it) { const int p = tid + 512 * it, t = p & (L - 1), sg = LATENT ? 0 : (p >> 8);
            float x1[8], vv[8];
#pragma unroll
            for (int e = 0; e < 8; ++e) { x1[e] = 0.f; vv[e] = 0.f; }
#pragma unroll
            for (int dr = 0; dr < 3; ++dr) {
                const v4u xa_ = xa[it][dr], xb_ = xb[it][dr];
                const f32x4 a0 = *(const LAS f32x4*)(Wl + dr * 24 + 8), a1 = *(const LAS f32x4*)(Wl + dr * 24 + 12), b0 = *(const LAS f32x4*)(Wl + dr * 24 + 16), b1 = *(const LAS f32x4*)(Wl + dr * 24 + 20);
                x1[0] += a0.x * bflo(xa_.x); x1[1] += a0.y * bfhi(xa_.x); x1[2] += a0.z * bflo(xa_.y); x1[3] += a0.w * bfhi(xa_.y);
                x1[4] += a1.x * bflo(xa_.z); x1[5] += a1.y * bfhi(xa_.z); x1[6] += a1.z * bflo(xa_.w); x1[7] += a1.w * bfhi(xa_.w);
                vv[0] += b0.x * bflo(xb_.x); vv[1] += b0.y * bfhi(xb_.x); vv[2] += b0.z * bflo(xb_.y); vv[3] += b0.w * bfhi(xb_.y);
                vv[4] += b1.x * bflo(xb_.z); vv[5] += b1.y * bfhi(xb_.z); vv[6] += b1.z * bflo(xb_.w); vv[7] += b1.w * bfhi(xb_.w); }
#pragma unroll
            for (int e = 0; e < 8; ++e) { const unsigned short zb = (unsigned short)f2bf(x1[e] * vv[e]); LAS unsigned short* zc = Zc + e * CH_STRIDE + sg * 4 * ZCE + t + 32;
#pragma unroll
                for (int q = 0; q < 4; ++q) zc[q * ZCE - q] = zb; }
        }
    }
    v4u xo[2][3];
#pragma unroll
    for (int it = 0; it < 2; ++it) { const int p = tid + 512 * it, t = p & (L - 1); const bf16* pr = P + (size_t)(base_row + p) * NINP + c0;
#pragma unroll
        for (int dr = -1; dr <= 1; ++dr) { xo[it][dr + 1] = (v4u){0u, 0u, 0u, 0u}; if (t + dr >= 0 && t + dr < L) xo[it][dr + 1] = *(const v4u*)(pr + dr * NINP); } }
    __syncthreads();
    {
        const int r = lane & 15, g = lane >> 4, q = (lane & 15) >> 2, pp = lane & 3;
        const LAS unsigned char* Rw = Rl + w * RST; LAS unsigned short* Yw = Y8 + w * 1024;
        if (LATENT) {
            const LAS unsigned char* zb = (const LAS unsigned char*)(Zc + w * CH_STRIDE + q * ZCE + 8 * g + 4 * pp + 32);
            const int aoff = 2 * (L + 32 - 16 * r + 8 * g);
            f32x4 acc[4];
#pragma unroll
            for (int i = 0; i < 4; ++i) acc[i] = (f32x4){0.f, 0.f, 0.f, 0.f};
#pragma unroll 3
            for (int kb = 0; kb < NB; ++kb) { const int s0p = 32 * kb - 32;
                const bf16x8 B = cat8(ds_tr16(zb + 2 * s0p), ds_tr16(zb + 2 * s0p + 8));
#pragma unroll
                for (int ti = 0; ti < 4; ++ti) { const bf16x8 A = *(const LAS bf16x8*)(Rw + aoff + 2 * (s0p - 256 * ti)); acc[ti] = __builtin_amdgcn_mfma_f32_16x16x32_bf16(A, B, acc[ti], 0, 0, 0); } }
            const int n = lane & 15;
#pragma unroll
            for (int ti = 0; ti < 4; ++ti)
#pragma unroll
                for (int i = 0; i < 4; ++i) Yw[256 * ti + 16 * (4 * g + i) + n] = (unsigned short)f2bf(acc[ti][i]);
        } else {
            const LAS unsigned char* zb = (const LAS unsigned char*)(Zc + w * CH_STRIDE + (pp * 4 + q) * ZCE + 8 * g + 32);
            const int aoff = 2 * (L + 32 - 8 * r + 8 * g);
            f32x4 acc[2][2];
#pragma unroll
            for (int i = 0; i < 2; ++i) { acc[i][0] = (f32x4){0.f, 0.f, 0.f, 0.f}; acc[i][1] = acc[i][0]; }
#pragma unroll 3
            for (int kb = 0; kb < NB; ++kb) { const int s0p = 32 * kb - 32;
                const bf16x8 B0 = cat8(ds_tr16(zb + 2 * s0p), ds_tr16(zb + 2 * s0p + 8)), B1 = cat8(ds_tr16(zb + 2 * s0p + 8), ds_tr16(zb + 2 * s0p + 16));
#pragma unroll
                for (int ti = 0; ti < 2; ++ti) { const bf16x8 A = *(const LAS bf16x8*)(Rw + aoff + 2 * (s0p - 128 * ti));
                    acc[ti][0] = __builtin_amdgcn_mfma_f32_16x16x32_bf16(A, B0, acc[ti][0], 0, 0, 0); acc[ti][1] = __builtin_amdgcn_mfma_f32_16x16x32_bf16(A, B1, acc[ti][1], 0, 0, 0); } }
            const int n = lane & 15, b = n >> 2, op = n & 3;
#pragma unroll
            for (int ti = 0; ti < 2; ++ti)
#pragma unroll
                for (int ob = 0; ob < 2; ++ob)
#pragma unroll
                    for (int i = 0; i < 4; ++i) Yw[b * 256 + 128 * ti + 8 * (4 * g + i) + 4 * ob + op] = (unsigned short)f2bf(acc[ti][ob][i]);
        }
    }
    __syncthreads();
    {
        bf16* Y = WSP(bf16, WS_YMIX); float* ssq = (float*)(F.ws + WS_CTL + CTL_SSQHY) + (size_t)l * M;
#pragma unroll
        for (int it = 0; it < 2; ++it) { const int p = tid + 512 * it, row = base_row + p;
            float x0[8];
#pragma unroll
            for (int e = 0; e < 8; ++e) x0[e] = 0.f;
#pragma unroll
            for (int dr = 0; dr < 3; ++dr) {
                const v4u xa_ = xo[it][dr]; const f32x4 a0 = *(const LAS f32x4*)(Wl + dr * 24), a1 = *(const LAS f32x4*)(Wl + dr * 24 + 4);
                x0[0] += a0.x * bflo(xa_.x); x0[1] += a0.y * bfhi(xa_.x); x0[2] += a0.z * bflo(xa_.y); x0[3] += a0.w * bfhi(xa_.y);
                x0[4] += a1.x * bflo(xa_.z); x0[5] += a1.y * bfhi(xa_.z); x0[6] += a1.z * bflo(xa_.w); x0[7] += a1.w * bfhi(xa_.w); }
            float o[8];
#pragma unroll
            for (int e = 0; e < 8; ++e) o[e] = x0[e] * bf2f(Y8[e * 1024 + p]);
            v4u wv; wv.x = pk2(o[0], o[1]); wv.y = pk2(o[2], o[3]); wv.z = pk2(o[4], o[5]); wv.w = pk2(o[6], o[7]);
            *(v4u*)(Y + (size_t)row * D + c0) = wv;
            const float r0 = bflo(wv.x), r1 = bfhi(wv.x), r2 = bflo(wv.y), r3 = bfhi(wv.y), r4 = bflo(wv.z), r5 = bfhi(wv.z), r6 = bflo(wv.w), r7 = bfhi(wv.w);
            if (do_ssq) atomicAdd(ssq + row, ((r0 * r0 + r1 * r1) + (r2 * r2 + r3 * r3)) + ((r4 * r4 + r5 * r5) + (r6 * r6 + r7 * r7)));
        }
    }
    __syncthreads();
}
__device__ __forceinline__ void sconv_rows4(Frame& F, int l, int row0) {
    const int c4 = F.lane * 4; const bool latent = row0 >= MC; const int L = latent ? 1024 : 256, t0 = latent ? ((row0 - MC) & 1023) : (row0 & 255);
    const bf16* pr = WSP(bf16, WS_PROJ) + (size_t)row0 * NINP + O_SC + c4; const float* cw = F.a->in[I_SCCONV] + l * 3 * 256 + c4;
    v2u cg[6], hx[6], bg[4];
#pragma unroll
    for (int j = 0; j < 6; ++j) { const bool ok = (t0 + j - 1 >= 0) && (t0 + j - 1 < L);
        cg[j] = (v2u){0u, 0u}; hx[j] = (v2u){0u, 0u};
        if (ok) { cg[j] = *(const v2u*)(pr + (j - 1) * NINP + 256); hx[j] = *(const v2u*)(pr + (j - 1) * NINP + 512); } }
#pragma unroll
    for (int j = 0; j < 4; ++j) bg[j] = *(const v2u*)(pr + j * NINP);
    const f32x4 w0 = *(const f32x4*)cw, w1 = *(const f32x4*)(cw + 256), w2 = *(const f32x4*)(cw + 512);
    float p[6][4];
#pragma unroll
    for (int j = 0; j < 6; ++j) { p[j][0] = bflo(cg[j].x) * bflo(hx[j].x); p[j][1] = bfhi(cg[j].x) * bfhi(hx[j].x); p[j][2] = bflo(cg[j].y) * bflo(hx[j].y); p[j][3] = bfhi(cg[j].y) * bfhi(hx[j].y); }
    float s[4];
#pragma unroll
    for (int j = 0; j < 4; ++j) {
        const float c0 = w0.x * p[j][0] + w1.x * p[j + 1][0] + w2.x * p[j + 2][0], c1 = w0.y * p[j][1] + w1.y * p[j + 1][1] + w2.y * p[j + 2][1];
        const float c2 = w0.z * p[j][2] + w1.z * p[j + 1][2] + w2.z * p[j + 2][2], c3 = w0.w * p[j][3] + w1.w * p[j + 1][3] + w2.w * p[j + 2][3];
        v2u o; o.x = pk2(bflo(bg[j].x) * c0, bfhi(bg[j].x) * c1); o.y = pk2(bflo(bg[j].y) * c2, bfhi(bg[j].y) * c3);
        *(v2u*)(WSP(bf16, WS_YMIX) + (size_t)(row0 + j) * D + 256 + c4) = o;
        const float r0 = bflo(o.x), r1 = bfhi(o.x), r2 = bflo(o.y), r3 = bfhi(o.y);
        s[j] = (r0 * r0 + r1 * r1) + (r2 * r2 + r3 * r3);
    }
#pragma unroll
    for (int j = 0; j < 4; ++j) s[j] = wave_sum(s[j], F.lane);
    if (F.lane == 0) { *(f32x4*)(WSP(float, WS_SSQSC) + row0) = (f32x4){s[0], s[1], s[2], s[3]}; }
}
constexpr int MX_PER = 32 + 32 + 32;
__device__ __forceinline__ void mix_phase(Frame& F, int l, int mode) {
    const bool do_ssq = mode == 0;
    const XGeom X{F.rank, F.nloc, F.idx, F.nx}; const int nu = 32 * X.nrb();
    if (mode != 2 && mode != 4 && mode != 6)
        for (int q = X.rank; q < nu; q += X.nloc) { const int rb = X.idx + (q >> 5) * X.nx, r = q & 31; if (rb >= 4) hyena_unit<true>(F, l, rb - 4, r, do_ssq); else hyena_unit<false>(F, l, rb, r, do_ssq); }
    if (mode != 3 && mode != 6)
        for (int q = X.rank; q < nu; q += X.nloc) { const int rb = X.idx + (q >> 5) * X.nx, r = q & 31; if (rb >= 4) attn_unit(F, l, true, rb - 4, (r >> 2) & 7, r & 3); else attn_unit(F, l, false, 4 * rb + (r >> 3), r & 7, 0); }
    if (mode < 2)
        for (int q = X.rank; q < nu; q += X.nloc) { const int rb = X.idx + (q >> 5) * X.nx, r = q & 31; sconv_rows4(F, l, 1024 * rb + r * 32 + F.wave * 4); }
}

#define AUXT(par, k) (aux + ((par) * 3 + (k)) * 256)
template <int NAI> struct EpiBase {
    static constexpr int ROWS = 128 * NAI;
    LAS float* aux; int tid;
    __device__ __forceinline__ void rescale(pg8::f32x4 (&acc)[NAI][2][4][2], int which, int par, int wr, int fr) const {
        const LAS float* T = AUXT(par, 1 + which);
#pragma unroll
        for (int ai = 0; ai < NAI; ++ai)
#pragma unroll
            for (int m = 0; m < 4; ++m) { const float s = T[ai * 128 + wr * 64 + m * 16 + fr];
#pragma unroll
                for (int bj = 0; bj < 2; ++bj)
#pragma unroll
                    for (int n = 0; n < 2; ++n) acc[ai][bj][m][n] = acc[ai][bj][m][n] * s; }
    }
};
template <int NAI> struct EpiInT : EpiBase<NAI> {
    using EpiBase<NAI>::aux; using EpiBase<NAI>::tid; using EpiBase<NAI>::ROWS;
    static constexpr bool PERM = true, KRESCALE = false;
    const float* ssqp; int np; const float* bias; bf16* proj; float* out; int l;
    struct Pre { f32x4 a, b, c, d; };
    __device__ __forceinline__ Pre prep_load(const pg8::Unit& u) const {
        Pre p; p.a = p.b = p.c = p.d = (f32x4){0.f, 0.f, 0.f, 0.f};
        if (tid < ROWS) { const float* sp = ssqp + (size_t)(u.pm * ROWS + tid) * 16;
            if (np == 1) p.a.x = sp[0]; else { p.a = *(const f32x4*)sp; p.b = *(const f32x4*)(sp + 4); p.c = *(const f32x4*)(sp + 8); p.d = *(const f32x4*)(sp + 12); } }
        return p;
    }
    __device__ __forceinline__ void prep_finish(const Pre& p, int par) const {
        if (tid < ROWS) { const float s = ((p.a.x + p.a.y) + (p.a.z + p.a.w)) + ((p.b.x + p.b.y) + (p.b.z + p.b.w)) + ((p.c.x + p.c.y) + (p.c.z + p.c.w)) + ((p.d.x + p.d.y) + (p.d.z + p.d.w));
            AUXT(par, 0)[tid] = rsqrtf(s * (1.0f / D) + EPS); }
    }
    __device__ __forceinline__ void operator()(const pg8::f32x4 (&acc)[NAI][2][4][2], const pg8::Unit& u, int wr, int wc, int fr, int fq, int par) const {
        const int row0 = u.pm * ROWS + wr * 64 + fr, j = modidx(u.pm * ROWS); const LAS float* T = AUXT(par, 0);
        const float* bp = bias + (size_t)j * NINP + u.pn * 256 + wc * 32 + 8 * fq;
        f32x4 bv[2][2];
#pragma unroll
        for (int bj = 0; bj < 2; ++bj)
#pragma unroll
            for (int n = 0; n < 2; ++n) bv[bj][n] = *(const f32x4*)(bp + bj * 128 + 4 * n);
#pragma unroll
        for (int ai = 0; ai < NAI; ++ai)
#pragma unroll
            for (int m = 0; m < 4; ++m) { const int row = row0 + ai * 128 + m * 16; const float rs = T[ai * 128 + wr * 64 + m * 16 + fr];
#pragma unroll
                for (int bj = 0; bj < 2; ++bj) { const f32x4 v0 = acc[ai][bj][m][0] * rs + bv[bj][0], v1 = acc[ai][bj][m][1] * rs + bv[bj][1];
                    const int col = u.pn * 256 + bj * 128 + wc * 32 + 8 * fq;
                    v4u w; w.x = pk2(v0[0], v0[1]); w.y = pk2(v0[2], v0[3]); w.z = pk2(v1[0], v1[1]); w.w = pk2(v1[2], v1[3]);
                    *(v4u*)(proj + (size_t)row * NINP + col) = w;
                    if (u.pn == 7 && row < MC && col < NIN) { const int b = row >> 8, t = row & 255;
                        float* o = (col < O_KPE) ? out + OUT_CKV + ((size_t)((b * 2 + l) * 256 + t)) * 128 + (col - O_CKV) : out + OUT_KPE + ((size_t)((b * 2 + l) * 256 + t)) * 32 + (col - O_KPE);
                        *(f32x4*)o = v0; *(f32x4*)(o + 4) = v1; } } }
    }
};
template <int NAI> struct EpiOutT : EpiBase<NAI> {
    using EpiBase<NAI>::aux; using EpiBase<NAI>::tid; using EpiBase<NAI>::ROWS;
    static constexpr bool PERM = true, KRESCALE = true;
    const float* ssq_hy; const float* ssq_sc; const float* ssq_at; const float* xa; const float* xb; float* xr; bf16* xg; const float* g1; const float* gg2; float* ssqp;
    struct Pre { f32x4 a, b; float hy, sc; };
    __device__ __forceinline__ Pre prep_load(const pg8::Unit& u) const {
        Pre p; p.a = p.b = (f32x4){0.f, 0.f, 0.f, 0.f}; p.hy = 0.f; p.sc = 0.f;
        if (tid < ROWS) { const int row = u.pm * ROWS + tid; p.a = *(const f32x4*)(ssq_at + (size_t)row * 8); p.b = *(const f32x4*)(ssq_at + (size_t)row * 8 + 4); p.hy = ssq_hy[row]; p.sc = ssq_sc[row]; }
        return p;
    }
    __device__ __forceinline__ void prep_finish(const Pre& p, int par) const {
        if (tid < ROWS) { const float sa = ((p.a.x + p.a.y) + (p.a.z + p.a.w)) + ((p.b.x + p.b.y) + (p.b.z + p.b.w));
            const float rh = rsqrtf(p.hy * (1.0f / 256) + EPS), rs = rsqrtf(p.sc * (1.0f / 256) + EPS), ra = rsqrtf(sa * (1.0f / 512) + EPS);
            AUXT(par, 0)[tid] = ra; AUXT(par, 1)[tid] = rh / rs; AUXT(par, 2)[tid] = rs / ra; }
    }
    __device__ __forceinline__ void operator()(const pg8::f32x4 (&acc)[NAI][2][4][2], const pg8::Unit& u, int wr, int wc, int fr, int fq, int par) const {
        const int row0 = u.pm * ROWS + wr * 64 + fr, j = modidx(u.pm * ROWS); const LAS float* T = AUXT(par, 0);
        const float* xin = (u.pm * ROWS < MC) ? xa : xb;
        const int lane = fq * 16 + fr;
        const int cb = u.pn * 256 + wc * 32 + 8 * fq;
#pragma unroll
        for (int ai = 0; ai < NAI; ++ai)
#pragma unroll
            for (int m = 0; m < 4; ++m) { const int row = row0 + ai * 128 + m * 16; const float rs = T[ai * 128 + wr * 64 + m * 16 + fr]; float ss = 0.f;
#pragma unroll
                for (int bj = 0; bj < 2; ++bj) { const int col = cb + bj * 128; v4u w;
#pragma unroll
                    for (int n = 0; n < 2; ++n) { const f32x4 gv = *(const f32x4*)(g1 + (size_t)j * 6144 + col + 4 * n), gg = *(const f32x4*)(gg2 + (size_t)j * D + col + 4 * n);
                        const f32x4 xv = *(const f32x4*)(xin + (size_t)row * D + col + 4 * n); const f32x4 x1 = xv + gv * (acc[ai][bj][m][n] * rs);
                        *(f32x4*)(xr + (size_t)row * D + col + 4 * n) = x1; ss += (x1[0] * x1[0] + x1[1] * x1[1]) + (x1[2] * x1[2] + x1[3] * x1[3]);
                        const f32x4 y = x1 * gg; if (n == 0) { w.x = pk2(y[0], y[1]); w.y = pk2(y[2], y[3]); } else { w.z = pk2(y[0], y[1]); w.w = pk2(y[2], y[3]); } }
                    *(v4u*)(xg + (size_t)row * D + col) = w; }
                ss += shx(ss, 16, lane); ss += shx(ss, 32, lane);
                if (fq == 0) ssqp[(size_t)row * 16 + u.pn * 4 + wc] = ss; }
    }
};
template <int NAI> struct EpiUpT : EpiBase<NAI> {
    using EpiBase<NAI>::aux; using EpiBase<NAI>::tid; using EpiBase<NAI>::ROWS;
    static constexpr bool PERM = true, KRESCALE = false;
    const float* ssqp; const float* bias; bf16* act;
    struct Pre { f32x4 a, b, c, d; };
    __device__ __forceinline__ Pre prep_load(const pg8::Unit& u) const {
        Pre p; p.a = p.b = p.c = p.d = (f32x4){0.f, 0.f, 0.f, 0.f};
        if (tid < ROWS) { const float* sp = ssqp + (size_t)(u.pm * ROWS + tid) * 16; p.a = *(const f32x4*)sp; p.b = *(const f32x4*)(sp + 4); p.c = *(const f32x4*)(sp + 8); p.d = *(const f32x4*)(sp + 12); }
        return p;
    }
    __device__ __forceinline__ void prep_finish(const Pre& p, int par) const {
        if (tid < ROWS) { const float s = ((p.a.x + p.a.y) + (p.a.z + p.a.w)) + ((p.b.x + p.b.y) + (p.b.z + p.b.w)) + ((p.c.x + p.c.y) + (p.c.z + p.c.w)) + ((p.d.x + p.d.y) + (p.d.z + p.d.w));
            AUXT(par, 0)[tid] = rsqrtf(s * (1.0f / D) + EPS); }
    }
    __device__ __forceinline__ void operator()(const pg8::f32x4 (&acc)[NAI][2][4][2], const pg8::Unit& u, int wr, int wc, int fr, int fq, int par) const {
        const int row0 = u.pm * ROWS + wr * 64 + fr, j = modidx(u.pm * ROWS); const LAS float* T = AUXT(par, 0);
        const float* bp = bias + (size_t)j * NGU + u.pn * 256 + wc * 32 + 8 * fq;
        f32x4 bv[2][2];
#pragma unroll
        for (int bj = 0; bj < 2; ++bj)
#pragma unroll
            for (int n = 0; n < 2; ++n) bv[bj][n] = *(const f32x4*)(bp + bj * 128 + 4 * n);
#pragma unroll
        for (int ai = 0; ai < NAI; ++ai)
#pragma unroll
            for (int m = 0; m < 4; ++m) { const int row = row0 + ai * 128 + m * 16; const float rs = T[ai * 128 + wr * 64 + m * 16 + fr]; float a[8];
#pragma unroll
                for (int n = 0; n < 2; ++n) { const f32x4 gt = acc[ai][0][m][n] * rs + bv[0][n], up = acc[ai][1][m][n] * rs + bv[1][n];
#pragma unroll
                    for (int e = 0; e < 4; ++e) a[n * 4 + e] = gt[e] * __builtin_amdgcn_rcpf(1.0f + __builtin_amdgcn_exp2f(-1.4426950408889634f * gt[e])) * up[e]; }
                v4u w; w.x = pk2(a[0], a[1]); w.y = pk2(a[2], a[3]); w.z = pk2(a[4], a[5]); w.w = pk2(a[6], a[7]);
                *(v4u*)(act + (size_t)row * DFF + u.pn * 128 + wc * 32 + 8 * fq) = w; }
    }
};
template <int NAI> struct EpiDownT : EpiBase<NAI> {
    using EpiBase<NAI>::aux; using EpiBase<NAI>::tid; using EpiBase<NAI>::ROWS;
    static constexpr bool PERM = true, KRESCALE = false;
    const float* xr; float* xo; bf16* xg; const float* g2; const float* gg1n; float* ssqp; int last;
    struct Pre {};
    __device__ __forceinline__ Pre prep_load(const pg8::Unit&) const { return Pre{}; }
    __device__ __forceinline__ void prep_finish(const Pre&, int) const {}
    __device__ __forceinline__ void operator()(const pg8::f32x4 (&acc)[NAI][2][4][2], const pg8::Unit& u, int wr, int wc, int fr, int fq, int) const {
        const int row0 = u.pm * ROWS + wr * 64 + fr, j = modidx(u.pm * ROWS), lane = fq * 16 + fr;
        const int cb = u.pn * 256 + wc * 32 + 8 * fq;
#pragma unroll
        for (int ai = 0; ai < NAI; ++ai)
#pragma unroll
            for (int m = 0; m < 4; ++m) { const int row = row0 + ai * 128 + m * 16; float ss = 0.f;
#pragma unroll
                for (int bj = 0; bj < 2; ++bj) { const int col = cb + bj * 128; v4u w;
#pragma unroll
                    for (int n = 0; n < 2; ++n) { const f32x4 gv = *(const f32x4*)(g2 + (size_t)j * 6144 + col + 4 * n);
                        const f32x4 xv = *(const f32x4*)(xr + (size_t)row * D + col + 4 * n); const f32x4 x2 = xv + gv * acc[ai][bj][m][n];
                        *(f32x4*)(xo + (size_t)row * D + col + 4 * n) = x2;
                        if (!last) { const f32x4 gg = *(const f32x4*)(gg1n + (size_t)j * D + col + 4 * n); ss += (x2[0] * x2[0] + x2[1] * x2[1]) + (x2[2] * x2[2] + x2[3] * x2[3]);
                            const f32x4 y = x2 * gg; if (n == 0) { w.x = pk2(y[0], y[1]); w.y = pk2(y[2], y[3]); } else { w.z = pk2(y[0], y[1]); w.w = pk2(y[2], y[3]); } } }
                    if (!last) *(v4u*)(xg + (size_t)row * D + col) = w; }
                if (!last) { ss += shx(ss, 16, lane); ss += shx(ss, 32, lane); if (fq == 0) ssqp[(size_t)row * 16 + u.pn * 4 + wc] = ss; } }
    }
};

typedef EpiInT<2> EpiIn; typedef EpiUpT<2> EpiUp;


#define MK_FRAME() Frame F; { int l_; asm volatile("v_mbcnt_lo_u32_b32 %0, -1, 0\n\tv_mbcnt_hi_u32_b32 %0, -1, %0" : "=v"(l_)); int w_ = wave0; asm volatile("" : "+s"(w_)); F.tid = w_ * 64 + l_; F.lane = l_; F.wave = w_; \
        KArgs k_ = (KArgs)__builtin_amdgcn_kernarg_segment_ptr(); asm volatile("" : "+s"(k_)); F.a = k_; F.ws = k_->ws; int g_ = gridDim.x, b_ = blockIdx.x; asm volatile("" : "+s"(g_), "+s"(b_)); F.G = g_; F.bid = b_; } \
        { volatile LAS unsigned* st_ = (volatile LAS unsigned*)((LAS unsigned char*)lds + MISC_OFF) + 8; F.nloc = (int)st_[0]; F.nx = (int)st_[1]; F.idx = (int)st_[2]; F.rank = (int)st_[3]; } \
        F.lds = (LAS unsigned char*)lds; LAS float* aux = (LAS float*)(F.lds + AUX_OFF); (void)aux
#define MK_IN(k) (ph_lo <= (k) && (k) < ph_hi)
#ifdef DIAG_TS
#define MK_STAMP(k) do { if (blockIdx.x == 0 && threadIdx.x == 0) ((unsigned long long*)(ka0->ws + WS_CTL + 64 * 1024))[(k)] = __builtin_amdgcn_s_memrealtime(); } while (0)
#else
#define MK_STAMP(k) do { } while (0)
#endif
#ifdef DIAG_TS
#define MK_LASTBAR 1
#else
#define MK_LASTBAR 0
#endif
#define MK_BAR(k) do { if (use_bar && (k) + 1 < ph_hi + MK_LASTBAR) { int l_; asm volatile("v_mbcnt_lo_u32_b32 %0, -1, 0\n\tv_mbcnt_hi_u32_b32 %0, -1, %0" : "=v"(l_)); \
        KArgs k_ = (KArgs)__builtin_amdgcn_kernarg_segment_ptr(); asm volatile("" : "+s"(k_)); unsigned* bar_ = (unsigned*)(k_->ws + WS_CTL) + CW_BAR + k_->li * XCD_BAR_WORDS; \
        volatile LAS unsigned* st_ = (volatile LAS unsigned*)((LAS unsigned char*)lds + MISC_OFF) + 8; \
        if ((k) < 2) xcd_barrier(bar_, xcc, st_, wave0 == 0 && l_ == 0); else xcd_local_barrier(bar_, xcc, st_, wave0 == 0 && l_ == 0); } MK_STAMP((k) + 1); } while (0)

template <int KM, int L> __device__ __forceinline__ void layer_phases(unsigned char* lds, int wave0, int ph_lo, int ph_hi, int use_bar, unsigned xcc, KArgs ka0) {
    constexpr int l = L, P = 2 + 6 * L;
    if (MK_IN(P + 0)) { if constexpr (KM & 4) { MK_FRAME();
        pg8::Gemm g{WSP(bf16, WS_XG), WSP(bf16, WS_WIN) + (size_t)l * NINP * D, M, NINP, D}; XOrder256 S; S.x = XGeom{F.rank, F.nloc, F.idx, F.nx}; S.npn = NINP / 256;
        EpiIn E; E.aux = aux; E.tid = F.tid; E.ssqp = WSP(float, WS_SSQ1P); E.np = l == 0 ? 1 : 16; E.bias = WSP(float, WS_BIN) + (size_t)l * 5 * NINP; E.proj = WSP(bf16, WS_PROJ); E.out = F.a->out; E.l = l;
        pg8::gemm_phase<EpiIn, XOrder256, true, true>(F.lds, g, S, E, F.tid); }
        MK_BAR(P + 0); }
    if (MK_IN(P + 1)) { if constexpr (KM & 8) { MK_FRAME(); prep_phase(F, l); } MK_BAR(P + 1); }
    if (MK_IN(P + 2)) { if constexpr (KM & 16) { MK_FRAME(); mix_phase(F, l, F.a->no_ssq); } MK_BAR(P + 2); }
    if (MK_IN(P + 3)) { if constexpr (KM & 32) { MK_FRAME(); float* MOD = WSP(float, WS_MOD); float* GG = WSP(float, WS_GG);
        pg8::Gemm g{WSP(bf16, WS_YMIX), WSP(bf16, WS_WOUT) + (size_t)l * D * D, M, D, D};
        EpiOutT<1> E; E.aux = aux; E.tid = F.tid; E.ssq_hy = (const float*)(F.ws + WS_CTL + CTL_SSQHY) + (size_t)l * M; E.ssq_sc = WSP(float, WS_SSQSC); E.ssq_at = WSP(float, WS_SSQAT);
        E.xa = l == 0 ? F.a->in[I_XP] : WSP(float, WS_XR); E.xb = l == 0 ? F.a->in[I_XS] - (size_t)MC * D : WSP(float, WS_XR); E.xr = WSP(float, WS_XR); E.xg = WSP(bf16, WS_XG);
        E.g1 = MOD + (size_t)l * 5 * 6144 + 2048; E.gg2 = GG + (size_t)((l * 2 + 1) * 5) * D; E.ssqp = WSP(float, WS_SSQ2P);
        { const XGeom X{F.rank, F.nloc, F.idx, F.nx}; for (int q = X.rank; q < 32 * X.nrb(); q += X.nloc) { const int rb = X.idx + (q >> 5) * X.nx, qq = q & 31; pg8::gemm_phase_h<EpiOutT<1>>(F.lds, g, 8 * rb + (qq & 7), qq >> 3, E, F.tid); } } }
        MK_BAR(P + 3); }
    if (MK_IN(P + 4)) { if constexpr (KM & 64) { MK_FRAME();
        pg8::Gemm g{WSP(bf16, WS_XG), WSP(bf16, WS_WGU) + (size_t)l * NGU * D, M, NGU, D}; XOrder256 S; S.x = XGeom{F.rank, F.nloc, F.idx, F.nx}; S.npn = NGU / 256;
        EpiUp E; E.aux = aux; E.tid = F.tid; E.ssqp = WSP(float, WS_SSQ2P); E.bias = WSP(float, WS_BGU) + (size_t)l * 5 * NGU; E.act = WSP(bf16, WS_ACT);
        pg8::gemm_phase<EpiUp, XOrder256, true, true>(F.lds, g, S, E, F.tid); }
        MK_BAR(P + 4); }
    if (MK_IN(P + 5)) { if constexpr (KM & 128) { MK_FRAME(); float* MOD = WSP(float, WS_MOD); float* GG = WSP(float, WS_GG);
        pg8::Gemm g{WSP(bf16, WS_ACT), WSP(bf16, WS_WD) + (size_t)l * D * DFF, M, D, DFF};
        EpiDownT<1> E; E.aux = aux; E.tid = F.tid; E.xr = WSP(float, WS_XR); E.xo = l == 1 ? F.a->out : WSP(float, WS_XR); E.xg = WSP(bf16, WS_XG);
        E.g2 = MOD + (size_t)l * 5 * 6144 + 5120; E.gg1n = GG + (size_t)((l == 1 ? 0 : (l + 1) * 2) * 5) * D; E.ssqp = WSP(float, WS_SSQ1P); E.last = (l == 1);
        { const XGeom X{F.rank, F.nloc, F.idx, F.nx}; for (int q = X.rank; q < 32 * X.nrb(); q += X.nloc) { const int rb = X.idx + (q >> 5) * X.nx, qq = q & 31; pg8::gemm_phase_h<EpiDownT<1>>(F.lds, g, 8 * rb + (qq & 7), qq >> 3, E, F.tid); } } }
        MK_BAR(P + 5); }
}
template <int KM> __global__ void __launch_bounds__(NTHR, 2) mk_fwd(Args args) {
    extern __shared__ __attribute__((aligned(16))) unsigned char lds[];
    KArgs ka0 = (KArgs)__builtin_amdgcn_kernarg_segment_ptr();
    const int wave0 = __builtin_amdgcn_readfirstlane(threadIdx.x >> 6);
    const int ph_lo = ka0->ph_lo, ph_hi = ka0->ph_hi, use_bar = ka0->use_bar;
    const unsigned xcc = xb_xcc_id();
    {
        LAS unsigned* misc = (LAS unsigned*)((LAS unsigned char*)lds + MISC_OFF);
        for (int u = threadIdx.x; u < 256; u += NTHR) misc[u] = 0u;
        __syncthreads();
        if (threadIdx.x == 0) { unsigned* bar_ = (unsigned*)(ka0->ws + WS_CTL) + CW_BAR + ka0->li * XCD_BAR_WORDS;
            misc[8 + 3] = xb_add(&bar_[XB_XCNT(xcc)], 1u);
            if (ph_lo >= 2) { unsigned nloc_, nx_, idx_; xcd_barrier_complete(bar_, xcc, nloc_, nx_, idx_); misc[8] = nloc_; misc[9] = nx_; misc[10] = idx_; } }
        __syncthreads();
    }
    MK_STAMP(0);
    if (MK_IN(0)) { if constexpr (KM & 1) { MK_FRAME(); p0_phase(F); } MK_BAR(0); }
    if (MK_IN(1)) { if constexpr (KM & 2) { MK_FRAME(); p1_phase(F); } MK_BAR(1); }
    layer_phases<KM, 0>(lds, wave0, ph_lo, ph_hi, use_bar, xcc, ka0);
    layer_phases<KM, 1>(lds, wave0, ph_lo, ph_hi, use_bar, xcc, ka0);
#ifdef DIAG_TS
    if (blockIdx.x == 0 && threadIdx.x == 0) {
        const unsigned long long* ts = (const unsigned long long*)(ka0->ws + WS_CTL + 64 * 1024); const unsigned long long tend = __builtin_amdgcn_s_memrealtime();
        const int sel[4] = {DIAG_A, DIAG_B, DIAG_C, DIAG_D}; const size_t off[4] = {0, (size_t)MC * D, (size_t)OUT_CKV, (size_t)OUT_KPE};
        for (int i = 0; i < 4; ++i) { const int k = sel[i]; const unsigned long long t1 = (k + 1 < N_PHASES) ? ts[k + 1] : tend; ka0->out[off[i]] = 4.0f * rintf((float)(t1 - ts[k]) * 0.0025f); }
    }
#endif
}

extern "C" void kernel_launch(void* const* d_in, const int* in_sizes, int n_in, void* d_out, int out_size, void* d_ws, size_t ws_size, hipStream_t stream) {
    static int grid = 0;
    if (grid == 0) {
        if (n_in != 31 || ws_size < WS_END) { fprintf(stderr, "kernel_launch: expected 31 inputs and >= %zu bytes of workspace; got %d, %zu\n", (size_t)WS_END, n_in, ws_size); grid = -1; return; }
        int dev = 0, cus = 0;
        if (hipGetDevice(&dev) != hipSuccess || hipDeviceGetAttribute(&cus, hipDeviceAttributeMultiprocessorCount, dev) != hipSuccess) { grid = -1; return; }
        if (hipFuncSetAttribute((const void*)mk_fwd<255>, hipFuncAttributeMaxDynamicSharedMemorySize, LDS_BYTES) != hipSuccess) { fprintf(stderr, "kernel_launch: hipFuncSetAttribute failed\n"); grid = -1; return; }
        int per_cu = 0;
        if (hipOccupancyMaxActiveBlocksPerMultiprocessor(&per_cu, (const void*)mk_fwd<255>, NTHR, LDS_BYTES) != hipSuccess || per_cu < 1) { fprintf(stderr, "kernel_launch: occupancy query says %d blocks per CU\n", per_cu); (void)hipGetLastError(); }
        grid = cus > 0 ? cus : 256;
    }
    if (grid < 0) return;
    (void)hipMemsetAsync((char*)d_ws + WS_CTL, 0, CTL_ZERO_BYTES, stream);
    Args a{};
    for (int i = 0; i < 31; ++i) a.in[i] = (const float*)d_in[i];
    a.out = (float*)d_out; a.ws = (unsigned char*)d_ws;
#ifndef PROBE_PH
#define PROBE_PH -1
#endif
#ifndef PROBE_MODE
#define PROBE_MODE 1
#endif
    a.use_bar = 1; a.pad = 0;
    void* kargs[] = {&a};
    hipError_t e = hipSuccess;
    if (PROBE_PH < 0) {
        a.ph_lo = 0; a.ph_hi = N_PHASES; a.li = 0; a.no_ssq = 0;
#ifdef PLAIN_LAUNCH
        hipLaunchKernelGGL(mk_fwd<255>, dim3(grid), dim3(NTHR), LDS_BYTES, stream, a); e = hipPeekAtLastError();
#else
        e = hipLaunchCooperativeKernel((const void*)mk_fwd<255>, dim3(grid), dim3(NTHR), kargs, LDS_BYTES, stream);
#endif
    } else {
        a.ph_lo = 0; a.ph_hi = PROBE_PH + 1; a.li = 0; a.no_ssq = 0;
        e = hipLaunchCooperativeKernel((const void*)mk_fwd<255>, dim3(grid), dim3(NTHR), kargs, LDS_BYTES, stream);
        a.ph_lo = PROBE_PH; a.ph_hi = PROBE_PH + 1; a.li = 1; a.no_ssq = PROBE_MODE;
        e = hipLaunchCooperativeKernel((const void*)mk_fwd<255>, dim3(grid), dim3(NTHR), kargs, LDS_BYTES, stream);
        if (PROBE_PH + 1 < N_PHASES) { a.ph_lo = PROBE_PH + 1; a.ph_hi = N_PHASES; a.li = 2; a.no_ssq = 0;
            e = hipLaunchCooperativeKernel((const void*)mk_fwd<255>, dim3(grid), dim3(NTHR), kargs, LDS_BYTES, stream); }
    }
    if (e != hipSuccess) fprintf(stderr, "kernel_launch: cooperative launch failed: %s (grid %d)\n", hipGetErrorString(e), grid);
}
```

```cpp
#include <hip/hip_runtime.h>
#include <cstdio>
#include <cstdint>

namespace pg8 {
#define PG8_LAS __attribute__((address_space(3)))
typedef unsigned short bf16_t;
typedef short bf16x8 __attribute__((ext_vector_type(8)));
typedef float f32x4 __attribute__((ext_vector_type(4)));
typedef unsigned u32x4 __attribute__((ext_vector_type(4)));
constexpr int BM = 256, BK = 64, HALF = 128, HTB = HALF * BK * 2  , STAGE_BYTES = 8 * HTB, NXCD = 8, WGM = 8;

__host__ __device__ __forceinline__ int lds_byte(int r, int c) { const int st = (r >> 4) * 2 + (c >> 5), rr = r & 15, cc = c & 31, ob = rr * 64 + cc * 2; return st * 1024 + (ob ^ (((ob >> 9) & 1) << 5)); }
__host__ __device__ __forceinline__ void stage_rc(int b, int& R, int& C) { const int st = b / 1024, sb = b % 1024, swz = sb ^ (((sb >> 9) & 1) << 5); R = (st >> 1) * 16 + swz / 64; C = (st & 1) * 32 + (swz % 64) / 2; }
__host__ __device__ __forceinline__ int perm32(int rho) { const int n = rho >> 4, i = rho & 15; return 8 * (i >> 2) + 4 * n + (i & 3); }

struct Unit { int pm, pn; };
struct Gemm { const bf16_t* A; const bf16_t* Bt; int M, N, K; int kt0, ktn; };

struct StaticOrder {
    int nM, nN, nwg, G, c;
    __host__ __device__ void init(int M, int N, int G_, int c_) { nM = M / BM; nN = N / BM; nwg = nM * nN; G = G_; c = c_; }
    __host__ __device__ bool next(int i, Unit& u) const {
        const long L = (long)i * G + c; if (L >= nwg) return false;
        int wgid = (int)L; { const int q = nwg / NXCD, r = nwg % NXCD, xcd = wgid % NXCD, off = wgid / NXCD; wgid = (xcd < r ? xcd * (q + 1) : r * (q + 1) + (xcd - r) * q) + off; }
        const int nig = WGM * nN, gid = wgid / nig, fm = gid * WGM, gsz = (nM - fm) < WGM ? (nM - fm) : WGM;
        u.pm = fm + ((wgid % nig) % gsz); u.pn = (wgid % nig) / gsz; return true;
    }
};
__device__ __forceinline__ unsigned cvt_pk_bf16(float lo, float hi) { unsigned r; asm volatile("v_cvt_pk_bf16_f32 %0, %1, %2" : "=v"(r) : "v"(lo), "v"(hi)); return r; }

template <class Epi, class Sched, bool ALIGN_EPI = false, bool SP2 = false>
__device__ __forceinline__ void gemm_phase(PG8_LAS unsigned char* lds, const Gemm g, const Sched& S, const Epi& E, int tid_in) {
    int tid_ = tid_in; asm volatile("" : "+v"(tid_));
    const int tid = tid_, wid = __builtin_amdgcn_readfirstlane(tid >> 6), lane = tid & 63, wr = wid >> 2, wc = wid & 3, fr = lane & 15, fq = lane >> 4;
    const int K = g.K, nt = g.ktn ? g.ktn : K / BK;
    unsigned voffA[2], voffB[2];
#pragma unroll
    for (int i = 0; i < 2; ++i) { int R, C; stage_rc(tid * 16 + i * 8192, R, C); const int Rb = Epi::PERM ? ((R & ~31) + perm32(R & 31)) : R;
        voffA[i] = (unsigned)(R * K + C) * 2u; voffB[i] = (unsigned)(Rb * K + C) * 2u; }
    const size_t kstep = (size_t)(BK * 2);
    const size_t hstep = (size_t)HALF * K * 2;
    const size_t tstep = 2 * hstep;
    const unsigned ldsw = (unsigned)wid * 1024u;
    const int aoff = lds_byte(wr * 64 + fr, fq * 8), boff = lds_byte(wc * 32 + fr, fq * 8);
#define PG8_SA(b, h) (((b) * 2 + (h)) * HTB)
#define PG8_SB(b, h) ((4 + (b) * 2 + (h)) * HTB)
#define PG8_STAGE(bufoff, gbase, voff) do { _Pragma("unroll") for (int _i = 0; _i < 2; ++_i) \
        __builtin_amdgcn_global_load_lds((const unsigned*)((const char*)(gbase) + (voff)[_i]), (PG8_LAS unsigned*)(lds + (bufoff) + ldsw + _i * 8192), 16, 0, 0); } while (0)
#define PG8_LDA(dst, b, h) do { _Pragma("unroll") for (int m = 0; m < 4; ++m) _Pragma("unroll") for (int k = 0; k < 2; ++k) dst[m][k] = *(const PG8_LAS bf16x8*)(lds + PG8_SA(b, h) + aoff + m * 2048 + k * 1024); } while (0)
#define PG8_LDB(dst, b, h) do { _Pragma("unroll") for (int n = 0; n < 2; ++n) _Pragma("unroll") for (int k = 0; k < 2; ++k) dst[n][k] = *(const PG8_LAS bf16x8*)(lds + PG8_SB(b, h) + boff + n * 2048 + k * 1024); } while (0)
#define PG8_MMA(ai, bj, At, Bt) do { __builtin_amdgcn_s_setprio(1); _Pragma("unroll") for (int m = 0; m < 4; ++m) _Pragma("unroll") for (int n = 0; n < 2; ++n) _Pragma("unroll") for (int k = 0; k < 2; ++k) \
        acc[ai][bj][m][n] = __builtin_amdgcn_mfma_f32_16x16x32_bf16(Bt[n][k], At[m][k], acc[ai][bj][m][n], 0, 0, 0); __builtin_amdgcn_s_setprio(0); } while (0)
#define PG8_WAIT_V(n) asm volatile("s_waitcnt vmcnt(" #n ")" ::: "memory")
#define PG8_WAIT_L(n) asm volatile("s_waitcnt lgkmcnt(" #n ")" ::: "memory")
#define PG8_BAR __builtin_amdgcn_s_barrier()
#define PG8_SCHED __builtin_amdgcn_sched_barrier(0)
    Unit cur, nxt; int ui = 0;
    if (!S.next(0, cur)) return;
    f32x4 acc[2][2][4][2];
#pragma unroll
    for (int a = 0; a < 2; ++a)
#pragma unroll
        for (int b = 0; b < 2; ++b)
#pragma unroll
            for (int m = 0; m < 4; ++m)
#pragma unroll
                for (int n = 0; n < 2; ++n) acc[a][b][m][n] = (f32x4){0.f, 0.f, 0.f, 0.f};
    bf16x8 At[4][2], B0[2][2], B1[2][2];
    const char* cA = (const char*)g.A + (size_t)cur.pm * tstep + (size_t)g.kt0 * kstep; const char* cB = (const char*)g.Bt + (size_t)cur.pn * tstep + (size_t)g.kt0 * kstep;
    const typename Epi::Pre pre0 = E.prep_load(cur);
    if constexpr (SP2) {
        PG8_STAGE(PG8_SB(0, 0), cB, voffB); PG8_STAGE(PG8_SB(0, 1), cB + hstep, voffB); PG8_STAGE(PG8_SA(0, 0), cA, voffA); PG8_STAGE(PG8_SA(0, 1), cA + hstep, voffA);
        if (wr == 1) PG8_BAR;
        PG8_WAIT_V(2); PG8_BAR;
        PG8_STAGE(PG8_SB(1, 0), cB + kstep, voffB); PG8_STAGE(PG8_SA(1, 0), cA + kstep, voffA); PG8_STAGE(PG8_SB(1, 1), cB + hstep + kstep, voffB);
        PG8_WAIT_V(6); PG8_BAR;
    } else {
        PG8_STAGE(PG8_SB(0, 0), cB, voffB); PG8_STAGE(PG8_SA(0, 0), cA, voffA); PG8_STAGE(PG8_SB(0, 1), cB + hstep, voffB); PG8_STAGE(PG8_SA(0, 1), cA + hstep, voffA);
        if (wr == 1) PG8_BAR;
        PG8_WAIT_V(4); PG8_BAR;
        PG8_STAGE(PG8_SB(1, 0), cB + kstep, voffB); PG8_STAGE(PG8_SA(1, 0), cA + kstep, voffA); PG8_STAGE(PG8_SB(1, 1), cB + hstep + kstep, voffB);
        PG8_WAIT_V(6); PG8_BAR;
    }
    E.prep_finish(pre0, 0);
    for (;;) {
        const bool has_next = S.next(ui + 1, nxt);
        const char* nA = has_next ? (const char*)g.A + (size_t)nxt.pm * tstep + (size_t)g.kt0 * kstep : cA; const char* nB = has_next ? (const char*)g.Bt + (size_t)nxt.pn * tstep + (size_t)g.kt0 * kstep : cB;
        for (int t = 0; t < nt; t += 2) {
            const bool last = (t == nt - 2);
            const char* a1 = cA + (size_t)(t + 1) * kstep;
            const char* a2 = last ? nA : cA + (size_t)(t + 2) * kstep; const char* b2 = last ? nB : cB + (size_t)(t + 2) * kstep;
            const char* a3 = a2 + kstep; const char* b3 = b2 + kstep;
            if constexpr (Epi::KRESCALE) { if (t == 4) E.rescale(acc, 0, ui & 1, wr, fr); else if (t == 8) E.rescale(acc, 1, ui & 1, wr, fr); }
            if constexpr (SP2) {
            PG8_LDB(B0, 0, 0); PG8_LDB(B1, 0, 1); PG8_SCHED; PG8_LDA(At, 0, 0); PG8_STAGE(PG8_SA(1, 1), a1 + hstep, voffA);
            PG8_WAIT_V(8); PG8_WAIT_L(0); PG8_BAR; PG8_MMA(0, 0, At, B0); PG8_MMA(0, 1, At, B1); PG8_BAR; PG8_SCHED;
            PG8_LDA(At, 0, 1); PG8_STAGE(PG8_SB(0, 0), b2, voffB); PG8_STAGE(PG8_SB(0, 1), b2 + hstep, voffB); PG8_STAGE(PG8_SA(0, 0), a2, voffA);
            PG8_WAIT_V(8); PG8_WAIT_L(0); PG8_BAR; PG8_MMA(1, 0, At, B0); PG8_MMA(1, 1, At, B1); PG8_BAR; PG8_SCHED;
            PG8_LDB(B0, 1, 0); PG8_LDB(B1, 1, 1); PG8_SCHED; PG8_LDA(At, 1, 0); PG8_STAGE(PG8_SA(0, 1), a2 + hstep, voffA);
            PG8_WAIT_V(8); PG8_WAIT_L(0); PG8_BAR; PG8_MMA(0, 0, At, B0); PG8_MMA(0, 1, At, B1); PG8_BAR; PG8_SCHED;
            PG8_LDA(At, 1, 1); PG8_STAGE(PG8_SB(1, 0), b3, voffB); PG8_STAGE(PG8_SB(1, 1), b3 + hstep, voffB); PG8_STAGE(PG8_SA(1, 0), a3, voffA);
            PG8_WAIT_V(8); PG8_WAIT_L(0); PG8_BAR; PG8_MMA(1, 0, At, B0); PG8_MMA(1, 1, At, B1); PG8_BAR; PG8_SCHED;
            } else {
            PG8_LDB(B0, 0, 0); PG8_SCHED; PG8_LDA(At, 0, 0); PG8_STAGE(PG8_SA(1, 1), a1 + hstep, voffA);
            PG8_WAIT_L(8); PG8_BAR; PG8_WAIT_L(0); PG8_MMA(0, 0, At, B0); PG8_BAR; PG8_SCHED;
            PG8_LDB(B1, 0, 1); PG8_STAGE(PG8_SB(0, 0), b2, voffB);
            PG8_BAR; PG8_WAIT_L(0); PG8_MMA(0, 1, At, B1); PG8_BAR;
            PG8_LDA(At, 0, 1); PG8_STAGE(PG8_SA(0, 0), a2, voffA);
            PG8_BAR; PG8_WAIT_L(0); PG8_MMA(1, 0, At, B0); PG8_BAR; PG8_SCHED;
            PG8_STAGE(PG8_SB(0, 1), b2 + hstep, voffB);
            PG8_WAIT_V(6); PG8_BAR; PG8_MMA(1, 1, At, B1); PG8_BAR;
            PG8_LDB(B0, 1, 0); PG8_SCHED; PG8_LDA(At, 1, 0); PG8_STAGE(PG8_SA(0, 1), a2 + hstep, voffA);
            PG8_WAIT_L(8); PG8_BAR; PG8_WAIT_L(0); PG8_MMA(0, 0, At, B0); PG8_BAR; PG8_SCHED;
            PG8_LDB(B1, 1, 1); PG8_STAGE(PG8_SB(1, 0), b3, voffB);
            PG8_BAR; PG8_WAIT_L(0); PG8_MMA(0, 1, At, B1); PG8_BAR;
            PG8_LDA(At, 1, 1); PG8_STAGE(PG8_SA(1, 0), a3, voffA);
            PG8_BAR; PG8_WAIT_L(0); PG8_MMA(1, 0, At, B0); PG8_BAR; PG8_SCHED;
            PG8_STAGE(PG8_SB(1, 1), b3 + hstep, voffB);
            PG8_WAIT_V(6); PG8_BAR; PG8_MMA(1, 1, At, B1); PG8_BAR;
            }
        }
        if constexpr (ALIGN_EPI) { if (wr == 0) PG8_BAR; }
        if (has_next) { const typename Epi::Pre pren = E.prep_load(nxt); E(acc, cur, wr, wc, fr, fq, ui & 1); E.prep_finish(pren, (ui + 1) & 1); }
        else E(acc, cur, wr, wc, fr, fq, ui & 1);
        if (!has_next) break;
#pragma unroll
        for (int a = 0; a < 2; ++a)
#pragma unroll
            for (int b = 0; b < 2; ++b)
#pragma unroll
                for (int m = 0; m < 4; ++m)
#pragma unroll
                    for (int n = 0; n < 2; ++n) acc[a][b][m][n] = (f32x4){0.f, 0.f, 0.f, 0.f};
        cur = nxt; cA = nA; cB = nB; ++ui;
        if constexpr (ALIGN_EPI) { if (wr == 1) PG8_BAR; }
    }
    PG8_WAIT_V(0);
    if constexpr (!ALIGN_EPI) { if (wr == 0) PG8_BAR; }
    PG8_BAR;
#undef PG8_SA
#undef PG8_SB
#undef PG8_STAGE
#undef PG8_LDA
#undef PG8_LDB
#undef PG8_MMA
#undef PG8_WAIT_V
#undef PG8_WAIT_L
#undef PG8_BAR
#undef PG8_SCHED
}

template <class Epi>
__device__ __forceinline__ void gemm_phase_h(PG8_LAS unsigned char* lds, const Gemm g, int pm, int pn, const Epi& E, int tid_in) {
    int tid_ = tid_in; asm volatile("" : "+v"(tid_));
    const int tid = tid_, wid = __builtin_amdgcn_readfirstlane(tid >> 6), lane = tid & 63, wr = wid >> 2, wc = wid & 3, fr = lane & 15, fq = lane >> 4;
    const int K = g.K, nt = K / BK;
    unsigned voffA[2], voffB[2];
#pragma unroll
    for (int i = 0; i < 2; ++i) { int R, C; stage_rc(tid * 16 + i * 8192, R, C); const int Rb = Epi::PERM ? ((R & ~31) + perm32(R & 31)) : R;
        voffA[i] = (unsigned)(R * K + C) * 2u; voffB[i] = (unsigned)(Rb * K + C) * 2u; }
    const size_t kstep = (size_t)(BK * 2), hstep = (size_t)HALF * K * 2;
    const unsigned ldsw = (unsigned)wid * 1024u;
    const int aoff = lds_byte(wr * 64 + fr, fq * 8), boff = lds_byte(wc * 32 + fr, fq * 8);
#define H_SA(b) ((b) * 49152)
#define H_SB(b, h) ((b) * 49152 + 16384 * (1 + (h)))
#define H_STAGE(bufoff, gbase, voff) do { _Pragma("unroll") for (int _i = 0; _i < 2; ++_i) \
        __builtin_amdgcn_global_load_lds((const unsigned*)((const char*)(gbase) + (voff)[_i]), (PG8_LAS unsigned*)(lds + (bufoff) + ldsw + _i * 8192), 16, 0, 0); } while (0)
#define H_LDA(dst, b) do { _Pragma("unroll") for (int m = 0; m < 4; ++m) _Pragma("unroll") for (int k = 0; k < 2; ++k) dst[m][k] = *(const PG8_LAS bf16x8*)(lds + H_SA(b) + aoff + m * 2048 + k * 1024); } while (0)
#define H_LDB(dst, b, h) do { _Pragma("unroll") for (int n = 0; n < 2; ++n) _Pragma("unroll") for (int k = 0; k < 2; ++k) dst[n][k] = *(const PG8_LAS bf16x8*)(lds + H_SB(b, h) + boff + n * 2048 + k * 1024); } while (0)
#define H_MMA(bj, At, Bt) do { __builtin_amdgcn_s_setprio(1); _Pragma("unroll") for (int m = 0; m < 4; ++m) _Pragma("unroll") for (int n = 0; n < 2; ++n) _Pragma("unroll") for (int k = 0; k < 2; ++k) \
        acc[0][bj][m][n] = __builtin_amdgcn_mfma_f32_16x16x32_bf16(Bt[n][k], At[m][k], acc[0][bj][m][n], 0, 0, 0); __builtin_amdgcn_s_setprio(0); } while (0)
#define H_WAIT_V(n) asm volatile("s_waitcnt vmcnt(" #n ")" ::: "memory")
#define H_WAIT_L(n) asm volatile("s_waitcnt lgkmcnt(" #n ")" ::: "memory")
#define H_BAR __builtin_amdgcn_s_barrier()
#define H_SCHED __builtin_amdgcn_sched_barrier(0)
    Unit cur; cur.pm = pm; cur.pn = pn;
    f32x4 acc[1][2][4][2];
#pragma unroll
    for (int b = 0; b < 2; ++b)
#pragma unroll
        for (int m = 0; m < 4; ++m)
#pragma unroll
            for (int n = 0; n < 2; ++n) acc[0][b][m][n] = (f32x4){0.f, 0.f, 0.f, 0.f};
    bf16x8 At[4][2], B0[2][2], B1[2][2];
    const char* cA = (const char*)g.A + (size_t)pm * hstep; const char* cB = (const char*)g.Bt + (size_t)pn * 2 * hstep;
    const typename Epi::Pre pre0 = E.prep_load(cur);
    H_STAGE(H_SB(0, 0), cB, voffB); H_STAGE(H_SB(0, 1), cB + hstep, voffB); H_STAGE(H_SA(0), cA, voffA);
    if (wr == 1) H_BAR;
    H_WAIT_V(0); H_BAR;
    H_STAGE(H_SB(1, 0), cB + kstep, voffB); H_STAGE(H_SB(1, 1), cB + hstep + kstep, voffB); H_STAGE(H_SA(1), cA + kstep, voffA);
    H_BAR;
    E.prep_finish(pre0, 0);
    int b = 0;
    for (int t = 0; t < nt; ++t) {
        const int t2 = (t + 2 < nt) ? t + 2 : t + 2 - nt;
        const int b2 = (b == 0) ? 2 : b - 1;
        const char* a2 = cA + (size_t)t2 * kstep; const char* bb2 = cB + (size_t)t2 * kstep;
        if constexpr (Epi::KRESCALE) { if (t == 4) E.rescale(acc, 0, 0, wr, fr); else if (t == 8) E.rescale(acc, 1, 0, wr, fr); }
        if (b == 0) { H_LDB(B0, 0, 0); H_LDB(B1, 0, 1); H_SCHED; H_LDA(At, 0); }
        else if (b == 1) { H_LDB(B0, 1, 0); H_LDB(B1, 1, 1); H_SCHED; H_LDA(At, 1); }
        else { H_LDB(B0, 2, 0); H_LDB(B1, 2, 1); H_SCHED; H_LDA(At, 2); }
        if (b2 == 0) { H_STAGE(H_SB(0, 0), bb2, voffB); H_STAGE(H_SB(0, 1), bb2 + hstep, voffB); H_STAGE(H_SA(0), a2, voffA); }
        else if (b2 == 1) { H_STAGE(H_SB(1, 0), bb2, voffB); H_STAGE(H_SB(1, 1), bb2 + hstep, voffB); H_STAGE(H_SA(1), a2, voffA); }
        else { H_STAGE(H_SB(2, 0), bb2, voffB); H_STAGE(H_SB(2, 1), bb2 + hstep, voffB); H_STAGE(H_SA(2), a2, voffA); }
        H_WAIT_V(6); H_WAIT_L(0); H_BAR; H_MMA(0, At, B0); H_MMA(1, At, B1); H_BAR; H_SCHED;
        b = (b == 2) ? 0 : b + 1;
    }
    if (wr == 0) H_BAR;
    E(acc, cur, wr, wc, fr, fq, 0);
    H_WAIT_V(0);
    H_BAR;
#undef H_SA
#undef H_SB
#undef H_STAGE
#undef H_LDA
#undef H_LDB
#undef H_MMA
#undef H_WAIT_V
#undef H_WAIT_L
#undef H_BAR
#undef H_SCHED
}
}

#define GAS __attribute__((address_space(1)))
#define LAS __attribute__((address_space(3)))
typedef unsigned short bf16;
typedef unsigned v4u __attribute__((ext_vector_type(4)));
typedef unsigned v2u __attribute__((ext_vector_type(2)));
typedef float f32x4 __attribute__((ext_vector_type(4)));
typedef float f32x2 __attribute__((ext_vector_type(2)));
typedef short bf16x8 __attribute__((ext_vector_type(8)));
typedef short bf16x4 __attribute__((ext_vector_type(4)));

constexpr int NWAVES = 8, NTHR = 512;
constexpr int M = 8192, MC = 4096, D = 1024, NIN = 1952, NINP = 2048, DFF = 2816, NGU = 5632;
constexpr int O_SC = 768, O_CQ = 1536, O_CKV = 1792, O_KPE = 1920;
constexpr int NH = 8, QKD = 96, VD = 64, QL = 256, KVL = 128, ROPE = 32;
constexpr float EPS = 1e-6f;
constexpr float QSCALE = 0.10206207261596575f * 1.4426950408889634f;
constexpr int XL0 = 2 * 256 + 32, XL1 = 2 * 1024 + 32;
constexpr int FILT_LAYER = 256 * (XL0 + XL1);
constexpr int OUT_CKV = M * D, OUT_KPE = OUT_CKV + 16 * 2 * 256 * 128;
constexpr int N_PHASES = 14;

constexpr size_t MiB = 1u << 20;
constexpr size_t WS_CTL = 0, CTL_ZERO_BYTES = 1 * MiB;
constexpr size_t CTL_XFLAG = 128 * 1024;
constexpr size_t CTL_SSQHY = 256 * 1024;
constexpr size_t WS_MOD = 384 * 1024;
constexpr size_t WS_GG = 1 * MiB;
constexpr size_t WS_BIN = WS_GG + 2 * 2 * 5 * 1024 * 4;
constexpr size_t WS_BGU = WS_BIN + 2 * 5 * 2048 * 4;
constexpr size_t WS_SSQ1P = 2 * MiB;
constexpr size_t WS_SSQ2P = WS_SSQ1P + 16 * M * 4;
constexpr size_t WS_SSQSC = WS_SSQ2P + 16 * M * 4;
constexpr size_t WS_SSQAT = WS_SSQSC + M * 4;
constexpr size_t WS_ROPE = WS_SSQAT + 8 * M * 4;
constexpr size_t WS_FILT = 4 * MiB;
constexpr size_t WS_WIN = 8 * MiB;
constexpr size_t WS_WOUT = WS_WIN + 2ull * NINP * D * 2;
constexpr size_t WS_WGU = WS_WOUT + 2ull * D * D * 2;
constexpr size_t WS_WD = WS_WGU + 2ull * NGU * D * 2;
constexpr size_t WS_WUQ = WS_WD + 2ull * D * DFF * 2;
constexpr size_t WS_WUKV = WS_WUQ + 2ull * 768 * 256 * 2;
constexpr size_t WS_XG = 58 * MiB;
constexpr size_t WS_XR = WS_XG + (size_t)M * D * 2;
constexpr size_t WS_PROJ = WS_XR + (size_t)M * D * 4;
constexpr size_t WS_Q = WS_PROJ + (size_t)M * NINP * 2;
constexpr size_t WS_ACT = WS_PROJ;
constexpr size_t WS_KC = WS_Q + (size_t)M * 768 * 2;
constexpr size_t WS_VTC = WS_KC + 16ull * 256 * 768 * 2;
constexpr size_t WS_KL = WS_VTC + 16ull * 8 * 64 * 256 * 2;
constexpr size_t WS_VTL = WS_KL + 2ull * 4 * 1280 * 768 * 2;
constexpr size_t WS_YMIX = WS_VTL + 2ull * 4 * 8 * 64 * 1280 * 2;
constexpr size_t WS_XCH = WS_YMIX + (size_t)M * D * 2;
constexpr size_t WS_END = WS_XCH + 256ull * 128 * 256 * 4;
static_assert(WS_MOD + 2 * 5 * 6144 * 4 <= CTL_ZERO_BYTES && CTL_SSQHY + 2 * M * 4 <= WS_MOD && WS_BGU + 2 * 5 * 5632 * 4 <= WS_SSQ1P && WS_ROPE + 1024 * 32 * 4 <= WS_FILT && WS_FILT + 2ull * FILT_LAYER * 2 <= WS_WIN && WS_WUKV + 2ull * 1024 * 128 * 2 <= WS_XG, "ws map");
static_assert((size_t)M * DFF * 2 == (size_t)M * NINP * 2 + (size_t)M * 768 * 2, "ACT overlays PROJ|Q exactly");
static_assert(WS_END <= 256 * MiB, "ws fits 256 MiB");
constexpr int CW_BAR = 4096;

constexpr int RING_BYTES = 147456;
constexpr int MISC_OFF = RING_BYTES;
constexpr int AUX_OFF = RING_BYTES + 1024;
constexpr int LDS_BYTES = 155648;
static_assert(AUX_OFF + 2 * 3 * 256 * 4 <= LDS_BYTES, "LDS map");
constexpr int P0_SCR = 8704, P0_SV = 8 * P0_SCR;
static_assert(P0_SV + 5 * 1024 * 4 <= RING_BYTES, "P0 LDS");

#define LDS_WAIT() asm volatile("s_waitcnt lgkmcnt(0)" ::: "memory")
#define VM_WAIT() asm volatile("s_waitcnt vmcnt(0)" ::: "memory")
typedef __bf16 bf16x2_t __attribute__((ext_vector_type(2)));
__device__ __forceinline__ unsigned pk2(float lo, float hi) { f32x2 v = {lo, hi}; bf16x2_t b = __builtin_convertvector(v, bf16x2_t); return __builtin_bit_cast(unsigned, b); }
__device__ __forceinline__ unsigned f2bf(float f) { return pk2(f, 0.f) & 0xffffu; }
__device__ __forceinline__ unsigned cvtpk(float lo, float hi) { return pk2(lo, hi); }
__device__ __forceinline__ float bf2f(unsigned short b) { return __builtin_bit_cast(float, (unsigned)b << 16); }
__device__ __forceinline__ float bflo(unsigned w) { return __builtin_bit_cast(float, w << 16); }
__device__ __forceinline__ float bfhi(unsigned w) { return __builtin_bit_cast(float, w & 0xffff0000u); }
__device__ __forceinline__ float shx(float v, int mask, int lane) { return __builtin_bit_cast(float, __builtin_amdgcn_ds_bpermute((lane ^ mask) << 2, __builtin_bit_cast(int, v))); }
__device__ __forceinline__ float max3f(float a, float b, float c) { float r; asm("v_max3_f32 %0, %1, %2, %3" : "=v"(r) : "v"(a), "v"(b), "v"(c)); return r; }
__device__ __forceinline__ float max32(float v) { auto rr = __builtin_amdgcn_permlane32_swap(__float_as_uint(v), __float_as_uint(v), false, false); return fmaxf(__uint_as_float(rr[0]), __uint_as_float(rr[1])); }
__device__ __forceinline__ float sum32(float v) { auto rr = __builtin_amdgcn_permlane32_swap(__float_as_uint(v), __float_as_uint(v), false, false); return __uint_as_float(rr[0]) + __uint_as_float(rr[1]); }
__device__ __forceinline__ float rdl(float v, int src) { return __builtin_bit_cast(float, __builtin_amdgcn_readlane(__builtin_bit_cast(int, v), src)); }
__device__ __forceinline__ float wave_sum(float v, int lane) {
#pragma unroll
    for (int o = 1; o < 64; o <<= 1) v += shx(v, o, lane);
    return v;
}
__device__ __forceinline__ int modidx(int row) { return row < MC ? 0 : 1 + ((row - MC) >> 10); }


#define XB_TMO      128
#define XB_XCNT(j)  (256  + 64 * (j))
#define XB_XSUB(j)  (1280 + 64 * (j))
#define XB_XGEN(j)  (2304 + 64 * (j))
#define XB_TOP      3328
#define XB_TOPGEN   3392
#define XCD_BAR_WORDS 5504
#define XB_SPIN_CAP (1u << 18)
__device__ __forceinline__ unsigned xb_ld(unsigned* p)              { return __hip_atomic_load(p, __ATOMIC_RELAXED, __HIP_MEMORY_SCOPE_AGENT); }
__device__ __forceinline__ unsigned xb_add(unsigned* p, unsigned v) { return __hip_atomic_fetch_add(p, v, __ATOMIC_RELAXED, __HIP_MEMORY_SCOPE_AGENT); }
__device__ __forceinline__ unsigned xb_xcc_id() { return (unsigned)__builtin_amdgcn_s_getreg((3 << 11) | 20) & 0xFu; }
#define XB_SPIN(cond, bar) do { unsigned _sp = 0; while (cond) { __builtin_amdgcn_s_sleep(1); \
    if ((++_sp & 255u) == 0u) { if (xb_ld(&(bar)[XB_TMO])) break; if (_sp > XB_SPIN_CAP) { atomicAdd(&(bar)[XB_TMO], 1u); break; } } } } while (0)
__device__ __forceinline__ void xcd_barrier_complete(unsigned* bar, unsigned x, unsigned& nloc, unsigned& nx, unsigned& idx) {
    const unsigned G = gridDim.x * gridDim.y * gridDim.z;
    unsigned sum, cnt, mine, below, sp = 0u;
    for (;;) {
        sum = 0u; cnt = 0u; mine = 0u; below = 0u;
#pragma unroll
        for (unsigned j = 0; j < 16; ++j) { const unsigned c = xb_ld(&bar[XB_XCNT(j)]); sum += c; cnt += (c > 0u) ? 1u : 0u; mine = (j == x) ? c : mine; below += (c > 0u && j < x) ? 1u : 0u; }
        if (sum == G) break;
        __builtin_amdgcn_s_sleep(1);
        if ((++sp & 255u) == 0u) { if (xb_ld(&bar[XB_TMO])) break; if (sp > XB_SPIN_CAP) { atomicAdd(&bar[XB_TMO], 1u); break; } }
    }
    nloc = mine > 0u ? mine : 1u; nx = cnt > 0u ? cnt : 1u; idx = below;
}
__device__ __forceinline__ void xcd_barrier(unsigned* bar, unsigned x, volatile LAS unsigned* st, bool leader) {
    asm volatile("s_waitcnt vmcnt(0)" ::: "memory");
    __syncthreads();
    if (leader) {
        __builtin_amdgcn_s_waitcnt(0);
        unsigned nloc = st[0], nx = st[1];
        if (nloc == 0u) { unsigned idx; xcd_barrier_complete(bar, x, nloc, nx, idx); st[0] = nloc; st[1] = nx; st[2] = idx; }
        const unsigned old = xb_add(&bar[XB_XSUB(x)], 1u);
        const unsigned gen = old / nloc;
        if (old + 1u == (gen + 1u) * nloc) {
            __builtin_amdgcn_fence(__ATOMIC_RELEASE, "agent");
            asm volatile("s_waitcnt vmcnt(0)" ::: "memory");
            const unsigned og = xb_add(&bar[XB_TOP], 1u);
            const unsigned tg = og / nx;
            if (og + 1u == (tg + 1u) * nx) xb_add(&bar[XB_TOPGEN], 1u);
            else XB_SPIN(xb_ld(&bar[XB_TOPGEN]) == tg, bar);
            __builtin_amdgcn_fence(__ATOMIC_ACQUIRE, "agent");
            xb_add(&bar[XB_XGEN(x)], 1u);
            asm volatile("s_waitcnt vmcnt(0)" ::: "memory");
        } else {
            XB_SPIN(xb_ld(&bar[XB_XGEN(x)]) == gen, bar);
            __builtin_amdgcn_fence(__ATOMIC_ACQUIRE, "agent");
            asm volatile("s_waitcnt vmcnt(0)" ::: "memory");
        }
    }
    __syncthreads();
}

#define XB_LSUB(j)  (3456 + 64 * (j))
#define XB_LGEN(j)  (4480 + 64 * (j))
__device__ __forceinline__ void xcd_local_barrier(unsigned* bar, unsigned x, volatile LAS unsigned* st, bool leader) {
    asm volatile("s_waitcnt vmcnt(0)" ::: "memory");
    __syncthreads();
    if (leader) {
        __builtin_amdgcn_s_waitcnt(0);
        unsigned nloc = st[0];
        if (nloc == 0u) { unsigned nx, idx; xcd_barrier_complete(bar, x, nloc, nx, idx); st[0] = nloc; st[1] = nx; st[2] = idx; }
        asm volatile("buffer_inv sc1" ::: "memory");
        const unsigned old = xb_add(&bar[XB_LSUB(x)], 1u);
        const unsigned gen = old / nloc;
        if (old + 1u == (gen + 1u) * nloc) xb_add(&bar[XB_LGEN(x)], 1u);
        else XB_SPIN(xb_ld(&bar[XB_LGEN(x)]) == gen, bar);
        asm volatile("s_waitcnt vmcnt(0)" ::: "memory");
    }
    __syncthreads();
}

struct Args { const float* in[31]; float* out; unsigned char* ws; int ph_lo, ph_hi, use_bar, li, no_ssq, pad; };
enum { I_XP = 0, I_XS, I_CCKV, I_CKPE, I_C, I_CCTX, I_WMOD, I_BMOD, I_GN1, I_WIN, I_HYCONV, I_HYW1, I_HYB1, I_HYFREQ, I_HYW2, I_HYB2, I_HYW3, I_HYBIAS, I_SCCONV,
       I_GQ, I_WUQ, I_GKV, I_WUKV, I_GQH, I_GKH, I_GGRP, I_WOUT, I_GN2, I_WG, I_WU, I_WD };

typedef const __attribute__((address_space(4))) Args* KArgs;
struct Frame {
    LAS unsigned char* lds;
    int tid, lane, wave, G, bid;
    int rank, nloc, idx, nx;
    KArgs a;
    unsigned char* ws;
};
#define WSP(T, off) ((T*)(F.ws + (off)))

struct XGeom { int rank, nloc, idx, nx; __device__ __forceinline__ int nrb() const { return (8 - idx + nx - 1) / nx; } };
struct XOrder256 {
    XGeom x; int npn;
    __device__ __forceinline__ bool next(int i, pg8::Unit& u) const { const int per = 4 * npn, q = i * x.nloc + x.rank; if (q >= per * x.nrb()) return false;
        const int rb = x.idx + (q / per) * x.nx, qq = q % per; u.pm = 4 * rb + (qq & 3); u.pn = qq >> 2; return true; }
};


struct TrItem { const float* W; const float* kscale; bf16* WT; int N, k0, n0, ldk, dst_row0; };
__device__ __forceinline__ void tr_load(const TrItem& it, float (&v)[32], int lane) {
#pragma unroll
    for (int i = 0; i < 32; ++i) { const int kk = 2 * i + (lane >> 5); v[i] = it.W[(size_t)(it.k0 + kk) * it.N + it.n0 + (lane & 31)]; }
}
__device__ __forceinline__ void tr_finish(const TrItem& it, float (&v)[32], LAS float* scr, int lane) {
    if (it.kscale) {
#pragma unroll
        for (int i = 0; i < 32; ++i) v[i] *= it.kscale[it.k0 + 2 * i + (lane >> 5)]; }
#pragma unroll
    for (int i = 0; i < 32; ++i) { const int kk = 2 * i + (lane >> 5); scr[kk * 33 + (lane & 31)] = v[i]; }
    LDS_WAIT(); asm volatile("" ::: "memory");
    const int c = lane & 7;
#pragma unroll
    for (int j = 0; j < 4; ++j) { const int n = (lane >> 3) + 8 * j; const LAS float* s = scr + (8 * c) * 33 + n;
        v4u o; o.x = pk2(s[0 * 33], s[1 * 33]); o.y = pk2(s[2 * 33], s[3 * 33]); o.z = pk2(s[4 * 33], s[5 * 33]); o.w = pk2(s[6 * 33], s[7 * 33]);
        *(v4u*)(it.WT + (size_t)(it.dst_row0 + n) * it.ldk + it.k0 + 8 * c) = o; }
    LDS_WAIT(); asm volatile("" ::: "memory");
}
constexpr int T_IN = 16 * 61, T_OUT = 16 * 32, T_G = 16 * 88, T_D = 44 * 32, T_UQ = 4 * 24, T_UKV = 2 * 32;
constexpr int T_LAYER = T_IN + T_OUT + 2 * T_G + T_D + T_UQ + T_UKV;
constexpr int IT_MOD = 192 * 16, IT_FILT = 2 * 1280, IT_ROPE = 256;
constexpr int P0_ITEMS = IT_MOD + IT_FILT + IT_ROPE + 2 * T_LAYER;

__device__ __forceinline__ void p0_mod_item(Frame& F, int it, const LAS float* sv) {
    const int kc = it & 15, nbl = it >> 4, l = nbl / 96, n0 = (nbl % 96) * 64 + F.lane, k0 = kc * 64;
    const float* W = F.a->in[I_WMOD] + (size_t)l * D * 6144 + n0 + (size_t)k0 * 6144;
    float acc[5] = {0.f, 0.f, 0.f, 0.f, 0.f};
#pragma unroll 1
    for (int h = 0; h < 2; ++h) {
        float w[32];
#pragma unroll
        for (int u = 0; u < 32; ++u) w[u] = W[(size_t)(h * 32 + u) * 6144];
#pragma unroll
        for (int u = 0; u < 32; ++u)
#pragma unroll
            for (int j = 0; j < 5; ++j) acc[j] += sv[j * 1024 + k0 + h * 32 + u] * w[u];
    }
    const float b = kc == 0 ? F.a->in[I_BMOD][l * 6144 + n0] : 0.f;
    float* mod = WSP(float, WS_MOD) + (size_t)l * 5 * 6144 + n0;
#pragma unroll
    for (int j = 0; j < 5; ++j) if (F.a->no_ssq == 0) atomicAdd(mod + j * 6144, acc[j] + b);
}
__device__ __forceinline__ void p0_filt_item(Frame& F, int it) {
    const int l = it / 1280, r = it % 1280, sel = r >= 256, m = sel ? r - 256 : r, L = sel ? 1024 : 256, lane = F.lane;
    const float* w1 = F.a->in[I_HYW1] + l * 33 * 64; const float* w2 = F.a->in[I_HYW2] + l * 64 * 64; const float* w3 = F.a->in[I_HYW3] + l * 64 * 512;
    const float zt = (float)m / (float)(L - 1), wang = 6.283185307179586f * (float)m / (float)L;
    float zv = 0.f;
    if (lane == 0) zv = zt;
    else if (lane <= 16) { const float band = 1e-4f + (float)(lane - 1) * ((15.0f - 1e-4f) / 15.0f); zv = cosf(band * wang); }
    else if (lane <= 32) { const float band = 1e-4f + (float)(lane - 17) * ((15.0f - 1e-4f) / 15.0f); zv = -sinf(band * wang); }
    const float fr = F.a->in[I_HYFREQ][l * 64 + lane];
    float s = F.a->in[I_HYB1][l * 64 + lane];
#pragma unroll
    for (int i = 0; i < 33; ++i) s += rdl(zv, i) * w1[i * 64 + lane];
    const float h1 = sinf(fr * s);
    s = F.a->in[I_HYB2][l * 64 + lane];
#pragma unroll 32
    for (int i = 0; i < 64; ++i) s += rdl(h1, i) * w2[i * 64 + lane];
    const float h2 = sinf(fr * s);
    float h3[8] = {0.f, 0.f, 0.f, 0.f, 0.f, 0.f, 0.f, 0.f};
#pragma unroll 8
    for (int i = 0; i < 64; ++i) { const float hv = rdl(h2, i);
#pragma unroll
        for (int q = 0; q < 8; ++q) h3[q] += hv * w3[i * 512 + q * 64 + lane]; }
    const int XL = 2 * L + 32;
    bf16* R = WSP(bf16, WS_FILT) + (size_t)l * FILT_LAYER + (sel ? 256 * XL0 : 0);
    const float da = logf(0.01f) / 0.3f, db = logf(0.01f) / 1.5f;
#pragma unroll
    for (int q = 0; q < 4; ++q) { const int c = q * 64 + lane; const float delta = fabsf(da + (float)c * ((db - da) / 255.0f)); const float win = expf(-zt * delta) + 0.05f;
        R[(size_t)c * XL + (L + 32 - m)] = (bf16)f2bf(h3[q] * win + (m == 0 ? F.a->in[I_HYBIAS][l * 256 + c] : 0.f));
        if (m >= 1) R[(size_t)c * XL + (L + 32 + m)] = (bf16)f2bf(h3[q + 4] * win);
        if (m == 0) for (int i = 0; i <= 32; ++i) R[(size_t)c * XL + i] = 0; }
}
__device__ __forceinline__ void tr_decode(Frame& F, int item, TrItem& t) {
    constexpr int T0 = IT_MOD + IT_FILT + IT_ROPE;
        int r = item - T0; const int l = r / T_LAYER; r -= l * T_LAYER; t.kscale = nullptr;
        if (r < T_IN) { const int kb = r / 61, nb = r % 61; t.W = F.a->in[I_WIN] + (size_t)l * D * NIN; t.N = NIN; t.k0 = kb * 64; t.n0 = nb * 32; t.WT = WSP(bf16, WS_WIN) + (size_t)l * NINP * D; t.ldk = D; t.dst_row0 = nb * 32; return; } r -= T_IN;
        if (r < T_OUT) { const int kb = r / 32, nb = r % 32; t.W = F.a->in[I_WOUT] + (size_t)l * D * D; t.N = D; t.k0 = kb * 64; t.n0 = nb * 32; t.WT = WSP(bf16, WS_WOUT) + (size_t)l * D * D; t.ldk = D; t.dst_row0 = nb * 32; t.kscale = F.a->in[I_GGRP] + l * D; return; } r -= T_OUT;
        if (r < 2 * T_G) { const int up = r >= T_G; if (up) r -= T_G; const int kb = r / 88, nb = r % 88, u0 = nb * 32;
            t.W = F.a->in[up ? I_WU : I_WG] + (size_t)l * D * DFF; t.N = DFF; t.k0 = kb * 64; t.n0 = u0; t.WT = WSP(bf16, WS_WGU) + (size_t)l * NGU * D; t.ldk = D; t.dst_row0 = (u0 >> 7) * 256 + up * 128 + (u0 & 127); return; } r -= 2 * T_G;
        if (r < T_D) { const int kb = r / 32, nb = r % 32; t.W = F.a->in[I_WD] + (size_t)l * DFF * D; t.N = D; t.k0 = kb * 64; t.n0 = nb * 32; t.WT = WSP(bf16, WS_WD) + (size_t)l * D * DFF; t.ldk = DFF; t.dst_row0 = nb * 32; return; } r -= T_D;
        if (r < T_UQ) { const int kb = r / 24, nb = r % 24; t.W = F.a->in[I_WUQ] + (size_t)l * QL * 768; t.N = 768; t.k0 = kb * 64; t.n0 = nb * 32; t.WT = WSP(bf16, WS_WUQ) + (size_t)l * 768 * QL; t.ldk = QL; t.dst_row0 = nb * 32; return; } r -= T_UQ;
        { const int kb = r / 32, nb = r % 32; t.W = F.a->in[I_WUKV] + (size_t)l * KVL * 1024; t.N = 1024; t.k0 = kb * 64; t.n0 = nb * 32; t.WT = WSP(bf16, WS_WUKV) + (size_t)l * 1024 * KVL; t.ldk = KVL; t.dst_row0 = nb * 32; }
}
__device__ __forceinline__ void p0_phase(Frame& F) {
    LAS float* sv = (LAS float*)(F.lds + P0_SV);
    for (int i = F.tid; i < 5 * 1024; i += NTHR) { const int j = i >> 10, k = i & 1023; const float c = (j == 0) ? F.a->in[I_CCTX][k] : F.a->in[I_C][(j - 1) * 1024 + k]; sv[i] = c / (1.f + expf(-c)); }
    __syncthreads();
    LAS float* scr = (LAS float*)(F.lds + F.wave * P0_SCR);
    const int gw = F.wave * F.G + F.bid, NGW = F.G * NWAVES;
    const int pm = F.a->no_ssq;
    for (int it = gw; it < P0_ITEMS; it += NGW) {
        int r = it;
        if (r < IT_MOD) { if (pm != 2) p0_mod_item(F, r, sv); continue; } r -= IT_MOD;
        if (r < IT_FILT) { if (pm != 3) p0_filt_item(F, r); continue; } r -= IT_FILT;
        if (r < IT_ROPE) { const int t = r * 4 + (F.lane >> 4), e16 = F.lane & 15; const float pos = (float)((e16 < 8) ? (t >> 6) : (t & 63));
            const float x = pos * exp2f(-(float)(e16 & 7) * (13.287712379549449f / 8.0f));
            const float k = rintf(x * 0.15915494309189535f); float rr = fmaf(-k, 6.2831854820251465f, x); rr = fmaf(-k, -1.7484555e-07f, rr);
            float* T = WSP(float, WS_ROPE) + (size_t)t * 32; T[e16] = cosf(rr); T[16 + e16] = sinf(rr); continue; } r -= IT_ROPE;
        break;
    }
    if (pm == 4) return;
    constexpr int T0 = IT_MOD + IT_FILT + IT_ROPE;
    int it = gw; while (it < T0) it += NGW;
    if (it < P0_ITEMS) {
        TrItem cur, nxt; float va[32], vb[32];
        tr_decode(F, it, cur); tr_load(cur, va, F.lane);
        for (;;) {
            const int i1 = it + NGW; const bool h1 = i1 < P0_ITEMS;
            if (h1) { tr_decode(F, i1, nxt); tr_load(nxt, vb, F.lane); }
            tr_finish(cur, va, scr, F.lane);
            if (!h1) break;
            const int i2 = i1 + NGW; const bool h2 = i2 < P0_ITEMS;
            if (h2) { tr_decode(F, i2, cur); tr_load(cur, va, F.lane); }
            tr_finish(nxt, vb, scr, F.lane);
            if (!h2) break;
            it = i2;
        }
    }
}

constexpr int AQ_LD = 264, AKV_LD = 136;
constexpr int QR = 64;
constexpr int QK_AQ = 0, QK_AKV = QK_AQ + QR * AQ_LD * 2, QK_KPE = QK_AKV + QR * AKV_LD * 2, QK_KSS = QK_KPE + QR * 32 * 4, QK_KRS = QK_KSS + QR * 4, QK_W = QK_KRS + 8 * 32 * 4, QK_END = QK_W + 512 * 128;
static_assert(QK_END <= RING_BYTES && (QK_W & 15) == 0, "qkv LDS");

template <bool FROM_CACHE>
__device__ __forceinline__ void qkv_unit(Frame& F, int l, int u) {
    LAS bf16* Aq = (LAS bf16*)(F.lds + QK_AQ); LAS bf16* Akv = (LAS bf16*)(F.lds + QK_AKV);
    LAS float* kpe = (LAS float*)(F.lds + QK_KPE); LAS float* kss = (LAS float*)(F.lds + QK_KSS); LAS float* krs = (LAS float*)(F.lds + QK_KRS);
    const int tid = F.tid, lane = F.lane, w = F.wave, f = lane & 15, g = lane >> 4;
    const int hs = u & 1, hl = w & 3, h = hs * 4 + hl, rhalf = w >> 2;
    const int row0 = FROM_CACHE ? 0 : (u >> 1) * QR;
    const bool latent = FROM_CACHE ? false : (row0 >= MC);
    int t0, Lk; bf16* Kseg; bf16* Vtseg;
    if (FROM_CACHE) { const int ridx = ((u & 31) >> 1) * QR, b = ridx >> 8; t0 = 1024 + (ridx & 255); Lk = 1280;
        Kseg = WSP(bf16, WS_KL) + ((size_t)(l * 4 + b) * 1280) * 768; Vtseg = WSP(bf16, WS_VTL) + (size_t)(l * 4 + b) * 8 * 64 * 1280; }
    else if (latent) { const int b = (row0 - MC) >> 10; t0 = (row0 - MC) & 1023; Lk = 1280;
        Kseg = WSP(bf16, WS_KL) + ((size_t)(l * 4 + b) * 1280) * 768; Vtseg = WSP(bf16, WS_VTL) + (size_t)(l * 4 + b) * 8 * 64 * 1280; }
    else { const int b = row0 >> 8; t0 = row0 & 255; Lk = 256; Kseg = WSP(bf16, WS_KC) + ((size_t)b * 256) * 768; Vtseg = WSP(bf16, WS_VTC) + (size_t)b * 8 * 64 * 256; }
    LAS unsigned char* Wl = F.lds + QK_W;
    LAS unsigned char* wl = Wl + (tid >> 3) * 128 + (((tid & 7) ^ ((tid >> 4) & 7)) << 4);
    v4u pre[8];
    const bf16* wpq = WSP(bf16, WS_WUQ) + (size_t)l * 768 * QL + (size_t)(hs * 384 + (tid >> 3)) * QL + (tid & 7) * 8;
    if (!FROM_CACHE) {
#pragma unroll
        for (int i = 0; i < 6; ++i) pre[i] = *(const v4u*)(wpq + (size_t)i * 64 * QL);
    }
#pragma unroll
    for (int rp = 0; rp < 2; ++rp) {
        const int r = (tid >> 4) + 32 * rp, s = tid & 15;
        if (!FROM_CACHE) {
            const bf16* prow = WSP(bf16, WS_PROJ) + (size_t)(row0 + r) * NINP;
            float v[16]; float ss = 0.f;
#pragma unroll
            for (int i = 0; i < 2; ++i) { const v4u ww = *(const v4u*)(prow + O_CQ + s * 16 + i * 8);
                v[i * 8 + 0] = bflo(ww.x); v[i * 8 + 1] = bfhi(ww.x); v[i * 8 + 2] = bflo(ww.y); v[i * 8 + 3] = bfhi(ww.y); v[i * 8 + 4] = bflo(ww.z); v[i * 8 + 5] = bfhi(ww.z); v[i * 8 + 6] = bflo(ww.w); v[i * 8 + 7] = bfhi(ww.w); }
#pragma unroll
            for (int i = 0; i < 16; ++i) ss += v[i] * v[i];
            ss += shx(ss, 1, lane); ss += shx(ss, 2, lane); ss += shx(ss, 4, lane); ss += shx(ss, 8, lane);
            const float rstd = rsqrtf(ss * (1.0f / QL) + EPS);
            const float* gq = F.a->in[I_GQ] + l * QL + s * 16;
#pragma unroll
            for (int i = 0; i < 2; ++i) { v4u o; o.x = pk2(v[i * 8 + 0] * rstd * gq[i * 8 + 0], v[i * 8 + 1] * rstd * gq[i * 8 + 1]); o.y = pk2(v[i * 8 + 2] * rstd * gq[i * 8 + 2], v[i * 8 + 3] * rstd * gq[i * 8 + 3]);
                o.z = pk2(v[i * 8 + 4] * rstd * gq[i * 8 + 4], v[i * 8 + 5] * rstd * gq[i * 8 + 5]); o.w = pk2(v[i * 8 + 6] * rstd * gq[i * 8 + 6], v[i * 8 + 7] * rstd * gq[i * 8 + 7]);
                *(LAS v4u*)(Aq + r * AQ_LD + s * 16 + i * 8) = o; }
        }
        float c[8], p[2];
        if (FROM_CACHE) { const int ridx = ((u & 31) >> 1) * QR + r, b = ridx >> 8, t = ridx & 255;
            const float* ck = F.a->in[I_CCKV] + ((size_t)((b * 2 + l) * 256 + t)) * 128 + s * 8; const float* kp = F.a->in[I_CKPE] + ((size_t)((b * 2 + l) * 256 + t)) * 32 + s * 2;
#pragma unroll
            for (int i = 0; i < 2; ++i) { const f32x4 ww = *(const f32x4*)(ck + i * 4); c[i * 4] = ww.x; c[i * 4 + 1] = ww.y; c[i * 4 + 2] = ww.z; c[i * 4 + 3] = ww.w; }
            const f32x2 ww = *(const f32x2*)kp; p[0] = ww.x; p[1] = ww.y;
        } else { const bf16* prow = WSP(bf16, WS_PROJ) + (size_t)(row0 + r) * NINP;
            const v4u ww = *(const v4u*)(prow + O_CKV + s * 8);
            c[0] = bflo(ww.x); c[1] = bfhi(ww.x); c[2] = bflo(ww.y); c[3] = bfhi(ww.y); c[4] = bflo(ww.z); c[5] = bfhi(ww.z); c[6] = bflo(ww.w); c[7] = bfhi(ww.w);
            const unsigned w2 = *(const unsigned*)(prow + O_KPE + s * 2); p[0] = bflo(w2); p[1] = bfhi(w2);
        }
        float ss = 0.f;
#pragma unroll
        for (int i = 0; i < 8; ++i) ss += c[i] * c[i];
        ss += shx(ss, 1, lane); ss += shx(ss, 2, lane); ss += shx(ss, 4, lane); ss += shx(ss, 8, lane);
        const float rstd = rsqrtf(ss * (1.0f / KVL) + EPS);
        const float* gkv = F.a->in[I_GKV] + l * KVL + s * 8;
        { v4u o; o.x = pk2(c[0] * rstd * gkv[0], c[1] * rstd * gkv[1]); o.y = pk2(c[2] * rstd * gkv[2], c[3] * rstd * gkv[3]);
            o.z = pk2(c[4] * rstd * gkv[4], c[5] * rstd * gkv[5]); o.w = pk2(c[6] * rstd * gkv[6], c[7] * rstd * gkv[7]);
            *(LAS v4u*)(Akv + r * AKV_LD + s * 8) = o; }
        float ps = p[0] * p[0] + p[1] * p[1];
        ps += shx(ps, 1, lane); ps += shx(ps, 2, lane); ps += shx(ps, 4, lane); ps += shx(ps, 8, lane);
        *(LAS f32x2*)(kpe + r * 32 + s * 2) = (f32x2){p[0], p[1]};
        if (s == 0) kss[r] = ps;
    }
    const bf16* wpk = WSP(bf16, WS_WUKV) + (size_t)l * 1024 * KVL + (size_t)(hs * 512 + (tid >> 3)) * KVL + (tid & 7) * 8;
    if (!FROM_CACHE) {
        f32x4 acc[2][6];
#pragma unroll
        for (int rt = 0; rt < 2; ++rt)
#pragma unroll
            for (int ct = 0; ct < 6; ++ct) acc[rt][ct] = (f32x4){0.f, 0.f, 0.f, 0.f};
#pragma unroll 1
        for (int kk = 0; kk < 4; ++kk) {
#pragma unroll
            for (int i = 0; i < 6; ++i) *(LAS v4u*)(wl + i * 64 * 128) = pre[i];
            __syncthreads();
            if (kk + 1 < 4) {
#pragma unroll
                for (int i = 0; i < 6; ++i) pre[i] = *(const v4u*)(wpq + (size_t)i * 64 * QL + (kk + 1) * 64); }
            else {
#pragma unroll
                for (int i = 0; i < 8; ++i) pre[i] = *(const v4u*)(wpk + (size_t)i * 64 * KVL); }
#pragma unroll
            for (int ks = 0; ks < 2; ++ks) {
                bf16x8 a[2], b[6];
#pragma unroll
                for (int rt = 0; rt < 2; ++rt) a[rt] = *(const LAS bf16x8*)(Aq + (rhalf * 32 + rt * 16 + f) * AQ_LD + kk * 64 + ks * 32 + g * 8);
#pragma unroll
                for (int ct = 0; ct < 6; ++ct) { const int nl = hl * QKD + ct * 16 + f; b[ct] = *(const LAS bf16x8*)(Wl + nl * 128 + (((ks * 4 + g) ^ ((nl >> 1) & 7)) << 4)); }
#pragma unroll
                for (int rt = 0; rt < 2; ++rt)
#pragma unroll
                    for (int ct = 0; ct < 6; ++ct) acc[rt][ct] = __builtin_amdgcn_mfma_f32_16x16x32_bf16(a[rt], b[ct], acc[rt][ct], 0, 0, 0);
            }
            __syncthreads();
        }
        const float* gqh = F.a->in[I_GQH] + l * QKD;
        float gq[6];
#pragma unroll
        for (int ct = 0; ct < 6; ++ct) gq[ct] = gqh[ct * 16 + f];
        const float* RT = WSP(float, WS_ROPE);
        bf16* Qo = WSP(bf16, WS_Q);
#pragma unroll
        for (int rt = 0; rt < 2; ++rt)
#pragma unroll
            for (int i = 0; i < 4; ++i) {
                float ss = 0.f;
#pragma unroll
                for (int ct = 0; ct < 6; ++ct) ss += acc[rt][ct][i] * acc[rt][ct][i];
                ss += shx(ss, 1, lane); ss += shx(ss, 2, lane); ss += shx(ss, 4, lane); ss += shx(ss, 8, lane);
                const float rstd = rsqrtf(ss * (1.0f / QKD) + EPS);
                const int tok = rhalf * 32 + rt * 16 + 4 * g + i, t = t0 + tok;
                float v[6];
#pragma unroll
                for (int ct = 0; ct < 6; ++ct) v[ct] = acc[rt][ct][i] * rstd * gq[ct];
                if (latent) {
#pragma unroll
                    for (int ct = 4; ct < 6; ++ct) { const float partner = shx(v[ct], 8, lane); const float cs = RT[(size_t)t * 32 + (ct - 4) * 8 + (f & 7)], sn = RT[(size_t)t * 32 + 16 + (ct - 4) * 8 + (f & 7)];
                        v[ct] = v[ct] * cs + (f < 8 ? -partner : partner) * sn; }
                }
                bf16* qrow = Qo + (size_t)(row0 + tok) * 768 + h * QKD + f;
#pragma unroll
                for (int ct = 0; ct < 6; ++ct) qrow[ct * 16] = (bf16)f2bf(v[ct] * QSCALE);
            }
    } else {
#pragma unroll
        for (int i = 0; i < 8; ++i) pre[i] = *(const v4u*)(wpk + (size_t)i * 64 * KVL);
    }
    {
        const float* gkh = F.a->in[I_GKH] + l * QKD;
        float gk[4];
#pragma unroll
        for (int ct = 0; ct < 4; ++ct) gk[ct] = gkh[ct * 16 + f];
        f32x4 acc[2][8];
#pragma unroll
        for (int rt = 0; rt < 2; ++rt)
#pragma unroll
            for (int ct = 0; ct < 8; ++ct) acc[rt][ct] = (f32x4){0.f, 0.f, 0.f, 0.f};
#pragma unroll 1
        for (int kk = 0; kk < 2; ++kk) {
#pragma unroll
            for (int i = 0; i < 8; ++i) *(LAS v4u*)(wl + i * 64 * 128) = pre[i];
            __syncthreads();
            if (kk + 1 < 2) {
#pragma unroll
                for (int i = 0; i < 8; ++i) pre[i] = *(const v4u*)(wpk + (size_t)i * 64 * KVL + (kk + 1) * 64); }
#pragma unroll
            for (int ks = 0; ks < 2; ++ks) {
                bf16x8 a[2], b[8];
#pragma unroll
                for (int rt = 0; rt < 2; ++rt) a[rt] = *(const LAS bf16x8*)(Akv + (rhalf * 32 + rt * 16 + f) * AKV_LD + kk * 64 + ks * 32 + g * 8);
#pragma unroll
                for (int ct = 0; ct < 8; ++ct) { const int nl = hl * 128 + ct * 16 + f; b[ct] = *(const LAS bf16x8*)(Wl + nl * 128 + (((ks * 4 + g) ^ ((nl >> 1) & 7)) << 4)); }
#pragma unroll
                for (int rt = 0; rt < 2; ++rt)
#pragma unroll
                    for (int ct = 0; ct < 8; ++ct) acc[rt][ct] = __builtin_amdgcn_mfma_f32_16x16x32_bf16(a[rt], b[ct], acc[rt][ct], 0, 0, 0);
            }
            __syncthreads();
        }
#pragma unroll
        for (int rt = 0; rt < 2; ++rt) {
#pragma unroll
            for (int i = 0; i < 4; ++i) {
                float ss = 0.f;
#pragma unroll
                for (int ct = 0; ct < 4; ++ct) ss += acc[rt][ct][i] * acc[rt][ct][i];
                ss += shx(ss, 1, lane); ss += shx(ss, 2, lane); ss += shx(ss, 4, lane); ss += shx(ss, 8, lane);
                const int tok = rt * 16 + 4 * g + i;
                const float rstd = rsqrtf((ss + kss[rhalf * 32 + tok]) * (1.0f / QKD) + EPS);
                if (f == 0) krs[w * 32 + tok] = rstd;
                bf16* krow = Kseg + (size_t)(t0 + rhalf * 32 + tok) * 768 + h * QKD + f;
#pragma unroll
                for (int ct = 0; ct < 4; ++ct) krow[ct * 16] = (bf16)f2bf(acc[rt][ct][i] * rstd * gk[ct]);
            }
#pragma unroll
            for (int ct = 4; ct < 8; ++ct) { const int d = (ct - 4) * 16 + f;
                v2u o; o.x = pk2(acc[rt][ct][0], acc[rt][ct][1]); o.y = pk2(acc[rt][ct][2], acc[rt][ct][3]);
                *(v2u*)(Vtseg + ((size_t)h * 64 + d) * Lk + t0 + rhalf * 32 + rt * 16 + 4 * g) = o; }
        }
        LDS_WAIT(); asm volatile("" ::: "memory");
        {
            const int tok = lane & 31, ax = lane >> 5, t = t0 + rhalf * 32 + tok; const float rs = krs[w * 32 + tok];
            float v[16];
#pragma unroll
            for (int i = 0; i < 4; ++i) { const f32x4 ww = *(const LAS f32x4*)(kpe + (rhalf * 32 + tok) * 32 + ax * 16 + i * 4); v[i * 4] = ww.x; v[i * 4 + 1] = ww.y; v[i * 4 + 2] = ww.z; v[i * 4 + 3] = ww.w; }
#pragma unroll
            for (int i = 0; i < 16; ++i) v[i] *= rs * gkh[64 + ax * 16 + i];
            if (latent) { const float* RT = WSP(float, WS_ROPE) + (size_t)t * 32 + ax * 8;
#pragma unroll
                for (int e = 0; e < 8; ++e) { const float cs = RT[e], sn = RT[16 + e]; const float A = v[e], B = v[8 + e]; v[e] = A * cs - B * sn; v[8 + e] = B * cs + A * sn; } }
            bf16* krow = Kseg + (size_t)t * 768 + h * QKD + 64 + ax * 16;
#pragma unroll
            for (int i = 0; i < 2; ++i) { v4u o; o.x = pk2(v[i * 8], v[i * 8 + 1]); o.y = pk2(v[i * 8 + 2], v[i * 8 + 3]); o.z = pk2(v[i * 8 + 4], v[i * 8 + 5]); o.w = pk2(v[i * 8 + 6], v[i * 8 + 7]); *(v4u*)(krow + i * 8) = o; }
        }
    }
    __syncthreads();
}

constexpr int P1_XROWS = M, P1_GG = 20, P1_BIAS = 2 * (NIN / 8 + NGU / 8);
constexpr int P1_ITEMS = P1_XROWS + P1_GG + P1_BIAS;
__device__ __forceinline__ void p1_phase(Frame& F) {
    const int gw = F.wave * F.G + F.bid, NGW = F.G * NWAVES, lane = F.lane;
    const float* MOD = WSP(float, WS_MOD);
    for (int it = gw; it < P1_XROWS; it += 2 * NGW) {
        const int ra = it, rb = it + NGW; const bool hb = rb < P1_XROWS; const int rb_ = hb ? rb : ra;
        const float* xa = (ra < MC) ? F.a->in[I_XP] + (size_t)ra * D : F.a->in[I_XS] + (size_t)(ra - MC) * D;
        const float* xb = (rb_ < MC) ? F.a->in[I_XP] + (size_t)rb_ * D : F.a->in[I_XS] + (size_t)(rb_ - MC) * D;
        const float* sca = MOD + (size_t)modidx(ra) * 6144 + 1024; const float* scb = MOD + (size_t)modidx(rb_) * 6144 + 1024; const float* gn = F.a->in[I_GN1];
        f32x4 va[4], vb[4]; float sa = 0.f, sb = 0.f;
#pragma unroll
        for (int q = 0; q < 4; ++q) { va[q] = *(const f32x4*)(xa + 256 * q + 4 * lane); vb[q] = *(const f32x4*)(xb + 256 * q + 4 * lane); }
#pragma unroll
        for (int q = 0; q < 4; ++q) { sa += (va[q].x * va[q].x + va[q].y * va[q].y) + (va[q].z * va[q].z + va[q].w * va[q].w); sb += (vb[q].x * vb[q].x + vb[q].y * vb[q].y) + (vb[q].z * vb[q].z + vb[q].w * vb[q].w); }
        sa = wave_sum(sa, lane); sb = wave_sum(sb, lane);
        bf16* oa = WSP(bf16, WS_XG) + (size_t)ra * D; bf16* ob = WSP(bf16, WS_XG) + (size_t)rb_ * D;
#pragma unroll
        for (int q = 0; q < 4; ++q) { const int c = 256 * q + 4 * lane; const f32x4 g = *(const f32x4*)(gn + c); const f32x4 s1 = *(const f32x4*)(sca + c), s2 = *(const f32x4*)(scb + c);
            v2u w; w.x = pk2(va[q].x * g.x * (1.f + s1.x), va[q].y * g.y * (1.f + s1.y)); w.y = pk2(va[q].z * g.z * (1.f + s1.z), va[q].w * g.w * (1.f + s1.w)); *(v2u*)(oa + c) = w;
            if (hb) { v2u w2; w2.x = pk2(vb[q].x * g.x * (1.f + s2.x), vb[q].y * g.y * (1.f + s2.y)); w2.y = pk2(vb[q].z * g.z * (1.f + s2.z), vb[q].w * g.w * (1.f + s2.w)); *(v2u*)(ob + c) = w2; } }
        if (lane == 0) { WSP(float, WS_SSQ1P)[(size_t)ra * 16] = sa; if (hb) WSP(float, WS_SSQ1P)[(size_t)rb * 16] = sb; }
    }
    for (int it = P1_XROWS + gw; it < P1_ITEMS; it += NGW) {
        int r = it;
        r -= P1_XROWS;
        if (r < P1_GG) { const int l = r / 10, kind = (r % 10) / 5, j = r % 5;
            const float* gn = F.a->in[kind ? I_GN2 : I_GN1] + l * D; const float* sc = MOD + ((size_t)l * 5 + j) * 6144 + (kind ? 4096 : 1024);
            float* o = WSP(float, WS_GG) + ((size_t)(l * 2 + kind) * 5 + j) * D;
#pragma unroll
            for (int q = 0; q < 4; ++q) { const int c = 256 * q + 4 * lane; const f32x4 g = *(const f32x4*)(gn + c); const f32x4 s4 = *(const f32x4*)(sc + c); *(f32x4*)(o + c) = (f32x4){g.x * (1.f + s4.x), g.y * (1.f + s4.y), g.z * (1.f + s4.z), g.w * (1.f + s4.w)}; }
            continue;
        }
        r -= P1_GG;
        {
            const int per = NIN / 8 + NGU / 8, l = r / per; int q = r % per; const bool gu = q >= NIN / 8; if (gu) q -= NIN / 8;
            const bf16* Wt = gu ? WSP(bf16, WS_WGU) + (size_t)l * NGU * D : WSP(bf16, WS_WIN) + (size_t)l * NINP * D;
            float* bo = gu ? WSP(float, WS_BGU) + (size_t)l * 5 * NGU : WSP(float, WS_BIN) + (size_t)l * 5 * NINP; const int ldb = gu ? NGU : NINP;
            const float* shb = MOD + (size_t)l * 5 * 6144 + (gu ? 3072 : 0);
            float sh[5][16];
#pragma unroll
            for (int j = 0; j < 5; ++j)
#pragma unroll
                for (int hh = 0; hh < 2; ++hh)
#pragma unroll
                    for (int e = 0; e < 2; ++e) { const f32x4 w = *(const f32x4*)(shb + (size_t)j * 6144 + hh * 512 + lane * 8 + e * 4); sh[j][hh * 8 + e * 4] = w.x; sh[j][hh * 8 + e * 4 + 1] = w.y; sh[j][hh * 8 + e * 4 + 2] = w.z; sh[j][hh * 8 + e * 4 + 3] = w.w; }
#pragma unroll 1
            for (int nb = 0; nb < 2; ++nb) {
                v4u xw[4][2];
#pragma unroll
                for (int n4 = 0; n4 < 4; ++n4)
#pragma unroll
                    for (int hh = 0; hh < 2; ++hh) xw[n4][hh] = *(const v4u*)(Wt + (size_t)(q * 8 + nb * 4 + n4) * D + hh * 512 + lane * 8);
#pragma unroll
                for (int n4 = 0; n4 < 4; ++n4) { const int n = q * 8 + nb * 4 + n4;
                    float w[16];
#pragma unroll
                    for (int hh = 0; hh < 2; ++hh) { const v4u x = xw[n4][hh]; w[hh * 8] = bflo(x.x); w[hh * 8 + 1] = bfhi(x.x); w[hh * 8 + 2] = bflo(x.y); w[hh * 8 + 3] = bfhi(x.y); w[hh * 8 + 4] = bflo(x.z); w[hh * 8 + 5] = bfhi(x.z); w[hh * 8 + 6] = bflo(x.w); w[hh * 8 + 7] = bfhi(x.w); }
#pragma unroll
                    for (int j = 0; j < 5; ++j) { float s = 0.f;
#pragma unroll
                        for (int e = 0; e < 16; ++e) s += w[e] * sh[j][e];
                        s = wave_sum(s, lane); if (lane == 0) bo[(size_t)j * ldb + n] = s; }
                }
            }
        }
    }
    for (int u = F.bid; u < 64; u += F.G) qkv_unit<true>(F, u >> 5, u);
}

__device__ __forceinline__ void prep_phase(Frame& F, int l) {
    { const XGeom X{F.rank, F.nloc, F.idx, F.nx}; for (int q = X.rank; q < 32 * X.nrb(); q += X.nloc) qkv_unit<false>(F, l, 32 * (X.idx + (q >> 5) * X.nx) + (q & 31)); }
}

typedef float f32x16 __attribute__((ext_vector_type(16)));
constexpr int AT_KLD = 208, AT_VLD = 136;
constexpr int AT_KT = 64 * AT_KLD, AT_VT = 64 * AT_VLD, AT_BUF = AT_KT + AT_VT;
static_assert(2 * AT_BUF <= RING_BYTES, "attention LDS");
__device__ __forceinline__ void attn_unit(Frame& F, int l, bool latent, int seg, int h, int qb) {
    int tid_ = F.tid; asm volatile("" : "+v"(tid_));
    const int tid = tid_, lane = tid & 63, r32 = lane & 31, hh = lane >> 5;
    const int Lk = latent ? 1280 : 256, NT = Lk / 64;
    const int qrow0 = (latent ? MC + seg * 1024 : seg * 256) + qb * 256 + F.wave * 32;
    const bf16* Kb = latent ? WSP(bf16, WS_KL) + ((size_t)(l * 4 + seg) * 1280) * 768 + h * QKD : WSP(bf16, WS_KC) + ((size_t)seg * 256) * 768 + h * QKD;
    const bf16* Vt = latent ? WSP(bf16, WS_VTL) + ((size_t)(l * 4 + seg) * 8 + h) * 64 * 1280 : WSP(bf16, WS_VTC) + ((size_t)seg * 8 + h) * 64 * 256;
    bf16x8 qf[6];
    { const bf16* Qp = WSP(bf16, WS_Q) + (size_t)(qrow0 + r32) * 768 + h * QKD + hh * 8;
#pragma unroll
      for (int kk = 0; kk < 6; ++kk) qf[kk] = *(const bf16x8*)(Qp + kk * 16); }
    const int kr0 = tid / 12, kc0 = tid % 12, kr1 = (tid + 512) / 12, kc1 = (tid + 512) % 12, vr = tid >> 3, vc = tid & 7;
    const bf16* ksrc0 = Kb + (size_t)kr0 * 768 + kc0 * 8; const bf16* ksrc1 = Kb + (size_t)kr1 * 768 + kc1 * 8; const bf16* vsrc = Vt + (size_t)vr * Lk + vc * 8;
    const int kdst0 = kr0 * AT_KLD + kc0 * 16, kdst1 = kr1 * AT_KLD + kc1 * 16, vdst = 2 * AT_KT + vr * AT_VLD + vc * 16;
    const bool k2 = tid < 256;
    v4u sk0, sk1 = (v4u){0u, 0u, 0u, 0u}, sv;
#define AT_LOADK(t) do { sk0 = *(const v4u*)(ksrc0 + (size_t)(t) * 64 * 768); if (k2) sk1 = *(const v4u*)(ksrc1 + (size_t)(t) * 64 * 768); } while (0)
#define AT_LOADV(t) do { sv = *(const v4u*)(vsrc + (t) * 64); } while (0)
#define AT_WRITEK(buf) do { LAS unsigned char* b_ = F.lds + (buf) * AT_KT; *(LAS v4u*)(b_ + kdst0) = sk0; if (k2) *(LAS v4u*)(b_ + kdst1) = sk1; } while (0)
#define AT_WRITEV(buf) do { LAS unsigned char* b_ = F.lds + (buf) * AT_VT; *(LAS v2u*)(b_ + vdst) = (v2u){sv.x, sv.y}; *(LAS v2u*)(b_ + vdst + 8) = (v2u){sv.z, sv.w}; } while (0)
    const int koff = r32 * AT_KLD + hh * 16, voff = 2 * AT_KT + r32 * AT_VLD + hh * 8;
    float mrun = -1e30f, lsum = 0.f;
    f32x16 o0, o1, sa0, sa1, sb0, sb1;
    v4u pw0, pw1, pw2, pw3;
#pragma unroll
    for (int r = 0; r < 16; ++r) { o0[r] = 0.f; o1[r] = 0.f; }
    {
        AT_LOADK(0);
        const v4u t0_ = *(const v4u*)(ksrc0 + (size_t)(1 * 1) * 64 * 768); v4u t1_ = (v4u){0u, 0u, 0u, 0u}; if (k2) t1_ = *(const v4u*)(ksrc1 + (size_t)(1 * 1) * 64 * 768);
        AT_WRITEK(0); sk0 = t0_; sk1 = t1_; AT_WRITEK(1); }
    __syncthreads();
    {   const LAS unsigned char* B = F.lds;
#pragma unroll
        for (int r = 0; r < 16; ++r) { sa0[r] = 0.f; sa1[r] = 0.f; }
#pragma unroll
        for (int kk = 0; kk < 6; ++kk) {
            const bf16x8 a0 = *(const LAS bf16x8*)(B + koff + kk * 32), a1 = *(const LAS bf16x8*)(B + koff + 32 * AT_KLD + kk * 32);
            sa0 = __builtin_amdgcn_mfma_f32_32x32x16_bf16(a0, qf[kk], sa0, 0, 0, 0); sa1 = __builtin_amdgcn_mfma_f32_32x32x16_bf16(a1, qf[kk], sa1, 0, 0, 0);
        } }
    __syncthreads();
#define AT_S(KK, N0, N1) do { const bf16x8 a0_ = *(const LAS bf16x8*)(Kn_ + koff + (KK) * 32), a1_ = *(const LAS bf16x8*)(Kn_ + koff + 32 * AT_KLD + (KK) * 32); \
        if ((KK) == 0) { f32x16 z_; _Pragma("unroll") for (int r = 0; r < 16; ++r) z_[r] = 0.f; \
            N0 = __builtin_amdgcn_mfma_f32_32x32x16_bf16(a0_, qf[0], z_, 0, 0, 0); N1 = __builtin_amdgcn_mfma_f32_32x32x16_bf16(a1_, qf[0], z_, 0, 0, 0); } \
        else { N0 = __builtin_amdgcn_mfma_f32_32x32x16_bf16(a0_, qf[KK], N0, 0, 0, 0); N1 = __builtin_amdgcn_mfma_f32_32x32x16_bf16(a1_, qf[KK], N1, 0, 0, 0); } } while (0)
#define AT_PV(GS, PW) do { const bf16x8 pB_ = __builtin_bit_cast(bf16x8, PW); \
        const v2u a0_ = *(const LAS v2u*)(Vp_ + voff + (GS) * 32), a1_ = *(const LAS v2u*)(Vp_ + voff + (GS) * 32 + 16); \
        const v2u b0_ = *(const LAS v2u*)(Vp_ + voff + 32 * AT_VLD + (GS) * 32), b1_ = *(const LAS v2u*)(Vp_ + voff + 32 * AT_VLD + (GS) * 32 + 16); \
        o0 = __builtin_amdgcn_mfma_f32_32x32x16_bf16(__builtin_bit_cast(bf16x8, (v4u){a0_.x, a0_.y, a1_.x, a1_.y}), pB_, o0, 0, 0, 0); \
        o1 = __builtin_amdgcn_mfma_f32_32x32x16_bf16(__builtin_bit_cast(bf16x8, (v4u){b0_.x, b0_.y, b1_.x, b1_.y}), pB_, o1, 0, 0, 0); } while (0)
#define AT_EXP8(C, R0) do { _Pragma("unroll") for (int r = (R0); r < (R0) + 8; r += 2) { const f32x2 d_ = (f32x2){C[r], C[r + 1]} - mn2_; C[r] = __builtin_amdgcn_exp2f(d_.x); C[r + 1] = __builtin_amdgcn_exp2f(d_.y); ps2_ += (f32x2){C[r], C[r + 1]}; } } while (0)
#define AT_STEP(T, C0, C1, N0, N1, DOS, DOPV, LOADK) do { \
        const int t_ = (T); \
        if (LOADK) AT_LOADK(t_ + 2); \
        AT_LOADV(t_); \
        const LAS unsigned char* Kn_ = F.lds + ((t_ + 1) & 1) * AT_KT; \
        const LAS unsigned char* Vp_ = F.lds + ((t_ + 1) & 1) * AT_VT; \
        if (DOPV) AT_PV(0, pw0); \
        if (DOS) AT_S(0, N0, N1); \
        float mx_ = fmaxf(C0[0], C1[0]); \
        _Pragma("unroll") for (int r = 1; r < 16; ++r) mx_ = max3f(mx_, C0[r], C1[r]); \
        __builtin_amdgcn_sched_barrier(0); \
        if (DOPV) AT_PV(1, pw1); \
        if (DOS) AT_S(1, N0, N1); \
        mx_ = max32(mx_); \
        const float mnew_ = fmaxf(mrun, mx_), alpha_ = __builtin_amdgcn_exp2f(mrun - mnew_); mrun = mnew_; \
        f32x2 ps2_ = (f32x2){0.f, 0.f}; const f32x2 mn2_ = (f32x2){mnew_, mnew_}; \
        AT_EXP8(C0, 0); \
        __builtin_amdgcn_sched_barrier(0); \
        if (DOPV) AT_PV(2, pw2); \
        if (DOS) AT_S(2, N0, N1); \
        AT_EXP8(C0, 8); \
        __builtin_amdgcn_sched_barrier(0); \
        if (DOPV) AT_PV(3, pw3); \
        if (DOS) AT_S(3, N0, N1); \
        AT_EXP8(C1, 0); \
        __builtin_amdgcn_sched_barrier(0); \
        if (DOS) AT_S(4, N0, N1); \
        AT_EXP8(C1, 8); \
        __builtin_amdgcn_sched_barrier(0); \
        if (DOS) AT_S(5, N0, N1); \
        lsum = lsum * alpha_ + (ps2_.x + ps2_.y); \
        _Pragma("unroll") for (int r = 0; r < 16; ++r) { o0[r] *= alpha_; o1[r] *= alpha_; } \
        pw0.x = cvtpk(C0[0], C0[1]); pw0.y = cvtpk(C0[2], C0[3]); pw0.z = cvtpk(C0[4], C0[5]); pw0.w = cvtpk(C0[6], C0[7]); \
        pw1.x = cvtpk(C0[8], C0[9]); pw1.y = cvtpk(C0[10], C0[11]); pw1.z = cvtpk(C0[12], C0[13]); pw1.w = cvtpk(C0[14], C0[15]); \
        pw2.x = cvtpk(C1[0], C1[1]); pw2.y = cvtpk(C1[2], C1[3]); pw2.z = cvtpk(C1[4], C1[5]); pw2.w = cvtpk(C1[6], C1[7]); \
        pw3.x = cvtpk(C1[8], C1[9]); pw3.y = cvtpk(C1[10], C1[11]); pw3.z = cvtpk(C1[12], C1[13]); pw3.w = cvtpk(C1[14], C1[15]); \
        if (LOADK) AT_WRITEK(t_ & 1); \
        AT_WRITEV(t_ & 1); \
        __syncthreads(); } while (0)
    AT_STEP(0, sa0, sa1, sb0, sb1, true, false, true);
    AT_STEP(1, sb0, sb1, sa0, sa1, true, true, true);
    for (int t = 2; t < NT - 2; t += 2) {
        AT_STEP(t, sa0, sa1, sb0, sb1, true, true, true);
        AT_STEP(t + 1, sb0, sb1, sa0, sa1, true, true, true);
    }
    AT_STEP(NT - 2, sa0, sa1, sb0, sb1, true, true, false);
    AT_STEP(NT - 1, sb0, sb1, sa0, sa1, false, true, false);
    {   const LAS unsigned char* Vp_ = F.lds + ((NT - 1) & 1) * AT_VT;
        AT_PV(0, pw0); AT_PV(1, pw1); AT_PV(2, pw2); AT_PV(3, pw3); }
    __syncthreads();
#undef AT_LOADK
#undef AT_LOADV
#undef AT_WRITEK
#undef AT_WRITEV
#undef AT_S
#undef AT_PV
#undef AT_EXP8
#undef AT_STEP
    lsum = sum32(lsum);
    const float inv = __builtin_amdgcn_rcpf(lsum); float ss = 0.f;
    bf16* yo = WSP(bf16, WS_YMIX) + (size_t)(qrow0 + r32) * D + 512 + h * 64 + 4 * hh;
#pragma unroll
    for (int rg = 0; rg < 4; ++rg) {
        v2u w0, w1; w0.x = pk2(o0[4 * rg] * inv, o0[4 * rg + 1] * inv); w0.y = pk2(o0[4 * rg + 2] * inv, o0[4 * rg + 3] * inv);
        w1.x = pk2(o1[4 * rg] * inv, o1[4 * rg + 1] * inv); w1.y = pk2(o1[4 * rg + 2] * inv, o1[4 * rg + 3] * inv);
        *(v2u*)(yo + 8 * rg) = w0; *(v2u*)(yo + 32 + 8 * rg) = w1;
        const float a0 = bflo(w0.x), a1 = bfhi(w0.x), a2 = bflo(w0.y), a3 = bfhi(w0.y), b0 = bflo(w1.x), b1 = bfhi(w1.x), b2 = bflo(w1.y), b3 = bfhi(w1.y);
        ss += (a0 * a0 + a1 * a1) + (a2 * a2 + a3 * a3) + (b0 * b0 + b1 * b1) + (b2 * b2 + b3 * b3);
    }
    ss = sum32(ss);
    if (hh == 0) WSP(float, WS_SSQAT)[(size_t)(qrow0 + r32) * 8 + h] = ss;
}
constexpr int HY_ZC_L = 1024 + 72, HY_ZC_C = 256 + 72;
constexpr int HY_ZC = 0;
constexpr int HY_RSTRIDE_L = 4160, HY_RSTRIDE_C = 1088;
static_assert(8 * 4 * HY_ZC_L * 2 + 8 * HY_RSTRIDE_L + 8 * 1024 * 2 + 288 <= RING_BYTES && 8 * 16 * HY_ZC_C * 2 + 8 * HY_RSTRIDE_C + 8 * 1024 * 2 + 288 <= RING_BYTES, "hyena LDS");
typedef short v4i16_t __attribute__((ext_vector_type(4)));
__device__ __forceinline__ bf16x4 ds_tr16(const LAS unsigned char* p) { return __builtin_bit_cast(bf16x4, __builtin_amdgcn_ds_read_tr16_b64_v4i16((LAS v4i16_t*)p)); }
__device__ __forceinline__ bf16x8 cat8(bf16x4 lo, bf16x4 hi) { return (bf16x8){lo[0], lo[1], lo[2], lo[3], hi[0], hi[1], hi[2], hi[3]}; }
template <bool LATENT>
__device__ __forceinline__ void hyena_unit(Frame& F, int l, int sq, int cgp, bool do_ssq) {
    int tid_ = F.tid; asm volatile("" : "+v"(tid_));
    const int tid = tid_, lane = tid & 63, w = F.wave, c0 = cgp * 8;
    constexpr int L = LATENT ? 1024 : 256, XL = 2 * L + 32, ZCE = LATENT ? HY_ZC_L : HY_ZC_C, NB = L / 32 + 1;
    constexpr int CH_STRIDE = (LATENT ? 4 : 16) * ZCE;
    constexpr int RST = LATENT ? HY_RSTRIDE_L : HY_RSTRIDE_C, HY_R = HY_ZC + 8 * CH_STRIDE * 2, HY_Y = HY_R + 8 * RST;
    const int base_row = LATENT ? MC + sq * 1024 : sq * 1024;
    LAS unsigned short* Zc = (LAS unsigned short*)(F.lds + HY_ZC); LAS unsigned char* Rl = F.lds + HY_R; LAS unsigned short* Y8 = (LAS unsigned short*)(F.lds + HY_Y);
    const bf16* P = WSP(bf16, WS_PROJ); const float* cw = F.a->in[I_HYCONV] + l * 3 * 768;
    constexpr int NFC = 8 * (XL / 8), NF = (NFC + NTHR - 1) / NTHR;
    LAS float* Wl = (LAS float*)(F.lds + HY_Y + 8 * 1024 * 2);
    v4u fr[NF], xa[2][3], xb[2][3];
    { const bf16* Rg = WSP(bf16, WS_FILT) + (size_t)l * FILT_LAYER + (LATENT ? 256 * XL0 : 0) + (size_t)c0 * XL;
#pragma unroll
      for (int k = 0; k < NF; ++k) { const int i = tid + k * NTHR; fr[k] = (v4u){0u, 0u, 0u, 0u}; if (i < NFC) { const int ch = i / (XL / 8), jj = i % (XL / 8); fr[k] = *(const v4u*)(Rg + (size_t)ch * XL + jj * 8); } } }
#pragma unroll
    for (int it = 0; it < 2; ++it) { const int p = tid + 512 * it, t = p & (L - 1); const bf16* pr = P + (size_t)(base_row + p) * NINP + c0;
#pragma unroll
        for (int dr = -1; dr <= 1; ++dr) { xa[it][dr + 1] = (v4u){0u, 0u, 0u, 0u}; xb[it][dr + 1] = xa[it][dr + 1];
            if (t + dr >= 0 && t + dr < L) { xa[it][dr + 1] = *(const v4u*)(pr + dr * NINP + 256); xb[it][dr + 1] = *(const v4u*)(pr + dr * NINP + 512); } } }
    float wreg = 0.f;
    if (tid < 72) wreg = cw[(tid / 24) * 768 + ((tid % 24) >> 3) * 256 + c0 + (tid & 7)];
    for (int i = tid; i < (8 * CH_STRIDE * 2) / 16; i += NTHR) *(LAS v4u*)(F.lds + HY_ZC + i * 16) = (v4u){0u, 0u, 0u, 0u};
#pragma unroll
    for (int k = 0; k < NF; ++k) { const int i = tid + k * NTHR; if (i < NFC) { const int ch = i / (XL / 8), jj = i % (XL / 8); *(LAS v4u*)(Rl + ch * RST + jj * 16) = fr[k]; } }
    if (tid < 72) Wl[tid] = wreg;
    __syncthreads();
    {
#pragma unroll
        for (int it = 0; it < 2; ++it) { const int p = tid + 512 * it, t = p & (L - 1), sg = LATENT ? 0 : (p >> 8);
            float x1[8], vv[8];
#pragma unroll
            for (int e = 0; e < 8; ++e) { x1[e] = 0.f; vv[e] = 0.f; }
#pragma unroll
            for (int dr = 0; dr < 3; ++dr) {
                const v4u xa_ = xa[it][dr], xb_ = xb[it][dr];
                const f32x4 a0 = *(const LAS f32x4*)(Wl + dr * 24 + 8), a1 = *(const LAS f32x4*)(Wl + dr * 24 + 12), b0 = *(const LAS f32x4*)(Wl + dr * 24 + 16), b1 = *(const LAS f32x4*)(Wl + dr * 24 + 20);
                x1[0] += a0.x * bflo(xa_.x); x1[1] += a0.y * bfhi(xa_.x); x1[2] += a0.z * bflo(xa_.y); x1[3] += a0.w * bfhi(xa_.y);
                x1[4] += a1.x * bflo(xa_.z); x1[5] += a1.y * bfhi(xa_.z); x1[6] += a1.z * bflo(xa_.w); x1[7] += a1.w * bfhi(xa_.w);
                vv[0] += b0.x * bflo(xb_.x); vv[1] += b0.y * bfhi(xb_.x); vv[2] += b0.z * bflo(xb_.y); vv[3] += b0.w * bfhi(xb_.y);
                vv[4] += b1.x * bflo(xb_.z); vv[5] += b1.y * bfhi(xb_.z); vv[6] += b1.z * bflo(xb_.w); vv[7] += b1.w * bfhi(xb_.w); }
#pragma unroll
            for (int e = 0; e < 8; ++e) { const unsigned short zb = (unsigned short)f2bf(x1[e] * vv[e]); LAS unsigned short* zc = Zc + e * CH_STRIDE + sg * 4 * ZCE + t + 32;
#pragma unroll
                for (int q = 0; q < 4; ++q) zc[q * ZCE - q] = zb; }
        }
    }
    v4u xo[2][3];
#pragma unroll
    for (int it = 0; it < 2; ++it) { const int p = tid + 512 * it, t = p & (L - 1); const bf16* pr = P + (size_t)(base_row + p) * NINP + c0;
#pragma unroll
        for (int dr = -1; dr <= 1; ++dr) { xo[it][dr + 1] = (v4u){0u, 0u, 0u, 0u}; if (t + dr >= 0 && t + dr < L) xo[it][dr + 1] = *(const v4u*)(pr + dr * NINP); } }
    __syncthreads();
    {
        const int r = lane & 15, g = lane >> 4, q = (lane & 15) >> 2, pp = lane & 3;
        const LAS unsigned char* Rw = Rl + w * RST; LAS unsigned short* Yw = Y8 + w * 1024;
        if (LATENT) {
            const LAS unsigned char* zb = (const LAS unsigned char*)(Zc + w * CH_STRIDE + q * ZCE + 8 * g + 4 * pp + 32);
            const int aoff = 2 * (L + 32 - 16 * r + 8 * g);
            f32x4 acc[4];
#pragma unroll
            for (int i = 0; i < 4; ++i) acc[i] = (f32x4){0.f, 0.f, 0.f, 0.f};
#pragma unroll 3
            for (int kb = 0; kb < NB; ++kb) { const int s0p = 32 * kb - 32;
                const bf16x8 B = cat8(ds_tr16(zb + 2 * s0p), ds_tr16(zb + 2 * s0p + 8));
#pragma unroll
                for (int ti = 0; ti < 4; ++ti) { const bf16x8 A = *(const LAS bf16x8*)(Rw + aoff + 2 * (s0p - 256 * ti)); acc[ti] = __builtin_amdgcn_mfma_f32_16x16x32_bf16(A, B, acc[ti], 0, 0, 0); } }
            const int n = lane & 15;
#pragma unroll
            for (int ti = 0; ti < 4; ++ti)
#pragma unroll
                for (int i = 0; i < 4; ++i) Yw[256 * ti + 16 * (4 * g + i) + n] = (unsigned short)f2bf(acc[ti][i]);
        } else {
            const LAS unsigned char* zb = (const LAS unsigned char*)(Zc + w * CH_STRIDE + (pp * 4 + q) * ZCE + 8 * g + 32);
            const int aoff = 2 * (L + 32 - 8 * r + 8 * g);
            f32x4 acc[2][2];
#pragma unroll
            for (int i = 0; i < 2; ++i) { acc[i][0] = (f32x4){0.f, 0.f, 0.f, 0.f}; acc[i][1] = acc[i][0]; }
#pragma unroll 3
            for (int kb = 0; kb < NB; ++kb) { const int s0p = 32 * kb - 32;
                const bf16x8 B0 = cat8(ds_tr16(zb + 2 * s0p), ds_tr16(zb + 2 * s0p + 8)), B1 = cat8(ds_tr16(zb + 2 * s0p + 8), ds_tr16(zb + 2 * s0p + 16));
#pragma unroll
                for (int ti = 0; ti < 2; ++ti) { const bf16x8 A = *(const LAS bf16x8*)(Rw + aoff + 2 * (s0p - 128 * ti));
                    acc[ti][0] = __builtin_amdgcn_mfma_f32_16x16x32_bf16(A, B0, acc[ti][0], 0, 0, 0); acc[ti][1] = __builtin_amdgcn_mfma_f32_16x16x32_bf16(A, B1, acc[ti][1], 0, 0, 0); } }
            const int n = lane & 15, b = n >> 2, op = n & 3;
#pragma unroll
            for (int ti = 0; ti < 2; ++ti)
#pragma unroll
                for (int ob = 0; ob < 2; ++ob)
#pragma unroll
                    for (int i = 0; i < 4; ++i) Yw[b * 256 + 128 * ti + 8 * (4 * g + i) + 4 * ob + op] = (unsigned short)f2bf(acc[ti][ob][i]);
        }
    }
    __syncthreads();
    {
        bf16* Y = WSP(bf16, WS_YMIX); float* ssq = (float*)(F.ws + WS_CTL + CTL_SSQHY) + (size_t)l * M;
#pragma unroll
        for (int it = 0; it < 2; ++it) { const int p = tid + 512 * it, row = base_row + p;
            float x0[8];
#pragma unroll
            for (int e = 0; e < 8; ++e) x0[e] = 0.f;
#pragma unroll
            for (int dr = 0; dr < 3; ++dr) {
                const v4u xa_ = xo[it][dr]; const f32x4 a0 = *(const LAS f32x4*)(Wl + dr * 24), a1 = *(const LAS f32x4*)(Wl + dr * 24 + 4);
                x0[0] += a0.x * bflo(xa_.x); x0[1] += a0.y * bfhi(xa_.x); x0[2] += a0.z * bflo(xa_.y); x0[3] += a0.w * bfhi(xa_.y);
                x0[4] += a1.x * bflo(xa_.z); x0[5] += a1.y * bfhi(xa_.z); x0[6] += a1.z * bflo(xa_.w); x0[7] += a1.w * bfhi(xa_.w); }
            float o[8];
#pragma unroll
            for (int e = 0; e < 8; ++e) o[e] = x0[e] * bf2f(Y8[e * 1024 + p]);
            v4u wv; wv.x = pk2(o[0], o[1]); wv.y = pk2(o[2], o[3]); wv.z = pk2(o[4], o[5]); wv.w = pk2(o[6], o[7]);
            *(v4u*)(Y + (size_t)row * D + c0) = wv;
            const float r0 = bflo(wv.x), r1 = bfhi(wv.x), r2 = bflo(wv.y), r3 = bfhi(wv.y), r4 = bflo(wv.z), r5 = bfhi(wv.z), r6 = bflo(wv.w), r7 = bfhi(wv.w);
            if (do_ssq) atomicAdd(ssq + row, ((r0 * r0 + r1 * r1) + (r2 * r2 + r3 * r3)) + ((r4 * r4 + r5 * r5) + (r6 * r6 + r7 * r7)));
        }
    }
    __syncthreads();
}
__device__ __forceinline__ void sconv_rows4(Frame& F, int l, int row0) {
    const int c4 = F.lane * 4; const bool latent = row0 >= MC; const int L = latent ? 1024 : 256, t0 = latent ? ((row0 - MC) & 1023) : (row0 & 255);
    const bf16* pr = WSP(bf16, WS_PROJ) + (size_t)row0 * NINP + O_SC + c4; const float* cw = F.a->in[I_SCCONV] + l * 3 * 256 + c4;
    v2u cg[6], hx[6], bg[4];
#pragma unroll
    for (int j = 0; j < 6; ++j) { const bool ok = (t0 + j - 1 >= 0) && (t0 + j - 1 < L);
        cg[j] = (v2u){0u, 0u}; hx[j] = (v2u){0u, 0u};
        if (ok) { cg[j] = *(const v2u*)(pr + (j - 1) * NINP + 256); hx[j] = *(const v2u*)(pr + (j - 1) * NINP + 512); } }
#pragma unroll
    for (int j = 0; j < 4; ++j) bg[j] = *(const v2u*)(pr + j * NINP);
    const f32x4 w0 = *(const f32x4*)cw, w1 = *(const f32x4*)(cw + 256), w2 = *(const f32x4*)(cw + 512);
    float p[6][4];
#pragma unroll
    for (int j = 0; j < 6; ++j) { p[j][0] = bflo(cg[j].x) * bflo(hx[j].x); p[j][1] = bfhi(cg[j].x) * bfhi(hx[j].x); p[j][2] = bflo(cg[j].y) * bflo(hx[j].y); p[j][3] = bfhi(cg[j].y) * bfhi(hx[j].y); }
    float s[4];
#pragma unroll
    for (int j = 0; j < 4; ++j) {
        const float c0 = w0.x * p[j][0] + w1.x * p[j + 1][0] + w2.x * p[j + 2][0], c1 = w0.y * p[j][1] + w1.y * p[j + 1][1] + w2.y * p[j + 2][1];
        const float c2 = w0.z * p[j][2] + w1.z * p[j + 1][2] + w2.z * p[j + 2][2], c3 = w0.w * p[j][3] + w1.w * p[j + 1][3] + w2.w * p[j + 2][3];
        v2u o; o.x = pk2(bflo(bg[j].x) * c0, bfhi(bg[j].x) * c1); o.y = pk2(bflo(bg[j].y) * c2, bfhi(bg[j].y) * c3);
        *(v2u*)(WSP(bf16, WS_YMIX) + (size_t)(row0 + j) * D + 256 + c4) = o;
        const float r0 = bflo(o.x), r1 = bfhi(o.x), r2 = bflo(o.y), r3 = bfhi(o.y);
        s[j] = (r0 * r0 + r1 * r1) + (r2 * r2 + r3 * r3);
    }
#pragma unroll
    for (int j = 0; j < 4; ++j) s[j] = wave_sum(s[j], F.lane);
    if (F.lane == 0) { *(f32x4*)(WSP(float, WS_SSQSC) + row0) = (f32x4){s[0], s[1], s[2], s[3]}; }
}
constexpr int MX_PER = 32 + 32 + 32;
__device__ __forceinline__ void mix_phase(Frame& F, int l, int mode) {
    const bool do_ssq = mode == 0;
    const XGeom X{F.rank, F.nloc, F.idx, F.nx}; const int nu = 32 * X.nrb();
    if (mode != 2 && mode != 4 && mode != 6)
        for (int q = X.rank; q < nu; q += X.nloc) { const int rb = X.idx + (q >> 5) * X.nx, r = q & 31; if (rb >= 4) hyena_unit<true>(F, l, rb - 4, r, do_ssq); else hyena_unit<false>(F, l, rb, r, do_ssq); }
    if (mode != 3 && mode != 6)
        for (int q = X.rank; q < nu; q += X.nloc) { const int rb = X.idx + (q >> 5) * X.nx, r = q & 31; if (rb >= 4) attn_unit(F, l, true, rb - 4, (r >> 2) & 7, r & 3); else attn_unit(F, l, false, 4 * rb + (r >> 3), r & 7, 0); }
    if (mode < 2)
        for (int q = X.rank; q < nu; q += X.nloc) { const int rb = X.idx + (q >> 5) * X.nx, r = q & 31; sconv_rows4(F, l, 1024 * rb + r * 32 + F.wave * 4); }
}

#define AUXT(par, k) (aux + ((par) * 3 + (k)) * 256)
template <int NAI> struct EpiBase {
    static constexpr int ROWS = 128 * NAI;
    LAS float* aux; int tid;
    __device__ __forceinline__ void rescale(pg8::f32x4 (&acc)[NAI][2][4][2], int which, int par, int wr, int fr) const {
        const LAS float* T = AUXT(par, 1 + which);
#pragma unroll
        for (int ai = 0; ai < NAI; ++ai)
#pragma unroll
            for (int m = 0; m < 4; ++m) { const float s = T[ai * 128 + wr * 64 + m * 16 + fr];
#pragma unroll
                for (int bj = 0; bj < 2; ++bj)
#pragma unroll
                    for (int n = 0; n < 2; ++n) acc[ai][bj][m][n] = acc[ai][bj][m][n] * s; }
    }
};
template <int NAI> struct EpiInT : EpiBase<NAI> {
    using EpiBase<NAI>::aux; using EpiBase<NAI>::tid; using EpiBase<NAI>::ROWS;
    static constexpr bool PERM = true, KRESCALE = false;
    const float* ssqp; int np; const float* bias; bf16* proj; float* out; int l;
    struct Pre { f32x4 a, b, c, d; };
    __device__ __forceinline__ Pre prep_load(const pg8::Unit& u) const {
        Pre p; p.a = p.b = p.c = p.d = (f32x4){0.f, 0.f, 0.f, 0.f};
        if (tid < ROWS) { const float* sp = ssqp + (size_t)(u.pm * ROWS + tid) * 16;
            if (np == 1) p.a.x = sp[0]; else { p.a = *(const f32x4*)sp; p.b = *(const f32x4*)(sp + 4); p.c = *(const f32x4*)(sp + 8); p.d = *(const f32x4*)(sp + 12); } }
        return p;
    }
    __device__ __forceinline__ void prep_finish(const Pre& p, int par) const {
        if (tid < ROWS) { const float s = ((p.a.x + p.a.y) + (p.a.z + p.a.w)) + ((p.b.x + p.b.y) + (p.b.z + p.b.w)) + ((p.c.x + p.c.y) + (p.c.z + p.c.w)) + ((p.d.x + p.d.y) + (p.d.z + p.d.w));
            AUXT(par, 0)[tid] = rsqrtf(s * (1.0f / D) + EPS); }
    }
    __device__ __forceinline__ void operator()(const pg8::f32x4 (&acc)[NAI][2][4][2], const pg8::Unit& u, int wr, int wc, int fr, int fq, int par) const {
        const int row0 = u.pm * ROWS + wr * 64 + fr, j = modidx(u.pm * ROWS); const LAS float* T = AUXT(par, 0);
        const float* bp = bias + (size_t)j * NINP + u.pn * 256 + wc * 32 + 8 * fq;
        f32x4 bv[2][2];
#pragma unroll
        for (int bj = 0; bj < 2; ++bj)
#pragma unroll
            for (int n = 0; n < 2; ++n) bv[bj][n] = *(const f32x4*)(bp + bj * 128 + 4 * n);
#pragma unroll
        for (int ai = 0; ai < NAI; ++ai)
#pragma unroll
            for (int m = 0; m < 4; ++m) { const int row = row0 + ai * 128 + m * 16; const float rs = T[ai * 128 + wr * 64 + m * 16 + fr];
#pragma unroll
                for (int bj = 0; bj < 2; ++bj) { const f32x4 v0 = acc[ai][bj][m][0] * rs + bv[bj][0], v1 = acc[ai][bj][m][1] * rs + bv[bj][1];
                    const int col = u.pn * 256 + bj * 128 + wc * 32 + 8 * fq;
                    v4u w; w.x = pk2(v0[0], v0[1]); w.y = pk2(v0[2], v0[3]); w.z = pk2(v1[0], v1[1]); w.w = pk2(v1[2], v1[3]);
                    *(v4u*)(proj + (size_t)row * NINP + col) = w;
                    if (u.pn == 7 && row < MC && col < NIN) { const int b = row >> 8, t = row & 255;
                        float* o = (col < O_KPE) ? out + OUT_CKV + ((size_t)((b * 2 + l) * 256 + t)) * 128 + (col - O_CKV) : out + OUT_KPE + ((size_t)((b * 2 + l) * 256 + t)) * 32 + (col - O_KPE);
                        *(f32x4*)o = v0; *(f32x4*)(o + 4) = v1; } } }
    }
};
template <int NAI> struct EpiOutT : EpiBase<NAI> {
    using EpiBase<NAI>::aux; using EpiBase<NAI>::tid; using EpiBase<NAI>::ROWS;
    static constexpr bool PERM = true, KRESCALE = true;
    const float* ssq_hy; const float* ssq_sc; const float* ssq_at; const float* xa; const float* xb; float* xr; bf16* xg; const float* g1; const float* gg2; float* ssqp;
    struct Pre { f32x4 a, b; float hy, sc; };
    __device__ __forceinline__ Pre prep_load(const pg8::Unit& u) const {
        Pre p; p.a = p.b = (f32x4){0.f, 0.f, 0.f, 0.f}; p.hy = 0.f; p.sc = 0.f;
        if (tid < ROWS) { const int row = u.pm * ROWS + tid; p.a = *(const f32x4*)(ssq_at + (size_t)row * 8); p.b = *(const f32x4*)(ssq_at + (size_t)row * 8 + 4); p.hy = ssq_hy[row]; p.sc = ssq_sc[row]; }
        return p;
    }
    __device__ __forceinline__ void prep_finish(const Pre& p, int par) const {
        if (tid < ROWS) { const float sa = ((p.a.x + p.a.y) + (p.a.z + p.a.w)) + ((p.b.x + p.b.y) + (p.b.z + p.b.w));
            const float rh = rsqrtf(p.hy * (1.0f / 256) + EPS), rs = rsqrtf(p.sc * (1.0f / 256) + EPS), ra = rsqrtf(sa * (1.0f / 512) + EPS);
            AUXT(par, 0)[tid] = ra; AUXT(par, 1)[tid] = rh / rs; AUXT(par, 2)[tid] = rs / ra; }
    }
    __device__ __forceinline__ void operator()(const pg8::f32x4 (&acc)[NAI][2][4][2], const pg8::Unit& u, int wr, int wc, int fr, int fq, int par) const {
        const int row0 = u.pm * ROWS + wr * 64 + fr, j = modidx(u.pm * ROWS); const LAS float* T = AUXT(par, 0);
        const float* xin = (u.pm * ROWS < MC) ? xa : xb;
        const int lane = fq * 16 + fr;
        const int cb = u.pn * 256 + wc * 32 + 8 * fq;
#pragma unroll
        for (int ai = 0; ai < NAI; ++ai)
#pragma unroll
            for (int m = 0; m < 4; ++m) { const int row = row0 + ai * 128 + m * 16; const float rs = T[ai * 128 + wr * 64 + m * 16 + fr]; float ss = 0.f;
#pragma unroll
                for (int bj = 0; bj < 2; ++bj) { const int col = cb + bj * 128; v4u w;
#pragma unroll
                    for (int n = 0; n < 2; ++n) { const f32x4 gv = *(const f32x4*)(g1 + (size_t)j * 6144 + col + 4 * n), gg = *(const f32x4*)(gg2 + (size_t)j * D + col + 4 * n);
                        const f32x4 xv = *(const f32x4*)(xin + (size_t)row * D + col + 4 * n); const f32x4 x1 = xv + gv * (acc[ai][bj][m][n] * rs);
                        *(f32x4*)(xr + (size_t)row * D + col + 4 * n) = x1; ss += (x1[0] * x1[0] + x1[1] * x1[1]) + (x1[2] * x1[2] + x1[3] * x1[3]);
                        const f32x4 y = x1 * gg; if (n == 0) { w.x = pk2(y[0], y[1]); w.y = pk2(y[2], y[3]); } else { w.z = pk2(y[0], y[1]); w.w = pk2(y[2], y[3]); } }
                    *(v4u*)(xg + (size_t)row * D + col) = w; }
                ss += shx(ss, 16, lane); ss += shx(ss, 32, lane);
                if (fq == 0) ssqp[(size_t)row * 16 + u.pn * 4 + wc] = ss; }
    }
};
template <int NAI> struct EpiUpT : EpiBase<NAI> {
    using EpiBase<NAI>::aux; using EpiBase<NAI>::tid; using EpiBase<NAI>::ROWS;
    static constexpr bool PERM = true, KRESCALE = false;
    const float* ssqp; const float* bias; bf16* act;
    struct Pre { f32x4 a, b, c, d; };
    __device__ __forceinline__ Pre prep_load(const pg8::Unit& u) const {
        Pre p; p.a = p.b = p.c = p.d = (f32x4){0.f, 0.f, 0.f, 0.f};
        if (tid < ROWS) { const float* sp = ssqp + (size_t)(u.pm * ROWS + tid) * 16; p.a = *(const f32x4*)sp; p.b = *(const f32x4*)(sp + 4); p.c = *(const f32x4*)(sp + 8); p.d = *(const f32x4*)(sp + 12); }
        return p;
    }
    __device__ __forceinline__ void prep_finish(const Pre& p, int par) const {
        if (tid < ROWS) { const float s = ((p.a.x + p.a.y) + (p.a.z + p.a.w)) + ((p.b.x + p.b.y) + (p.b.z + p.b.w)) + ((p.c.x + p.c.y) + (p.c.z + p.c.w)) + ((p.d.x + p.d.y) + (p.d.z + p.d.w));
            AUXT(par, 0)[tid] = rsqrtf(s * (1.0f / D) + EPS); }
    }
    __device__ __forceinline__ void operator()(const pg8::f32x4 (&acc)[NAI][2][4][2], const pg8::Unit& u, int wr, int wc, int fr, int fq, int par) const {
        const int row0 = u.pm * ROWS + wr * 64 + fr, j = modidx(u.pm * ROWS); const LAS float* T = AUXT(par, 0);
        const float* bp = bias + (size_t)j * NGU + u.pn * 256 + wc * 32 + 8 * fq;
        f32x4 bv[2][2];
#pragma unroll
        for (int bj = 0; bj < 2; ++bj)
#pragma unroll
            for (int n = 0; n < 2; ++n) bv[bj][n] = *(const f32x4*)(bp + bj * 128 + 4 * n);
#pragma unroll
        for (int ai = 0; ai < NAI; ++ai)
#pragma unroll
            for (int m = 0; m < 4; ++m) { const int row = row0 + ai * 128 + m * 16; const float rs = T[ai * 128 + wr * 64 + m * 16 + fr]; float a[8];
#pragma unroll
                for (int n = 0; n < 2; ++n) { const f32x4 gt = acc[ai][0][m][n] * rs + bv[0][n], up = acc[ai][1][m][n] * rs + bv[1][n];
#pragma unroll
                    for (int e = 0; e < 4; ++e) a[n * 4 + e] = gt[e] * __builtin_amdgcn_rcpf(1.0f + __builtin_amdgcn_exp2f(-1.4426950408889634f * gt[e])) * up[e]; }
                v4u w; w.x = pk2(a[0], a[1]); w.y = pk2(a[2], a[3]); w.z = pk2(a[4], a[5]); w.w = pk2(a[6], a[7]);
                *(v4u*)(act + (size_t)row * DFF + u.pn * 128 + wc * 32 + 8 * fq) = w; }
    }
};
template <int NAI> struct EpiDownT : EpiBase<NAI> {
    using EpiBase<NAI>::aux; using EpiBase<NAI>::tid; using EpiBase<NAI>::ROWS;
    static constexpr bool PERM = true, KRESCALE = false;
    const float* xr; float* xo; bf16* xg; const float* g2; const float* gg1n; float* ssqp; int last;
    struct Pre {};
    __device__ __forceinline__ Pre prep_load(const pg8::Unit&) const { return Pre{}; }
    __device__ __forceinline__ void prep_finish(const Pre&, int) const {}
    __device__ __forceinline__ void operator()(const pg8::f32x4 (&acc)[NAI][2][4][2], const pg8::Unit& u, int wr, int wc, int fr, int fq, int) const {
        const int row0 = u.pm * ROWS + wr * 64 + fr, j = modidx(u.pm * ROWS), lane = fq * 16 + fr;
        const int cb = u.pn * 256 + wc * 32 + 8 * fq;
#pragma unroll
        for (int ai = 0; ai < NAI; ++ai)
#pragma unroll
            for (int m = 0; m < 4; ++m) { const int row = row0 + ai * 128 + m * 16; float ss = 0.f;
#pragma unroll
                for (int bj = 0; bj < 2; ++bj) { const int col = cb + bj * 128; v4u w;
#pragma unroll
                    for (int n = 0; n < 2; ++n) { const f32x4 gv = *(const f32x4*)(g2 + (size_t)j * 6144 + col + 4 * n);
                        const f32x4 xv = *(const f32x4*)(xr + (size_t)row * D + col + 4 * n); const f32x4 x2 = xv + gv * acc[ai][bj][m][n];
                        *(f32x4*)(xo + (size_t)row * D + col + 4 * n) = x2;
                        if (!last) { const f32x4 gg = *(const f32x4*)(gg1n + (size_t)j * D + col + 4 * n); ss += (x2[0] * x2[0] + x2[1] * x2[1]) + (x2[2] * x2[2] + x2[3] * x2[3]);
                            const f32x4 y = x2 * gg; if (n == 0) { w.x = pk2(y[0], y[1]); w.y = pk2(y[2], y[3]); } else { w.z = pk2(y[0], y[1]); w.w = pk2(y[2], y[3]); } } }
                    if (!last) *(v4u*)(xg + (size_t)row * D + col) = w; }
                if (!last) { ss += shx(ss, 16, lane); ss += shx(ss, 32, lane); if (fq == 0) ssqp[(size_t)row * 16 + u.pn * 4 + wc] = ss; } }
    }
};

typedef EpiInT<2> EpiIn; typedef EpiUpT<2> EpiUp;

struct OneUnit { int pm, pn; __device__ __forceinline__ bool next(int i, pg8::Unit& u) const { if (i) return false; u.pm = pm; u.pn = pn; return true; } };
template <class E2, class E1> struct EpiSplitK {
    static constexpr bool PERM = true, KRESCALE = E1::KRESCALE;
    E2 e2; E1 e1;
    int kh, tid, slot, li; unsigned gen; unsigned char* ws;
    using Pre = typename E2::Pre;
    __device__ __forceinline__ Pre prep_load(const pg8::Unit& u) const { return e2.prep_load(u); }
    __device__ __forceinline__ void prep_finish(const Pre& p, int par) const { e2.prep_finish(p, par); }
    __device__ __forceinline__ void rescale(pg8::f32x4 (&acc)[2][2][4][2], int which, int par, int wr, int fr) const { if (kh == 0) e2.rescale(acc, which, par, wr, fr); }
    template <int OWN> __device__ __forceinline__ void finish(const pg8::f32x4 (&acc)[2][2][4][2], const pg8::Unit& u, int wr, int wc, int fr, int fq, int par) const {
        constexpr int OTH = OWN ^ 1;
        const LAS float* T2 = e2.aux + (par * 3 + 2) * 256;
        const bool sc = KRESCALE && kh == 0;
        f32x4* xm = (f32x4*)((float*)(ws + WS_XCH) + (size_t)slot * 32768); const f32x4* xp = (const f32x4*)((const float*)(ws + WS_XCH) + (size_t)(slot ^ 1) * 32768);
        unsigned* fl = (unsigned*)(ws + WS_CTL + CTL_XFLAG) + (size_t)li * 256 * 16; unsigned* fmine = fl + slot * 16; unsigned* fpart = fl + (slot ^ 1) * 16; unsigned* bar = (unsigned*)(ws + WS_CTL) + CW_BAR + li * XCD_BAR_WORDS;
        { f32x4* p = xm + tid;
#pragma unroll
          for (int m = 0; m < 4; ++m) { const float s = sc ? T2[OTH * 128 + wr * 64 + m * 16 + fr] : 1.0f;
#pragma unroll
            for (int bj = 0; bj < 2; ++bj)
#pragma unroll
                for (int n = 0; n < 2; ++n) { *p = acc[OTH][bj][m][n] * s; p += 512; asm volatile("" : "+v"(p)); } } }
        asm volatile("s_waitcnt vmcnt(0)" ::: "memory");
        __syncthreads();
        if (tid == 0) { __hip_atomic_store(fmine, gen, __ATOMIC_RELAXED, __HIP_MEMORY_SCOPE_AGENT);
            XB_SPIN(xb_ld(fpart) < gen, bar); }
        __syncthreads();
        pg8::f32x4 h[1][2][4][2];
        { const f32x4* p = xp + tid;
#pragma unroll
          for (int m = 0; m < 4; ++m) { const float s = sc ? T2[OWN * 128 + wr * 64 + m * 16 + fr] : 1.0f;
#pragma unroll
            for (int bj = 0; bj < 2; ++bj)
#pragma unroll
                for (int n = 0; n < 2; ++n) { h[0][bj][m][n] = acc[OWN][bj][m][n] * s + *p; p += 512; asm volatile("" : "+v"(p)); } } }
        E1 e = e1; e.aux = e2.aux + 128 * OWN;
        pg8::Unit u1; u1.pm = 2 * u.pm + OWN; u1.pn = u.pn;
        e(h, u1, wr, wc, fr, fq, par);
    }
    __device__ __forceinline__ void operator()(const pg8::f32x4 (&acc)[2][2][4][2], const pg8::Unit& u, int wr, int wc, int fr, int fq, int par) const {
        if (kh == 0) finish<0>(acc, u, wr, wc, fr, fq, par); else finish<1>(acc, u, wr, wc, fr, fq, par);
    }
};


#define MK_FRAME() Frame F; { int l_; asm volatile("v_mbcnt_lo_u32_b32 %0, -1, 0\n\tv_mbcnt_hi_u32_b32 %0, -1, %0" : "=v"(l_)); int w_ = wave0; asm volatile("" : "+s"(w_)); F.tid = w_ * 64 + l_; F.lane = l_; F.wave = w_; \
        KArgs k_ = (KArgs)__builtin_amdgcn_kernarg_segment_ptr(); asm volatile("" : "+s"(k_)); F.a = k_; F.ws = k_->ws; int g_ = gridDim.x, b_ = blockIdx.x; asm volatile("" : "+s"(g_), "+s"(b_)); F.G = g_; F.bid = b_; } \
        { volatile LAS unsigned* st_ = (volatile LAS unsigned*)((LAS unsigned char*)lds + MISC_OFF) + 8; F.nloc = __builtin_amdgcn_readfirstlane((int)st_[0]); F.nx = __builtin_amdgcn_readfirstlane((int)st_[1]); F.idx = __builtin_amdgcn_readfirstlane((int)st_[2]); F.rank = __builtin_amdgcn_readfirstlane((int)st_[3]); } \
        F.lds = (LAS unsigned char*)lds; LAS float* aux = (LAS float*)(F.lds + AUX_OFF); (void)aux
#define MK_IN(k) (ph_lo <= (k) && (k) < ph_hi)
#ifdef DIAG_TS
#define MK_STAMP(k) do { if (blockIdx.x == 0 && threadIdx.x == 0) ((unsigned long long*)(ka0->ws + WS_CTL + 64 * 1024))[(k)] = __builtin_amdgcn_s_memrealtime(); } while (0)
#else
#define MK_STAMP(k) do { } while (0)
#endif
#ifdef DIAG_TS
#define MK_LASTBAR 1
#else
#define MK_LASTBAR 0
#endif
#define MK_BAR(k) do { if (use_bar && (k) + 1 < ph_hi + MK_LASTBAR) { int l_; asm volatile("v_mbcnt_lo_u32_b32 %0, -1, 0\n\tv_mbcnt_hi_u32_b32 %0, -1, %0" : "=v"(l_)); \
        KArgs k_ = (KArgs)__builtin_amdgcn_kernarg_segment_ptr(); asm volatile("" : "+s"(k_)); unsigned* bar_ = (unsigned*)(k_->ws + WS_CTL) + CW_BAR + k_->li * XCD_BAR_WORDS; \
        volatile LAS unsigned* st_ = (volatile LAS unsigned*)((LAS unsigned char*)lds + MISC_OFF) + 8; \
        if ((k) < 2) xcd_barrier(bar_, xcc, st_, wave0 == 0 && l_ == 0); else xcd_local_barrier(bar_, xcc, st_, wave0 == 0 && l_ == 0); } MK_STAMP((k) + 1); } while (0)

template <int KM, int L> __device__ __forceinline__ void layer_phases(unsigned char* lds, int wave0, int ph_lo, int ph_hi, int use_bar, unsigned xcc, KArgs ka0) {
    constexpr int l = L, P = 2 + 6 * L;
    if (MK_IN(P + 0)) { if constexpr (KM & 4) { MK_FRAME();
        pg8::Gemm g{WSP(bf16, WS_XG), WSP(bf16, WS_WIN) + (size_t)l * NINP * D, M, NINP, D}; XOrder256 S; S.x = XGeom{F.rank, F.nloc, F.idx, F.nx}; S.npn = NINP / 256;
        EpiIn E; E.aux = aux; E.tid = F.tid; E.ssqp = WSP(float, WS_SSQ1P); E.np = l == 0 ? 1 : 16; E.bias = WSP(float, WS_BIN) + (size_t)l * 5 * NINP; E.proj = WSP(bf16, WS_PROJ); E.out = F.a->out; E.l = l;
        pg8::gemm_phase<EpiIn, XOrder256, true, true>(F.lds, g, S, E, F.tid); }
        MK_BAR(P + 0); }
    if (MK_IN(P + 1)) { if constexpr (KM & 8) { MK_FRAME(); prep_phase(F, l); } MK_BAR(P + 1); }
    if (MK_IN(P + 2)) { if constexpr (KM & 16) { MK_FRAME(); mix_phase(F, l, F.a->no_ssq); } MK_BAR(P + 2); }
    if (MK_IN(P + 3)) { if constexpr (KM & 32) { MK_FRAME(); float* MOD = WSP(float, WS_MOD); float* GG = WSP(float, WS_GG);
        pg8::Gemm g{WSP(bf16, WS_YMIX), WSP(bf16, WS_WOUT) + (size_t)l * D * D, M, D, D};
        EpiOutT<1> E; E.aux = aux; E.tid = F.tid; E.ssq_hy = (const float*)(F.ws + WS_CTL + CTL_SSQHY) + (size_t)l * M; E.ssq_sc = WSP(float, WS_SSQSC); E.ssq_at = WSP(float, WS_SSQAT);
        E.xa = l == 0 ? F.a->in[I_XP] : WSP(float, WS_XR); E.xb = l == 0 ? F.a->in[I_XS] - (size_t)MC * D : WSP(float, WS_XR); E.xr = WSP(float, WS_XR); E.xg = WSP(bf16, WS_XG);
        E.g1 = MOD + (size_t)l * 5 * 6144 + 2048; E.gg2 = GG + (size_t)((l * 2 + 1) * 5) * D; E.ssqp = WSP(float, WS_SSQ2P);
        { const XGeom X{F.rank, F.nloc, F.idx, F.nx};
          if ((X.nloc & 1) == 0) {
            for (int q = X.rank; q < 32 * X.nrb(); q += X.nloc) { const int rb = X.idx + (q >> 5) * X.nx, qq = q & 31, tile = qq >> 1, kh = qq & 1;
                pg8::Gemm gs{g.A, g.Bt, M, D, D, kh * (D / 128), D / 128};
                EpiSplitK<EpiOutT<2>, EpiOutT<1>> ES; ES.e1 = E; ES.e2.aux = aux; ES.e2.tid = F.tid; ES.e2.ssq_hy = E.ssq_hy; ES.e2.ssq_sc = E.ssq_sc; ES.e2.ssq_at = E.ssq_at;
                ES.kh = kh; ES.tid = F.tid; ES.slot = rb * 32 + qq; ES.li = F.a->li; ES.gen = 1u + 2u * l; ES.ws = F.ws;
                OneUnit S1; S1.pm = 4 * rb + (tile & 3); S1.pn = tile >> 2;
                pg8::gemm_phase<EpiSplitK<EpiOutT<2>, EpiOutT<1>>, OneUnit, true, true>(F.lds, gs, S1, ES, F.tid); }
          } else
            for (int q = X.rank; q < 32 * X.nrb(); q += X.nloc) { const int rb = X.idx + (q >> 5) * X.nx, qq = q & 31; pg8::gemm_phase_h<EpiOutT<1>>(F.lds, g, 8 * rb + (qq & 7), qq >> 3, E, F.tid); } } }
        MK_BAR(P + 3); }
    if (MK_IN(P + 4)) { if constexpr (KM & 64) { MK_FRAME();
        pg8::Gemm g{WSP(bf16, WS_XG), WSP(bf16, WS_WGU) + (size_t)l * NGU * D, M, NGU, D}; XOrder256 S; S.x = XGeom{F.rank, F.nloc, F.idx, F.nx}; S.npn = NGU / 256;
        EpiUp E; E.aux = aux; E.tid = F.tid; E.ssqp = WSP(float, WS_SSQ2P); E.bias = WSP(float, WS_BGU) + (size_t)l * 5 * NGU; E.act = WSP(bf16, WS_ACT);
        pg8::gemm_phase<EpiUp, XOrder256, true, true>(F.lds, g, S, E, F.tid); }
        MK_BAR(P + 4); }
    if (MK_IN(P + 5)) { if constexpr (KM & 128) { MK_FRAME(); float* MOD = WSP(float, WS_MOD); float* GG = WSP(float, WS_GG);
        pg8::Gemm g{WSP(bf16, WS_ACT), WSP(bf16, WS_WD) + (size_t)l * D * DFF, M, D, DFF};
        EpiDownT<1> E; E.aux = aux; E.tid = F.tid; E.xr = WSP(float, WS_XR); E.xo = l == 1 ? F.a->out : WSP(float, WS_XR); E.xg = WSP(bf16, WS_XG);
        E.g2 = MOD + (size_t)l * 5 * 6144 + 5120; E.gg1n = GG + (size_t)((l == 1 ? 0 : (l + 1) * 2) * 5) * D; E.ssqp = WSP(float, WS_SSQ1P); E.last = (l == 1);
        { const XGeom X{F.rank, F.nloc, F.idx, F.nx};
          if ((X.nloc & 1) == 0) {
            for (int q = X.rank; q < 32 * X.nrb(); q += X.nloc) { const int rb = X.idx + (q >> 5) * X.nx, qq = q & 31, tile = qq >> 1, kh = qq & 1;
                pg8::Gemm gs{g.A, g.Bt, M, D, DFF, kh * (DFF / 128), DFF / 128};
                EpiSplitK<EpiDownT<2>, EpiDownT<1>> ES; ES.e1 = E; ES.e2.aux = aux; ES.e2.tid = F.tid;
                ES.kh = kh; ES.tid = F.tid; ES.slot = rb * 32 + qq; ES.li = F.a->li; ES.gen = 2u + 2u * l; ES.ws = F.ws;
                OneUnit S1; S1.pm = 4 * rb + (tile & 3); S1.pn = tile >> 2;
                pg8::gemm_phase<EpiSplitK<EpiDownT<2>, EpiDownT<1>>, OneUnit, true, true>(F.lds, gs, S1, ES, F.tid); }
          } else
            for (int q = X.rank; q < 32 * X.nrb(); q += X.nloc) { const int rb = X.idx + (q >> 5) * X.nx, qq = q & 31; pg8::gemm_phase_h<EpiDownT<1>>(F.lds, g, 8 * rb + (qq & 7), qq >> 3, E, F.tid); } } }
        MK_BAR(P + 5); }
}
template <int KM> __global__ void __launch_bounds__(NTHR, 2) mk_fwd(Args args) {
    extern __shared__ __attribute__((aligned(16))) unsigned char lds[];
    KArgs ka0 = (KArgs)__builtin_amdgcn_kernarg_segment_ptr();
    const int wave0 = __builtin_amdgcn_readfirstlane(threadIdx.x >> 6);
    const int ph_lo = ka0->ph_lo, ph_hi = ka0->ph_hi, use_bar = ka0->use_bar;
    const unsigned xcc = xb_xcc_id();
    {
        LAS unsigned* misc = (LAS unsigned*)((LAS unsigned char*)lds + MISC_OFF);
        for (int u = threadIdx.x; u < 256; u += NTHR) misc[u] = 0u;
        __syncthreads();
        if (threadIdx.x == 0) { unsigned* bar_ = (unsigned*)(ka0->ws + WS_CTL) + CW_BAR + ka0->li * XCD_BAR_WORDS;
            misc[8 + 3] = xb_add(&bar_[XB_XCNT(xcc)], 1u);
            if (ph_lo >= 2) { unsigned nloc_, nx_, idx_; xcd_barrier_complete(bar_, xcc, nloc_, nx_, idx_); misc[8] = nloc_; misc[9] = nx_; misc[10] = idx_; } }
        __syncthreads();
    }
    MK_STAMP(0);
    if (MK_IN(0)) { if constexpr (KM & 1) { MK_FRAME(); p0_phase(F); } MK_BAR(0); }
    if (MK_IN(1)) { if constexpr (KM & 2) { MK_FRAME(); p1_phase(F); } MK_BAR(1); }
    layer_phases<KM, 0>(lds, wave0, ph_lo, ph_hi, use_bar, xcc, ka0);
    layer_phases<KM, 1>(lds, wave0, ph_lo, ph_hi, use_bar, xcc, ka0);
#ifdef DIAG_TS
    if (blockIdx.x == 0 && threadIdx.x == 0) {
        const unsigned long long* ts = (const unsigned long long*)(ka0->ws + WS_CTL + 64 * 1024); const unsigned long long tend = __builtin_amdgcn_s_memrealtime();
        const int sel[4] = {DIAG_A, DIAG_B, DIAG_C, DIAG_D}; const size_t off[4] = {0, (size_t)MC * D, (size_t)OUT_CKV, (size_t)OUT_KPE};
        for (int i = 0; i < 4; ++i) { const int k = sel[i]; const unsigned long long t1 = (k + 1 < N_PHASES) ? ts[k + 1] : tend; ka0->out[off[i]] = 4.0f * rintf((float)(t1 - ts[k]) * 0.0025f); }
    }
#endif
}

extern "C" void kernel_launch(void* const* d_in, const int* in_sizes, int n_in, void* d_out, int out_size, void* d_ws, size_t ws_size, hipStream_t stream) {
    static int grid = 0;
    if (grid == 0) {
        if (n_in != 31 || ws_size < WS_END) { fprintf(stderr, "kernel_launch: expected 31 inputs and >= %zu bytes of workspace; got %d, %zu\n", (size_t)WS_END, n_in, ws_size); grid = -1; return; }
        int dev = 0, cus = 0;
        if (hipGetDevice(&dev) != hipSuccess || hipDeviceGetAttribute(&cus, hipDeviceAttributeMultiprocessorCount, dev) != hipSuccess) { grid = -1; return; }
        if (hipFuncSetAttribute((const void*)mk_fwd<255>, hipFuncAttributeMaxDynamicSharedMemorySize, LDS_BYTES) != hipSuccess) { fprintf(stderr, "kernel_launch: hipFuncSetAttribute failed\n"); grid = -1; return; }
        int per_cu = 0;
        if (hipOccupancyMaxActiveBlocksPerMultiprocessor(&per_cu, (const void*)mk_fwd<255>, NTHR, LDS_BYTES) != hipSuccess || per_cu < 1) { fprintf(stderr, "kernel_launch: occupancy query says %d blocks per CU\n", per_cu); (void)hipGetLastError(); }
        grid = cus > 0 ? cus : 256;
    }
    if (grid < 0) return;
    (void)hipMemsetAsync((char*)d_ws + WS_CTL, 0, CTL_ZERO_BYTES, stream);
    Args a{};
    for (int i = 0; i < 31; ++i) a.in[i] = (const float*)d_in[i];
    a.out = (float*)d_out; a.ws = (unsigned char*)d_ws;
#ifndef PROBE_PH
#define PROBE_PH -1
#endif
#ifndef PROBE_MODE
#define PROBE_MODE 1
#endif
    a.use_bar = 1; a.pad = 0;
    void* kargs[] = {&a};
    hipError_t e = hipSuccess;
    if (PROBE_PH < 0) {
        a.ph_lo = 0; a.ph_hi = N_PHASES; a.li = 0; a.no_ssq = 0;
#ifdef PLAIN_LAUNCH
        hipLaunchKernelGGL(mk_fwd<255>, dim3(grid), dim3(NTHR), LDS_BYTES, stream, a); e = hipPeekAtLastError();
#else
        e = hipLaunchCooperativeKernel((const void*)mk_fwd<255>, dim3(grid), dim3(NTHR), kargs, LDS_BYTES, stream);
#endif
    } else {
        a.ph_lo = 0; a.ph_hi = PROBE_PH + 1; a.li = 0; a.no_ssq = 0;
        e = hipLaunchCooperativeKernel((const void*)mk_fwd<255>, dim3(grid), dim3(NTHR), kargs, LDS_BYTES, stream);
        a.ph_lo = PROBE_PH; a.ph_hi = PROBE_PH + 1; a.li = 1; a.no_ssq = PROBE_MODE;
        e = hipLaunchCooperativeKernel((const void*)mk_fwd<255>, dim3(grid), dim3(NTHR), kargs, LDS_BYTES, stream);
        if (PROBE_PH + 1 < N_PHASES) { a.ph_lo = PROBE_PH + 1; a.ph_hi = N_PHASES; a.li = 2; a.no_ssq = 0;
            e = hipLaunchCooperativeKernel((const void*)mk_fwd<255>, dim3(grid), dim3(NTHR), kargs, LDS_BYTES, stream); }
    }
    if (e != hipSuccess) fprintf(stderr, "kernel_launch: cooperative launch failed: %s (grid %d)\n", hipGetErrorString(e), grid);
}
```
